# Optimizing an MI355X kernel written in HIP

```python
import math
import jax
import jax.numpy as jnp
from jax import lax
import numpy as np

D_MODEL = 1024
BATCH = 16
SEQ = 2048
DEPTH = 4

GRID_W = 64
CTX_LEN = 256
N_MIXERS = 2
N_MOD = 6
EPS = 1e-6

GDN_HK = 8
GDN_HV = 16
GDN_DK = 128
GDN_DV = 128
GDN_QK_W = GDN_HK * GDN_DK
GDN_V_W = GDN_HV * GDN_DV
GDN_QKV_W = 2 * GDN_QK_W + GDN_V_W
GDN_IN_W = GDN_QKV_W + GDN_V_W + 4 * GDN_HV
CONV_W = 5
CHUNK = 64

ATT_HQ = 8
ATT_HKV = 2
ATT_G = ATT_HQ // ATT_HKV
ATT_DH = 128
ATT_IN_W = (ATT_HQ + 2 * ATT_HKV) * ATT_DH
Q_BLOCK = 128
ROPE_THETA = 10000.0

D_FF = ((8 * D_MODEL + 3 * 256 - 1) // (3 * 256)) * 256

ALPHA = (2 * DEPTH) ** 0.25
BETA_INIT = (8 * DEPTH) ** -0.25
N_GDN = (DEPTH + N_MIXERS - 1) // N_MIXERS
N_ATT = DEPTH // N_MIXERS

kernel_name = "hybrid_gdn_gqa_dit_trunk"


def layer_norm(x, g, b):
    xf = x.astype(jnp.float32)
    mu = jnp.mean(xf, axis=-1, keepdims=True)
    var = jnp.mean(jnp.square(xf - mu), axis=-1, keepdims=True)
    return ((xf - mu) * lax.rsqrt(var + EPS) * g + b).astype(x.dtype)


def rms_norm(x, g):
    xf = x.astype(jnp.float32)
    return xf * lax.rsqrt(jnp.mean(jnp.square(xf), axis=-1, keepdims=True) + EPS) * g


def l2_norm(x):
    return x * lax.rsqrt(jnp.sum(jnp.square(x), axis=-1, keepdims=True) + EPS)


def modulation(cond, w, b):
    m = jax.nn.silu(cond) @ w + b
    return m.reshape(m.shape[:-1] + (N_MOD, D_MODEL))


def modulate(x, shift, scale):
    return x * (1.0 + scale) + shift


def post_norm(x, delta, gate, g, b):
    return layer_norm(ALPHA * x + gate * delta, g, b)


def rope_tables(n_tokens):
    rows = n_tokens // GRID_W
    row = jnp.repeat(jnp.arange(rows), GRID_W).astype(jnp.float32)
    col = jnp.tile(jnp.arange(GRID_W), rows).astype(jnp.float32)
    n_freq = ATT_DH // 4
    freqs = ROPE_THETA ** (-jnp.arange(n_freq, dtype=jnp.float32) / n_freq)
    ang_r = row[:, None] * freqs
    ang_c = col[:, None] * freqs
    ang = jnp.concatenate([ang_r, ang_r, ang_c, ang_c], axis=-1)
    return jnp.cos(ang), jnp.sin(ang)


def rope_2d(x, cos, sin):
    xs = x.reshape(x.shape[:-1] + (2, 2, ATT_DH // 4))
    x1, x2 = xs[..., 0, :], xs[..., 1, :]
    rot = jnp.stack([-x2, x1], axis=-2).reshape(x.shape)
    return x * cos + rot * sin


def short_conv(x, w):
    pad = CONV_W // 2
    n_tok = x.shape[1]
    xp = jnp.pad(x, ((0, 0), (pad, pad), (0, 0)))
    y = xp[:, 0:n_tok] * w[0]
    for j in range(1, CONV_W):
        y = y + xp[:, j:j + n_tok] * w[j]
    return y


def chunk_gated_delta(q, k, v, g, beta, s0):
    f32 = jnp.float32
    B, T, H, DK = q.shape
    n = T // CHUNK

    def chunks(a):
        a = a.astype(f32).reshape((B, n, CHUNK, H) + a.shape[3:])
        return jnp.moveaxis(a, (1, 3), (0, 2))

    qc = chunks(q) * (DK ** -0.5)
    kc = chunks(k)
    vc = chunks(v)
    bc = chunks(beta)
    gcum = jnp.cumsum(chunks(g), axis=-1)
    incl = jnp.tril(jnp.ones((CHUNK, CHUNK), bool))
    strict = jnp.tril(jnp.ones((CHUNK, CHUNK), bool), -1)
    diff = gcum[..., :, None] - gcum[..., None, :]
    decay = jnp.where(incl, jnp.exp(jnp.where(incl, diff, 0.0)), 0.0)
    kb = kc * bc[..., None]
    a_mat = jnp.where(strict, jnp.einsum('nbhik,nbhjk->nbhij', kb, kc) * decay, 0.0)
    eye = jnp.eye(CHUNK, dtype=f32)
    t_inv = lax.linalg.triangular_solve(eye + a_mat, jnp.broadcast_to(eye, a_mat.shape),
                                        left_side=True, lower=True)
    u = jnp.einsum('nbhij,nbhjv->nbhiv', t_inv, vc * bc[..., None])
    w = jnp.einsum('nbhij,nbhjk->nbhik', t_inv, kb * jnp.exp(gcum)[..., None])
    qk = jnp.einsum('nbhik,nbhjk->nbhij', qc, kc) * decay

    def step(s, inp):
        q_i, k_i, u_i, w_i, qk_i, g_i = inp
        v_new = u_i - jnp.einsum('bhck,bhkv->bhcv', w_i, s)
        o_i = (jnp.einsum('bhck,bhkv->bhcv', q_i * jnp.exp(g_i)[..., None], s)
               + jnp.einsum('bhij,bhjv->bhiv', qk_i, v_new))
        g_last = g_i[..., -1:]
        s = (s * jnp.exp(g_last)[..., None]
             + jnp.einsum('bhck,bhcv->bhkv', k_i * jnp.exp(g_last - g_i)[..., None], v_new))
        return s, o_i

    s_fin, o = lax.scan(step, s0.astype(f32), (qc, kc, u, w, qk, gcum))
    o = jnp.moveaxis(o, (0, 2), (1, 3)).reshape(B, T, H, -1)
    return o, s_fin


def gdn_direction(q, k, v, g, beta, s0, reverse):
    if reverse:
        q, k, v, g, beta = (jnp.flip(a, axis=1) for a in (q, k, v, g, beta))
    o, s = chunk_gated_delta(q, k, v, g, beta, s0)
    if reverse:
        o = jnp.flip(o, axis=1)
    return o, s


def gdn_project(h, w_in, conv_w, a_log, dt_bias):
    B, T, _ = h.shape
    p = (h @ w_in).astype(jnp.float32)
    qkv = jax.nn.silu(short_conv(p[..., :GDN_QKV_W], conv_w.astype(jnp.float32)))
    z = p[..., GDN_QKV_W:GDN_QKV_W + GDN_V_W]
    off = GDN_QKV_W + GDN_V_W
    b_raw = p[..., off:off + 2 * GDN_HV].reshape(B, T, 2, GDN_HV)
    a_raw = p[..., off + 2 * GDN_HV:].reshape(B, T, 2, GDN_HV)
    rep = GDN_HV // GDN_HK
    q = jnp.repeat(l2_norm(qkv[..., :GDN_QK_W].reshape(B, T, GDN_HK, GDN_DK)), rep, axis=2)
    k = jnp.repeat(l2_norm(qkv[..., GDN_QK_W:2 * GDN_QK_W].reshape(B, T, GDN_HK, GDN_DK)), rep, axis=2)
    v = qkv[..., 2 * GDN_QK_W:].reshape(B, T, GDN_HV, GDN_DV)
    beta = jax.nn.sigmoid(b_raw)
    g = -jnp.exp(a_log.astype(jnp.float32)) * jax.nn.softplus(a_raw + dt_bias.astype(jnp.float32))
    return q, k, v, z, beta, g


def gdn_output(o, z, norm_g, w_out, dtype):
    B, T = o.shape[:2]
    y = rms_norm(o, norm_g) * jax.nn.silu(z.reshape(B, T, GDN_HV, GDN_DV))
    return y.reshape(B, T, GDN_V_W).astype(dtype) @ w_out


def gdn_mixer(h_lat, h_ctx, w_in, conv_w, a_log, dt_bias, norm_g, w_out, with_ctx_out):
    ql, kl, vl, zl, bl, gl = gdn_project(h_lat, w_in, conv_w, a_log, dt_bias)
    qc, kc, vc, zc, bc, gc = gdn_project(h_ctx, w_in, conv_w, a_log, dt_bias)
    s_zero = jnp.zeros((h_lat.shape[0], GDN_HV, GDN_DK, GDN_DV), jnp.float32)
    o_lat = []
    o_ctx = []
    for d, reverse in enumerate((False, True)):
        oc, s_ctx = gdn_direction(qc, kc, vc, gc[:, :, d], bc[:, :, d], s_zero, reverse)
        ol, _ = gdn_direction(ql, kl, vl, gl[:, :, d], bl[:, :, d], s_ctx, reverse)
        o_lat.append(ol)
        o_ctx.append(oc)
    out_lat = gdn_output(o_lat[0] + o_lat[1], zl, norm_g, w_out, h_lat.dtype)
    out_ctx = gdn_output(o_ctx[0] + o_ctx[1], zc, norm_g, w_out, h_ctx.dtype) if with_ctx_out else None
    return out_lat, out_ctx


def attn_project(h, w_qkv, q_norm, k_norm):
    B, T, _ = h.shape
    p = h @ w_qkv
    nq = ATT_HQ * ATT_DH
    nk = ATT_HKV * ATT_DH
    q = rms_norm(p[..., :nq].reshape(B, T, ATT_HQ, ATT_DH), q_norm)
    k = rms_norm(p[..., nq:nq + nk].reshape(B, T, ATT_HKV, ATT_DH), k_norm)
    v = p[..., nq + nk:].reshape(B, T, ATT_HKV, ATT_DH).astype(jnp.float32)
    q = q.reshape(B, T, ATT_HKV, ATT_G, ATT_DH).transpose(0, 2, 3, 1, 4)
    return q, k.transpose(0, 2, 1, 3), v.transpose(0, 2, 1, 3)


def softmax_attend(q, k, v):
    s = jnp.einsum('bhgqd,bhsd->bhgqs', q, k).astype(jnp.float32) * (ATT_DH ** -0.5)
    p = jax.nn.softmax(s, axis=-1)
    return jnp.einsum('bhgqs,bhsd->bhgqd', p, v)


def merge_heads(o):
    B, _, _, T, _ = o.shape
    return o.transpose(0, 3, 1, 2, 4).reshape(B, T, ATT_HQ * ATT_DH)


def attn_mixer(h_lat, h_ctx, w_qkv, q_norm, k_norm, w_out, cos, sin, with_ctx_out):
    ql, kl, vl = attn_project(h_lat, w_qkv, q_norm, k_norm)
    ql = rope_2d(ql, cos, sin)
    kl = rope_2d(kl, cos, sin)
    qc, kc, vc = attn_project(h_ctx, w_qkv, q_norm, k_norm)
    k_all = jnp.concatenate([kc, kl], axis=2)
    v_all = jnp.concatenate([vc, vl], axis=2)
    B, _, _, T, _ = ql.shape
    nblk = T // Q_BLOCK
    qb = jnp.moveaxis(ql.reshape(B, ATT_HKV, ATT_G, nblk, Q_BLOCK, ATT_DH), 3, 0)
    ob = lax.map(lambda q_blk: softmax_attend(q_blk, k_all, v_all), qb)
    ol = jnp.moveaxis(ob, 0, 3).reshape(B, ATT_HKV, ATT_G, T, ATT_DH)
    out_lat = merge_heads(ol).astype(h_lat.dtype) @ w_out
    out_ctx = merge_heads(softmax_attend(qc, kc, vc)).astype(h_ctx.dtype) @ w_out if with_ctx_out else None
    return out_lat, out_ctx


def swiglu(h, w_in, w_out):
    gu = h @ w_in
    return (jax.nn.silu(gu[..., :D_FF]) * gu[..., D_FF:]) @ w_out


def setup_inputs(seed: int = 0) -> dict:
    key = jax.random.key(seed)
    ks = jax.random.split(key, 24)
    f32 = jnp.float32
    D = D_MODEL

    def nrm(k, shape, scale):
        return jax.random.normal(k, shape, f32) * scale

    dt = jnp.exp(jax.random.uniform(ks[13], (N_GDN, 2, GDN_HV), f32, math.log(1e-3), math.log(1e-1)))
    return {
        "x": nrm(ks[0], (BATCH, SEQ, D), 1.0),
        "c": nrm(ks[1], (BATCH, D), 1.0),
        "ctx": nrm(ks[2], (BATCH, CTX_LEN, D), 1.0),
        "c_ctx": nrm(ks[3], (D,), 1.0),
        "w_mod": nrm(ks[4], (DEPTH, D, N_MOD * D), D ** -0.5),
        "b_mod": nrm(ks[5], (DEPTH, N_MOD * D), 0.02),
        "ln_g": 1.0 + nrm(ks[6], (DEPTH, 2, D), 0.05),
        "ln_b": nrm(ks[7], (DEPTH, 2, D), 0.02),
        "w_ffn_in": nrm(ks[8], (DEPTH, D, 2 * D_FF), D ** -0.5),
        "w_ffn_out": nrm(ks[9], (DEPTH, D_FF, D), D_FF ** -0.5 * BETA_INIT),
        "gdn_w_in": nrm(ks[10], (N_GDN, D, GDN_IN_W), D ** -0.5),
        "gdn_conv": nrm(ks[11], (N_GDN, CONV_W, GDN_QKV_W), CONV_W ** -0.5),
        "gdn_a_log": jnp.log(jax.random.uniform(ks[12], (N_GDN, 2, GDN_HV), f32, 1.0, 16.0)),
        "gdn_dt_bias": dt + jnp.log(-jnp.expm1(-dt)),
        "gdn_norm_g": 1.0 + nrm(ks[14], (N_GDN, GDN_DV), 0.05),
        "gdn_w_out": nrm(ks[15], (N_GDN, GDN_V_W, D), GDN_V_W ** -0.5 * BETA_INIT),
        "attn_w_qkv": nrm(ks[16], (N_ATT, D, ATT_IN_W), D ** -0.5),
        "attn_q_norm": 1.0 + nrm(ks[17], (N_ATT, ATT_DH), 0.05),
        "attn_k_norm": 1.0 + nrm(ks[18], (N_ATT, ATT_DH), 0.05),
        "attn_w_out": nrm(ks[19], (N_ATT, ATT_HQ * ATT_DH, D), (ATT_HQ * ATT_DH) ** -0.5 * BETA_INIT),
    }


def reference(x, c, ctx, c_ctx, w_mod, b_mod, ln_g, ln_b, w_ffn_in, w_ffn_out,
              gdn_w_in, gdn_conv, gdn_a_log, gdn_dt_bias, gdn_norm_g, gdn_w_out,
              attn_w_qkv, attn_q_norm, attn_k_norm, attn_w_out):
    cos, sin = rope_tables(x.shape[1])
    xl, xc = x, ctx
    for i in range(DEPTH):
        with_ctx_out = i < DEPTH - 1
        ml = modulation(c, w_mod[i], b_mod[i])
        mc = modulation(c_ctx, w_mod[i], b_mod[i])
        sh_l, sc_l, ga_l, shf_l, scf_l, gaf_l = (ml[:, j, None, :] for j in range(N_MOD))
        sh_c, sc_c, ga_c, shf_c, scf_c, gaf_c = (mc[j] for j in range(N_MOD))
        hl = modulate(xl, sh_l, sc_l)
        hc = modulate(xc, sh_c, sc_c)
        j = i // N_MIXERS
        if i % N_MIXERS == 0:
            dl, dc = gdn_mixer(hl, hc, gdn_w_in[j], gdn_conv[j], gdn_a_log[j], gdn_dt_bias[j],
                               gdn_norm_g[j], gdn_w_out[j], with_ctx_out)
        else:
            dl, dc = attn_mixer(hl, hc, attn_w_qkv[j], attn_q_norm[j], attn_k_norm[j], attn_w_out[j],
                                cos, sin, with_ctx_out)
        xl = post_norm(xl, dl, ga_l, ln_g[i, 0], ln_b[i, 0])
        xl = post_norm(xl, swiglu(modulate(xl, shf_l, scf_l), w_ffn_in[i], w_ffn_out[i]),
                       gaf_l, ln_g[i, 1], ln_b[i, 1])
        if with_ctx_out:
            xc = post_norm(xc, dc, ga_c, ln_g[i, 0], ln_b[i, 0])
            xc = post_norm(xc, swiglu(modulate(xc, shf_c, scf_c), w_ffn_in[i], w_ffn_out[i]),
                           gaf_c, ln_g[i, 1], ln_b[i, 1])
    return xl
```

```cpp
#include <hip/hip_runtime.h>
#include <hip/hip_bf16.h>
#include <hip/hip_cooperative_groups.h>
#include <cstdio>
#include <cstdint>
#include <cmath>
namespace cg = cooperative_groups;
__device__ __forceinline__ int opaque_tid() { int t = threadIdx.x; asm volatile("" : "+v"(t)); return t; }
namespace pg8 {
#define PG8_LAS __attribute__((address_space(3)))
typedef unsigned short bf16_t;
typedef short bf16x8 __attribute__((ext_vector_type(8)));
typedef float f32x4 __attribute__((ext_vector_type(4)));
typedef unsigned u32x4 __attribute__((ext_vector_type(4)));
constexpr int BM = 256, BK = 64, HALF = 128, HTB = HALF * BK * 2  , STAGE_BYTES = 8 * HTB, NXCD = 8, WGM = 8;

__host__ __device__ __forceinline__ int lds_byte(int r, int c) { const int st = (r >> 4) * 2 + (c >> 5), rr = r & 15, cc = c & 31, ob = rr * 64 + cc * 2; return st * 1024 + (ob ^ (((ob >> 9) & 1) << 5)); }
__host__ __device__ __forceinline__ void stage_rc(int b, int& R, int& C) { const int st = b / 1024, sb = b % 1024, swz = sb ^ (((sb >> 9) & 1) << 5); R = (st >> 1) * 16 + swz / 64; C = (st & 1) * 32 + (swz % 64) / 2; }
__host__ __device__ __forceinline__ int perm32(int rho) { const int n = rho >> 4, i = rho & 15; return 8 * (i >> 2) + 4 * n + (i & 3); }

struct Unit { int pm, pn; };
struct Gemm { const bf16_t* A; const bf16_t* Bt; int M, N, K; };

struct StaticOrder {
    int nM, nN, nwg, G, c;
    __host__ __device__ void init(int M, int N, int G_, int c_) { nM = M / BM; nN = N / BM; nwg = nM * nN; G = G_; c = c_; }
    __host__ __device__ bool next(int i, Unit& u) const {
        const long L = (long)i * G + c; if (L >= nwg) return false;
        int wgid = (int)L; { const int q = nwg / NXCD, r = nwg % NXCD, xcd = wgid % NXCD, off = wgid / NXCD; wgid = (xcd < r ? xcd * (q + 1) : r * (q + 1) + (xcd - r) * q) + off; }
        const int nig = WGM * nN, gid = wgid / nig, fm = gid * WGM, gsz = (nM - fm) < WGM ? (nM - fm) : WGM;
        u.pm = fm + ((wgid % nig) % gsz); u.pn = (wgid % nig) / gsz; return true;
    }
    __device__ __forceinline__ void a_ready(const Unit&) const {}
    __device__ __forceinline__ void done(const Unit&) const {}
};

__device__ __forceinline__ unsigned cvt_pk_bf16(float lo, float hi) { unsigned r; asm volatile("v_cvt_pk_bf16_f32 %0, %1, %2" : "=v"(r) : "v"(lo), "v"(hi)); return r; }
typedef float f32x2 __attribute__((ext_vector_type(2)));
__device__ __forceinline__ f32x2 gelu_pk(f32x2 v) {
    const f32x2 av = __builtin_elementwise_abs(v), d = av * 0.2316418882f + 1.0f;
    f32x2 t; t.x = __builtin_amdgcn_rcpf(d.x); t.y = __builtin_amdgcn_rcpf(d.y);
    f32x2 q = t * 0.5307027145f + (-0.7265760135f); q = q * t + 0.7107068705f; q = q * t + (-0.142248368f); q = q * t + 0.127414796f; q = q * t;
    const f32x2 s = (v * v) * (-0.72134752044f);
    f32x2 e; e.x = __builtin_amdgcn_exp2f(s.x); e.y = __builtin_amdgcn_exp2f(s.y);
    const f32x2 m = v * (q * e), r = v - m;
    f32x2 o; o.x = v.x < 0.f ? m.x : r.x; o.y = v.y < 0.f ? m.y : r.y; return o;
}

template <int ACT  > struct EpiBf16 {
    static constexpr bool PERM = true, AFTER_DRAIN = false; static_assert(ACT == 0 || ACT == 1, "EpiBf16: ACT is 0 (none) or 1 (gelu_pk)");
    bf16_t* O; int ldc; const float* bias; int split_cols; size_t split_stride; float scale0;
    __device__ __forceinline__ void operator()(const f32x4 (&acc)[2][2][4][2], const Unit& u, int wr, int wc, int fr, int fq) const {
        const int row0 = u.pm * BM + wr * 64 + fr; int colt = u.pn * BM; bf16_t* base = O;
        float sc = 1.f; if (split_cols) { const int t = colt / split_cols; base += (size_t)t * split_stride; colt -= t * split_cols; if (t == 0) sc = scale0; }
        const int col0 = colt + wc * 32 + 8 * fq, bcol0 = u.pn * BM + wc * 32 + 8 * fq;
        f32x4 bv[2][2];
#pragma unroll
        for (int bj = 0; bj < 2; ++bj)
#pragma unroll
            for (int n = 0; n < 2; ++n) bv[bj][n] = bias ? *(const f32x4*)(bias + bcol0 + bj * HALF + 4 * n) : (f32x4){0.f, 0.f, 0.f, 0.f};
#pragma unroll
        for (int ai = 0; ai < 2; ++ai)
#pragma unroll
            for (int m = 0; m < 4; ++m) { bf16_t* rowp = base + (size_t)(row0 + ai * HALF + m * 16) * ldc + col0;
#pragma unroll
                for (int bj = 0; bj < 2; ++bj) { f32x4 v0 = acc[ai][bj][m][0] + bv[bj][0], v1 = acc[ai][bj][m][1] + bv[bj][1];
                    if (ACT == 1) { f32x2 a = gelu_pk((f32x2){v0[0], v0[1]}), b = gelu_pk((f32x2){v0[2], v0[3]}), c = gelu_pk((f32x2){v1[0], v1[1]}), d = gelu_pk((f32x2){v1[2], v1[3]});
                        v0 = (f32x4){a.x, a.y, b.x, b.y}; v1 = (f32x4){c.x, c.y, d.x, d.y}; }
                    v0 = v0 * sc; v1 = v1 * sc; u32x4 w; w.x = cvt_pk_bf16(v0[0], v0[1]); w.y = cvt_pk_bf16(v0[2], v0[3]); w.z = cvt_pk_bf16(v1[0], v1[1]); w.w = cvt_pk_bf16(v1[2], v1[3]);
                    *(u32x4*)(rowp + bj * HALF) = w; } }
    }
};

struct PanelStats {
    unsigned* xbuf;
    unsigned* cnt;
    unsigned* tmo;
    int ntn; float eps;
    unsigned code;
    __device__ __forceinline__ bool run(const f32x4 (&v)[2][2][4][2], const Unit& u, int wr, int wc, int fr, int fq, PG8_LAS unsigned char* lds, int wid, int lane) const {
        typedef float f32x2v __attribute__((ext_vector_type(2)));
        PG8_LAS f32x2v* P = (PG8_LAS f32x2v*)lds;
        PG8_LAS f32x2v* S = (PG8_LAS f32x2v*)(lds + 8192);
        PG8_LAS unsigned* flag = (PG8_LAS unsigned*)(lds + 8192 + 2048);
#pragma unroll
        for (int ai = 0; ai < 2; ++ai)
#pragma unroll
            for (int m = 0; m < 4; ++m) {
                float s = 0.f;
#pragma unroll
                for (int bj = 0; bj < 2; ++bj)
#pragma unroll
                    for (int n = 0; n < 2; ++n) { const f32x4 x = v[ai][bj][m][n]; s += (x[0] + x[1]) + (x[2] + x[3]); }
                s += __shfl_xor(s, 16); s += __shfl_xor(s, 32);
                const float mw = s * (1.0f / 64.0f); float q = 0.f;
#pragma unroll
                for (int bj = 0; bj < 2; ++bj)
#pragma unroll
                    for (int n = 0; n < 2; ++n) { const f32x4 d = v[ai][bj][m][n] - mw; q += (d[0] * d[0] + d[1] * d[1]) + (d[2] * d[2] + d[3] * d[3]); }
                q += __shfl_xor(q, 16); q += __shfl_xor(q, 32);
                if (fq == 0) P[(ai * HALF + wr * 64 + m * 16 + fr) * 4 + wc] = (f32x2v){mw, q};
            }
        asm volatile("s_waitcnt lgkmcnt(0)" ::: "memory"); __builtin_amdgcn_s_barrier(); asm volatile("" ::: "memory");
#if defined(BROKEN_EXCHANGE_NO_WAIT)
#warning BROKEN CONTROL BUILD: the row-statistics exchange does not wait; results are wrong by design
        if (blockIdx.x >= 64) { const long long t0_ = clock64(); while (clock64() - t0_ < 60000) __builtin_amdgcn_s_sleep(8); }
#endif
        const int row = wid * 32 + (lane & 31);
        if (lane < 32) {
            const f32x2v a = P[row * 4 + 0], b = P[row * 4 + 1], c = P[row * 4 + 2], d = P[row * 4 + 3];
            const float mt = (a.x + b.x + c.x + d.x) * 0.25f;
            const float da = a.x - mt, db = b.x - mt, dc = c.x - mt, dd = d.x - mt;
            const float m2 = (a.y + b.y) + (c.y + d.y) + 64.0f * ((da * da + db * db) + (dc * dc + dd * dd));
            unsigned long long* slot = (unsigned long long*)xbuf + ((size_t)(u.pm * BM + row) * 4 + u.pn);
            __hip_atomic_store(slot, ((unsigned long long)__float_as_uint(m2) << 32) | __float_as_uint(mt), __ATOMIC_RELAXED, __HIP_MEMORY_SCOPE_AGENT);
        }
        asm volatile("s_waitcnt vmcnt(0)" ::: "memory");
        if (lane == 0) __hip_atomic_fetch_add(cnt + 64 * u.pm, 1u, __ATOMIC_RELAXED, __HIP_MEMORY_SCOPE_AGENT);
        if (wid == 0) {
            bool dead = false; const unsigned long long t0 = __builtin_amdgcn_s_memrealtime(); const unsigned want = 8u * (unsigned)ntn;
            for (;;) {
#if defined(BROKEN_EXCHANGE_NO_WAIT)
                break;
#endif
                if ((unsigned)__builtin_amdgcn_readfirstlane(__hip_atomic_load(cnt + 64 * u.pm, __ATOMIC_RELAXED, __HIP_MEMORY_SCOPE_AGENT)) >= want) break;
                if (__builtin_amdgcn_s_memrealtime() - t0 > 2000000ull) {
                    if (lane == 0) { unsigned expect = 0u; __hip_atomic_compare_exchange_strong(tmo + 1, &expect, code | (unsigned)(u.pm & 0xff), __ATOMIC_RELAXED, __ATOMIC_RELAXED, __HIP_MEMORY_SCOPE_AGENT);
                                     __hip_atomic_store(tmo, 1u, __ATOMIC_RELAXED, __HIP_MEMORY_SCOPE_AGENT); }
                    dead = true; break; }
                __builtin_amdgcn_s_sleep(2);
            }
            __builtin_amdgcn_fence(__ATOMIC_ACQUIRE, "agent");
            if (lane == 0) flag[0] = dead ? 1u : 0u;
        }
        asm volatile("s_waitcnt vmcnt(0) lgkmcnt(0)" ::: "memory"); __builtin_amdgcn_s_barrier(); asm volatile("" ::: "memory");
        const bool bad = flag[0] != 0u;
        if (lane < 32) {
            const unsigned long long* slot = (const unsigned long long*)xbuf + (size_t)(u.pm * BM + row) * 4; float mt[4], m2[4]; float ms = 0.f;
#pragma unroll
            for (int t = 0; t < 4; ++t) { if (t < ntn) { const unsigned long long w = __hip_atomic_load(slot + t, __ATOMIC_RELAXED, __HIP_MEMORY_SCOPE_AGENT); mt[t] = __uint_as_float((unsigned)w); m2[t] = __uint_as_float((unsigned)(w >> 32)); } else { mt[t] = 0.f; m2[t] = 0.f; } ms += mt[t]; }
            const float mean = ms / (float)ntn; float q = 0.f;
#pragma unroll
            for (int t = 0; t < 4; ++t) if (t < ntn) { const float dm = mt[t] - mean; q += m2[t] + 256.0f * dm * dm; }
            S[row] = (f32x2v){mean, 1.0f / sqrtf(q / (256.0f * (float)ntn) + eps)};
        }
        asm volatile("s_waitcnt lgkmcnt(0)" ::: "memory"); __builtin_amdgcn_s_barrier(); asm volatile("" ::: "memory");
        return bad;
    }
};
struct EpiLnRes {
    static constexpr bool PERM = false, AFTER_DRAIN = true;
    const float* base; float* out; int ldc; const float* bias; PanelStats st; unsigned poison;
    __device__ __forceinline__ void fused(f32x4 (&acc)[2][2][4][2], const Unit& u, int wr, int wc, int fr, int fq, PG8_LAS unsigned char* lds, int wid, int lane) const {
        typedef float f32x2v __attribute__((ext_vector_type(2)));
        const PG8_LAS f32x2v* S = (const PG8_LAS f32x2v*)(lds + 8192);
        const int col0 = u.pn * BM + wc * 32 + 4 * fq;
#pragma unroll
        for (int bj = 0; bj < 2; ++bj)
#pragma unroll
            for (int n = 0; n < 2; ++n) { const f32x4 bv = bias ? *(const f32x4*)(bias + col0 + bj * HALF + n * 16) : (f32x4){0.f, 0.f, 0.f, 0.f};
#pragma unroll
                for (int ai = 0; ai < 2; ++ai)
#pragma unroll
                    for (int m = 0; m < 4; ++m) acc[ai][bj][m][n] += bv; }
        f32x4 pre[4][2][2];
#pragma unroll
        for (int m = 0; m < 4; ++m) { const size_t off = (size_t)(u.pm * BM + wr * 64 + m * 16 + fr) * ldc + col0;
#pragma unroll
            for (int bj = 0; bj < 2; ++bj)
#pragma unroll
                for (int n = 0; n < 2; ++n) pre[m][bj][n] = *(const f32x4*)(base + off + bj * HALF + n * 16); }
        const bool bad = st.run(acc, u, wr, wc, fr, fq, lds, wid, lane) || poison != 0u;
        const float qnan = __builtin_nanf("");
#pragma unroll
        for (int ai = 0; ai < 2; ++ai)
#pragma unroll
            for (int m = 0; m < 4; ++m) { const int r = ai * HALF + wr * 64 + m * 16 + fr; const f32x2v sr = S[r]; const size_t off = (size_t)(u.pm * BM + r) * ldc + col0;
#pragma unroll
                for (int bj = 0; bj < 2; ++bj)
#pragma unroll
                    for (int n = 0; n < 2; ++n) { const f32x4 bs = ai == 0 ? pre[m][bj][n] : *(const f32x4*)(base + off + bj * HALF + n * 16); f32x4 o = bs + (acc[ai][bj][m][n] - sr.x) * sr.y;
                        if (bad) o = (f32x4){qnan, qnan, qnan, qnan}; *(f32x4*)(out + off + bj * HALF + n * 16) = o; }
                if (m & 1) asm volatile("" ::: "memory"); }
    }
};
struct EpiLnResLn {
    static constexpr bool PERM = false, AFTER_DRAIN = true;
    const float* base; float* out; bf16_t* xn; int ldc; const float* bias; PanelStats st1, st2; unsigned poison;
    __device__ __forceinline__ void fused(f32x4 (&acc)[2][2][4][2], const Unit& u, int wr, int wc, int fr, int fq, PG8_LAS unsigned char* lds, int wid, int lane) const {
        typedef float f32x2v __attribute__((ext_vector_type(2))); typedef unsigned u32x2v __attribute__((ext_vector_type(2)));
        const PG8_LAS f32x2v* S = (const PG8_LAS f32x2v*)(lds + 8192);
        const int col0 = u.pn * BM + wc * 32 + 4 * fq;
#pragma unroll
        for (int bj = 0; bj < 2; ++bj)
#pragma unroll
            for (int n = 0; n < 2; ++n) { const f32x4 bv = bias ? *(const f32x4*)(bias + col0 + bj * HALF + n * 16) : (f32x4){0.f, 0.f, 0.f, 0.f};
#pragma unroll
                for (int ai = 0; ai < 2; ++ai)
#pragma unroll
                    for (int m = 0; m < 4; ++m) acc[ai][bj][m][n] += bv; }
        bool bad = st1.run(acc, u, wr, wc, fr, fq, lds, wid, lane) || poison != 0u;
        const float qnan = __builtin_nanf("");
#pragma unroll
        for (int ai = 0; ai < 2; ++ai)
#pragma unroll
            for (int m = 0; m < 4; ++m) { const int r = ai * HALF + wr * 64 + m * 16 + fr; const f32x2v sr = S[r]; const size_t off = (size_t)(u.pm * BM + r) * ldc + col0;
#pragma unroll
                for (int bj = 0; bj < 2; ++bj)
#pragma unroll
                    for (int n = 0; n < 2; ++n) { const f32x4 bs = *(const f32x4*)(base + off + bj * HALF + n * 16); acc[ai][bj][m][n] = bs + (acc[ai][bj][m][n] - sr.x) * sr.y; }
                asm volatile("" : "+v"(acc[ai][0][m][0]), "+v"(acc[ai][0][m][1]), "+v"(acc[ai][1][m][0]), "+v"(acc[ai][1][m][1]));
                if (m & 1) asm volatile("" ::: "memory"); }
        const bool bad1 = bad;
        bad = st2.run(acc, u, wr, wc, fr, fq, lds, wid, lane) || bad;
#pragma unroll
        for (int ai = 0; ai < 2; ++ai)
#pragma unroll
            for (int m = 0; m < 4; ++m) { const int r = ai * HALF + wr * 64 + m * 16 + fr; const f32x2v sr = S[r]; const size_t off = (size_t)(u.pm * BM + r) * ldc + col0;
#pragma unroll
                for (int bj = 0; bj < 2; ++bj)
#pragma unroll
                    for (int n = 0; n < 2; ++n) { const f32x4 x1 = acc[ai][bj][m][n]; *(f32x4*)(out + off + bj * HALF + n * 16) = bad1 ? (f32x4){qnan, qnan, qnan, qnan} : x1;
                        const f32x4 o = (x1 - sr.x) * sr.y; u32x2v w; w.x = cvt_pk_bf16(o[0], o[1]); w.y = cvt_pk_bf16(o[2], o[3]);
                        if (bad) { w.x = 0x7fc07fc0u; w.y = 0x7fc07fc0u; } *(u32x2v*)(xn + off + bj * HALF + n * 16) = w; }
                asm volatile("" ::: "memory"); }
    }
};

template <class Epi, class Sched, bool ALIGN_EPI = false, bool SP2 = false>
__device__ __forceinline__ void gemm_phase(PG8_LAS unsigned char* lds, const Gemm g, const Sched& S, const Epi& E) {
    const int tid = opaque_tid(), wid = __builtin_amdgcn_readfirstlane(tid >> 6), lane = tid & 63, wr = wid >> 2, wc = wid & 3, fr = lane & 15, fq = lane >> 4;
    const int K = g.K, nt = K / BK;
    unsigned voffA[2], voffB[2];
#pragma unroll
    for (int i = 0; i < 2; ++i) { int R, C; stage_rc(tid * 16 + i * 8192, R, C); const int Rb = Epi::PERM ? ((R & ~31) + perm32(R & 31)) : R;
        voffA[i] = (unsigned)(R * K + C) * 2u; voffB[i] = (unsigned)(Rb * K + C) * 2u; }
    const size_t kstep = (size_t)(BK * 2);
    const size_t hstep = (size_t)HALF * K * 2;
    const size_t tstep = 2 * hstep;
    const unsigned ldsw = (unsigned)wid * 1024u;
    const int aoff = lds_byte(wr * 64 + fr, fq * 8), boff = lds_byte(wc * 32 + fr, fq * 8);
#define PG8_SA(b, h) (((b) * 2 + (h)) * HTB)
#define PG8_SB(b, h) ((4 + (b) * 2 + (h)) * HTB)
#define PG8_STAGE(bufoff, gbase, voff) do { _Pragma("unroll") for (int _i = 0; _i < 2; ++_i) \
        __builtin_amdgcn_global_load_lds((const unsigned*)((const char*)(gbase) + (voff)[_i]), (PG8_LAS unsigned*)(lds + (bufoff) + ldsw + _i * 8192), 16, 0, 0); } while (0)
#define PG8_LDA(dst, b, h) do { _Pragma("unroll") for (int m = 0; m < 4; ++m) _Pragma("unroll") for (int k = 0; k < 2; ++k) dst[m][k] = *(const PG8_LAS bf16x8*)(lds + PG8_SA(b, h) + aoff + m * 2048 + k * 1024); } while (0)
#define PG8_LDB(dst, b, h) do { _Pragma("unroll") for (int n = 0; n < 2; ++n) _Pragma("unroll") for (int k = 0; k < 2; ++k) dst[n][k] = *(const PG8_LAS bf16x8*)(lds + PG8_SB(b, h) + boff + n * 2048 + k * 1024); } while (0)
#define PG8_MMA(ai, bj, At, Bt) do { __builtin_amdgcn_s_setprio(1); _Pragma("unroll") for (int m = 0; m < 4; ++m) _Pragma("unroll") for (int n = 0; n < 2; ++n) _Pragma("unroll") for (int k = 0; k < 2; ++k) \
        acc[ai][bj][m][n] = __builtin_amdgcn_mfma_f32_16x16x32_bf16(Bt[n][k], At[m][k], acc[ai][bj][m][n], 0, 0, 0); __builtin_amdgcn_s_setprio(0); } while (0)
#define PG8_WAIT_V(n) asm volatile("s_waitcnt vmcnt(" #n ")" ::: "memory")
#define PG8_WAIT_L(n) asm volatile("s_waitcnt lgkmcnt(" #n ")" ::: "memory")
#define PG8_BAR __builtin_amdgcn_s_barrier()
#define PG8_SCHED __builtin_amdgcn_sched_barrier(0)
    Unit cur, nxt; int ui = 0;
    if (!S.next(0, cur)) return;
    f32x4 acc[2][2][4][2];
#pragma unroll
    for (int a = 0; a < 2; ++a)
#pragma unroll
        for (int b = 0; b < 2; ++b)
#pragma unroll
            for (int m = 0; m < 4; ++m)
#pragma unroll
                for (int n = 0; n < 2; ++n) acc[a][b][m][n] = (f32x4){0.f, 0.f, 0.f, 0.f};
    bf16x8 At[4][2], B0[2][2], B1[2][2];
    const char* cA = (const char*)g.A + (size_t)cur.pm * tstep; const char* cB = (const char*)g.Bt + (size_t)cur.pn * tstep;
    S.a_ready(cur);
    if constexpr (SP2) {
        PG8_STAGE(PG8_SB(0, 0), cB, voffB); PG8_STAGE(PG8_SB(0, 1), cB + hstep, voffB); PG8_STAGE(PG8_SA(0, 0), cA, voffA); PG8_STAGE(PG8_SA(0, 1), cA + hstep, voffA);
        if (wr == 1) PG8_BAR;
        PG8_WAIT_V(2); PG8_BAR;
        PG8_STAGE(PG8_SB(1, 0), cB + kstep, voffB); PG8_STAGE(PG8_SA(1, 0), cA + kstep, voffA); PG8_STAGE(PG8_SB(1, 1), cB + hstep + kstep, voffB);
        PG8_WAIT_V(6); PG8_BAR;
    } else {
        PG8_STAGE(PG8_SB(0, 0), cB, voffB); PG8_STAGE(PG8_SA(0, 0), cA, voffA); PG8_STAGE(PG8_SB(0, 1), cB + hstep, voffB); PG8_STAGE(PG8_SA(0, 1), cA + hstep, voffA);
        if (wr == 1) PG8_BAR;
        PG8_WAIT_V(4); PG8_BAR;
        PG8_STAGE(PG8_SB(1, 0), cB + kstep, voffB); PG8_STAGE(PG8_SA(1, 0), cA + kstep, voffA); PG8_STAGE(PG8_SB(1, 1), cB + hstep + kstep, voffB);
        PG8_WAIT_V(6); PG8_BAR;
    }
    for (;;) {
        const bool has_next = S.next(ui + 1, nxt);
        const char* nA = has_next ? (const char*)g.A + (size_t)nxt.pm * tstep : cA; const char* nB = has_next ? (const char*)g.Bt + (size_t)nxt.pn * tstep : cB;
        for (int t = 0; t < nt; t += 2) {
            const bool last = (t == nt - 2);
            const char* a1 = cA + (size_t)(t + 1) * kstep;
            const char* a2 = last ? nA : cA + (size_t)(t + 2) * kstep; const char* b2 = last ? nB : cB + (size_t)(t + 2) * kstep;
            const char* a3 = a2 + kstep; const char* b3 = b2 + kstep;
            if (last && has_next) S.a_ready(nxt);
            if constexpr (SP2) {
            PG8_LDB(B0, 0, 0); PG8_LDB(B1, 0, 1); PG8_SCHED; PG8_LDA(At, 0, 0); PG8_STAGE(PG8_SA(1, 1), a1 + hstep, voffA);
            PG8_WAIT_V(8); PG8_WAIT_L(0); PG8_BAR; PG8_MMA(0, 0, At, B0); PG8_MMA(0, 1, At, B1); PG8_BAR; PG8_SCHED;
            PG8_LDA(At, 0, 1); PG8_STAGE(PG8_SB(0, 0), b2, voffB); PG8_STAGE(PG8_SB(0, 1), b2 + hstep, voffB); PG8_STAGE(PG8_SA(0, 0), a2, voffA);
            PG8_WAIT_V(8); PG8_WAIT_L(0); PG8_BAR; PG8_MMA(1, 0, At, B0); PG8_MMA(1, 1, At, B1); PG8_BAR; PG8_SCHED;
            PG8_LDB(B0, 1, 0); PG8_LDB(B1, 1, 1); PG8_SCHED; PG8_LDA(At, 1, 0); PG8_STAGE(PG8_SA(0, 1), a2 + hstep, voffA);
            PG8_WAIT_V(8); PG8_WAIT_L(0); PG8_BAR; PG8_MMA(0, 0, At, B0); PG8_MMA(0, 1, At, B1); PG8_BAR; PG8_SCHED;
            PG8_LDA(At, 1, 1); PG8_STAGE(PG8_SB(1, 0), b3, voffB); PG8_STAGE(PG8_SB(1, 1), b3 + hstep, voffB); PG8_STAGE(PG8_SA(1, 0), a3, voffA);
            PG8_WAIT_V(8); PG8_WAIT_L(0); PG8_BAR; PG8_MMA(1, 0, At, B0); PG8_MMA(1, 1, At, B1); PG8_BAR; PG8_SCHED;
            } else {
            PG8_LDB(B0, 0, 0); PG8_SCHED; PG8_LDA(At, 0, 0); PG8_STAGE(PG8_SA(1, 1), a1 + hstep, voffA);
            PG8_WAIT_L(8); PG8_BAR; PG8_WAIT_L(0); PG8_MMA(0, 0, At, B0); PG8_BAR; PG8_SCHED;
            PG8_LDB(B1, 0, 1); PG8_STAGE(PG8_SB(0, 0), b2, voffB);
            PG8_BAR; PG8_WAIT_L(0); PG8_MMA(0, 1, At, B1); PG8_BAR;
            PG8_LDA(At, 0, 1); PG8_STAGE(PG8_SA(0, 0), a2, voffA);
            PG8_BAR; PG8_WAIT_L(0); PG8_MMA(1, 0, At, B0); PG8_BAR; PG8_SCHED;
            PG8_STAGE(PG8_SB(0, 1), b2 + hstep, voffB);
            PG8_WAIT_V(6); PG8_BAR; PG8_MMA(1, 1, At, B1); PG8_BAR;
            PG8_LDB(B0, 1, 0); PG8_SCHED; PG8_LDA(At, 1, 0); PG8_STAGE(PG8_SA(0, 1), a2 + hstep, voffA);
            PG8_WAIT_L(8); PG8_BAR; PG8_WAIT_L(0); PG8_MMA(0, 0, At, B0); PG8_BAR; PG8_SCHED;
            PG8_LDB(B1, 1, 1); PG8_STAGE(PG8_SB(1, 0), b3, voffB);
            PG8_BAR; PG8_WAIT_L(0); PG8_MMA(0, 1, At, B1); PG8_BAR;
            PG8_LDA(At, 1, 1); PG8_STAGE(PG8_SA(1, 0), a3, voffA);
            PG8_BAR; PG8_WAIT_L(0); PG8_MMA(1, 0, At, B0); PG8_BAR; PG8_SCHED;
            PG8_STAGE(PG8_SB(1, 1), b3 + hstep, voffB);
            PG8_WAIT_V(6); PG8_BAR; PG8_MMA(1, 1, At, B1); PG8_BAR;
            }
        }
        if constexpr (ALIGN_EPI) { if (wr == 0) PG8_BAR; }
        if constexpr (!Epi::AFTER_DRAIN) { E(acc, cur, wr, wc, fr, fq); S.done(cur); }
        if (!has_next) break;
#pragma unroll
        for (int a = 0; a < 2; ++a)
#pragma unroll
            for (int b = 0; b < 2; ++b)
#pragma unroll
                for (int m = 0; m < 4; ++m)
#pragma unroll
                    for (int n = 0; n < 2; ++n) acc[a][b][m][n] = (f32x4){0.f, 0.f, 0.f, 0.f};
        cur = nxt; cA = nA; cB = nB; ++ui;
        if constexpr (ALIGN_EPI) { if (wr == 1) PG8_BAR; }
    }
    PG8_WAIT_V(0);
    if constexpr (!ALIGN_EPI) { if (wr == 0) PG8_BAR; }
    PG8_BAR;
    if constexpr (Epi::AFTER_DRAIN) { E.fused(acc, cur, wr, wc, fr, fq, lds, wid, lane); S.done(cur); }
#undef PG8_SA
#undef PG8_SB
#undef PG8_STAGE
#undef PG8_LDA
#undef PG8_LDB
#undef PG8_MMA
#undef PG8_WAIT_V
#undef PG8_WAIT_L
#undef PG8_BAR
#undef PG8_SCHED
}
}

namespace att {
using bf16 = __hip_bfloat16;
constexpr int D = 128, NW = 8, QBLK = 32, KVBLK = 64;
constexpr float SCALE = 0.088388347648318440f;
constexpr float THR = 8.f;
constexpr int SDEPTH = 2;
constexpr size_t SHM_V = KVBLK * D * 2, SHM_K = KVBLK * D * 2, SHM_ATTN = 2 * SHM_V + 2 * SHM_K + NW * 64 * 4;
using bf16x8 = __attribute__((ext_vector_type(8))) short;
using s16x4  = __attribute__((ext_vector_type(4))) short;
using f32x16 = __attribute__((ext_vector_type(16))) float;
using f32x8  = __attribute__((ext_vector_type(8))) float;
using u32x4  = __attribute__((ext_vector_type(4))) unsigned;
#define KSWZ(row, colB) ((row) * 256 + ((colB) ^ (((row) & 7) << 4)))
#define SBAR() __builtin_amdgcn_sched_barrier(0)
__device__ __forceinline__ int crow(int r, int hi) { return (r & 3) + 8 * (r >> 2) + 4 * hi; }
__device__ __forceinline__ unsigned cvtpk(float lo, float hi) {
  unsigned r; asm volatile("v_cvt_pk_bf16_f32 %0, %1, %2" : "=v"(r) : "v"(lo), "v"(hi)); return r;
}
template <typename TIn> struct Stage;
template <> struct Stage<bf16>  { using T = bf16x8;
  __device__ static __forceinline__ T ld8(const bf16* p) { return *reinterpret_cast<const bf16x8*>(p); }
  __device__ static __forceinline__ bf16x8 tobf(T x) { return x; } };
template <> struct Stage<float> { using T = f32x8;
  __device__ static __forceinline__ T ld8(const float* p) { return *reinterpret_cast<const f32x8*>(p); }
  __device__ static __forceinline__ bf16x8 tobf(T x) {
    u32x4 w = {cvtpk(x[0], x[1]), cvtpk(x[2], x[3]), cvtpk(x[4], x[5]), cvtpk(x[6], x[7])}; return *reinterpret_cast<bf16x8*>(&w); } };

__device__ __forceinline__ void partialSM(f32x16& p0, f32x16& p1, float& m_reg, float& mn, float& alpha) {
  constexpr float C = SCALE * 1.4426950408889634f;
  float pmax = p0[0]; for (int r = 1; r < 16; ++r) pmax = fmaxf(pmax, p0[r]); for (int r = 0; r < 16; ++r) pmax = fmaxf(pmax, p1[r]);
  { auto rr = __builtin_amdgcn_permlane32_swap(__float_as_uint(pmax), __float_as_uint(pmax), false, false);
    pmax = fmaxf(__uint_as_float(rr[0]), __uint_as_float(rr[1])); }
  if (__builtin_expect(__all(pmax - m_reg <= THR / SCALE), 1)) { mn = m_reg; alpha = 1.f; }
  else { mn = fmaxf(m_reg, pmax); alpha = __builtin_amdgcn_exp2f((m_reg - mn) * C); m_reg = mn; }
  float mnC = -mn * C;
  for (int r = 0; r < 16; ++r) p0[r] = fmaf(p0[r], C, mnC); for (int r = 0; r < 16; ++r) p1[r] = fmaf(p1[r], C, mnC);
  for (int r = 0; r < 16; ++r) p0[r] = __builtin_amdgcn_exp2f(p0[r]);
}
__device__ __forceinline__ void finishSM(f32x16& p0, f32x16& p1, float alpha, float& l_reg, bf16x8& pa0, bf16x8& pa1, bf16x8& pa2, bf16x8& pa3) {
  for (int r = 0; r < 16; ++r) p1[r] = __builtin_amdgcn_exp2f(p1[r]);
  float ps = 0; for (int r = 0; r < 16; ++r) ps += p0[r]; for (int r = 0; r < 16; ++r) ps += p1[r];
  { auto rr = __builtin_amdgcn_permlane32_swap(__float_as_uint(ps), __float_as_uint(ps), false, false);
    ps = __uint_as_float(rr[0]) + __uint_as_float(rr[1]); }
  l_reg = l_reg * alpha + ps;
#define PK4(P, BASE, OUT) do { unsigned a0 = cvtpk(P[BASE + 0], P[BASE + 1]), a1 = cvtpk(P[BASE + 2], P[BASE + 3]);   \
    unsigned b0 = cvtpk(P[BASE + 4], P[BASE + 5]), b1 = cvtpk(P[BASE + 6], P[BASE + 7]);                              \
    auto r0 = __builtin_amdgcn_permlane32_swap(a0, b0, false, false); auto r1 = __builtin_amdgcn_permlane32_swap(a1, b1, false, false); \
    u32x4 w = {r0[0], r1[0], r0[1], r1[1]}; OUT = *reinterpret_cast<bf16x8*>(&w); } while (0)
  PK4(p0, 0, pa0); PK4(p0, 8, pa1); PK4(p1, 0, pa2); PK4(p1, 8, pa3);
#undef PK4
}
__device__ __forceinline__ void qkt(f32x16& p0, f32x16& p1, const bf16* Ks, const bf16x8* qr, int r32, int hi) {
  p0 = f32x16{}; p1 = f32x16{};
  for (int d0 = 0; d0 < 8; ++d0) { int cb = (d0 * 16 + hi * 8) * 2;
    bf16x8 b0 = *reinterpret_cast<const bf16x8*>((const char*)Ks + KSWZ(r32, cb));
    bf16x8 b1 = *reinterpret_cast<const bf16x8*>((const char*)Ks + KSWZ(32 + r32, cb));
    p0 = __builtin_amdgcn_mfma_f32_32x32x16_bf16(b0, qr[d0], p0, 0, 0, 0);
    p1 = __builtin_amdgcn_mfma_f32_32x32x16_bf16(b1, qr[d0], p1, 0, 0, 0); }
}
__device__ __forceinline__ int v_st(int k, int c) { const int kk = (k & ~0xC) | ((k & 4) << 1) | ((k & 8) >> 1); return ((kk >> 3) * 4 + (c >> 5)) * 512 + ((kk & 7) * 32 + (c & 31)) * 2; }
__device__ __forceinline__ int v_rd_base(int lane) { return ((lane & 3) << 3) | (((lane >> 2) & 3) << 6) | (((lane >> 4) & 1) << 5) | (((lane >> 5) & 1) << 8); }
constexpr int v_rd_off(int d0, int ks, int half) { return d0 * 512 + ks * 4096 + half * 2048; }
template <int OFF> __device__ __forceinline__ s16x4 tr_read(int vb) {
  s16x4 r; asm volatile("ds_read_b64_tr_b16 %0, %1 offset:%2" : "=&v"(r) : "v"(vb), "i"(OFF) : "memory"); return r;
}
template <int D0> __device__ __forceinline__ void pv_one(f32x16& od, int vb, bf16x8 pa0, bf16x8 pa1, bf16x8 pa2, bf16x8 pa3) {
  const s16x4 l0 = tr_read<v_rd_off(D0, 0, 0)>(vb), h0 = tr_read<v_rd_off(D0, 0, 1)>(vb), l1 = tr_read<v_rd_off(D0, 1, 0)>(vb), h1 = tr_read<v_rd_off(D0, 1, 1)>(vb);
  const s16x4 l2 = tr_read<v_rd_off(D0, 2, 0)>(vb), h2 = tr_read<v_rd_off(D0, 2, 1)>(vb), l3 = tr_read<v_rd_off(D0, 3, 0)>(vb), h3 = tr_read<v_rd_off(D0, 3, 1)>(vb);
  asm volatile("s_waitcnt lgkmcnt(0)" ::: "memory"); SBAR();
#define PK(L, H) (bf16x8){L[0], L[1], L[2], L[3], H[0], H[1], H[2], H[3]}
  od = __builtin_amdgcn_mfma_f32_32x32x16_bf16(pa0, PK(l0, h0), od, 0, 0, 0);
  od = __builtin_amdgcn_mfma_f32_32x32x16_bf16(pa1, PK(l1, h1), od, 0, 0, 0);
  od = __builtin_amdgcn_mfma_f32_32x32x16_bf16(pa2, PK(l2, h2), od, 0, 0, 0);
  od = __builtin_amdgcn_mfma_f32_32x32x16_bf16(pa3, PK(l3, h3), od, 0, 0, 0);
#undef PK
}
__device__ __forceinline__ void pv_d0(f32x16* o, int vb, bf16x8 pa0, bf16x8 pa1, bf16x8 pa2, bf16x8 pa3) {
  pv_one<0>(o[0], vb, pa0, pa1, pa2, pa3); pv_one<1>(o[1], vb, pa0, pa1, pa2, pa3); pv_one<2>(o[2], vb, pa0, pa1, pa2, pa3); pv_one<3>(o[3], vb, pa0, pa1, pa2, pa3);
}

template <typename TQ, int LDQ, int LDK, int LDO>
__device__ __forceinline__ void attn_dense_body(const TQ* __restrict__ Qb, const bf16* __restrict__ Kh, const bf16* __restrict__ Vh,
                                                unsigned short* __restrict__ Ob, int seq, char* lds) {
  using St = Stage<bf16>; using SQ = Stage<TQ>;
  const int tid = opaque_tid(), wid = tid >> 6, lane = tid & 63, r32 = lane & 31, hi = lane >> 5;
  bf16* V_lds = (bf16*)lds; bf16* K_lds = (bf16*)(lds + 2 * SHM_V);
  float* ws = (float*)(lds + 2 * SHM_V + 2 * SHM_K) + wid * 64; float* li_l = ws; float* al_l = ws + 32;
  float m_reg = -1e30f, l_reg = 0; f32x16 o[4] = {}; bf16x8 qr[8];
  const TQ* Qw = Qb + (long)(wid * QBLK + r32) * LDQ + hi * 8;
#pragma unroll
  for (int d0 = 0; d0 < 8; ++d0) qr[d0] = SQ::tobf(SQ::ld8(Qw + d0 * 16));
  const int sr = tid >> 4, sc = (tid & 15) * 8, vst0 = v_st(sr, sc), vst1 = v_st(32 + sr, sc);
  const int vb0 = (int)(uintptr_t)V_lds + v_rd_base(lane);
  struct { typename St::T vs0, vs1, ks0, ks1; } sr_[SDEPTH];
#define SLOAD(i, k0) do { sr_[i].vs0 = St::ld8(&Vh[(long)((k0) + sr) * LDK + sc]); sr_[i].vs1 = St::ld8(&Vh[(long)((k0) + 32 + sr) * LDK + sc]); \
    sr_[i].ks0 = St::ld8(&Kh[(long)((k0) + sr) * LDK + sc]); sr_[i].ks1 = St::ld8(&Kh[(long)((k0) + 32 + sr) * LDK + sc]); } while (0)
#define SWRITE(b, i) do { *(bf16x8*)((char*)V_lds + (b) * SHM_V + vst0) = St::tobf(sr_[i].vs0);          \
    *(bf16x8*)((char*)V_lds + (b) * SHM_V + vst1) = St::tobf(sr_[i].vs1); int kc = sc * 2;               \
    *(bf16x8*)((char*)K_lds + (b) * SHM_K + KSWZ(sr, kc)) = St::tobf(sr_[i].ks0);                       \
    *(bf16x8*)((char*)K_lds + (b) * SHM_K + KSWZ(32 + sr, kc)) = St::tobf(sr_[i].ks1); } while (0)
#define SWAIT() do { if constexpr (SDEPTH == 2) asm volatile("s_waitcnt vmcnt(4)" ::: "memory"); else asm volatile("s_waitcnt vmcnt(0)" ::: "memory"); } while (0)
#define RESC(a) do { if (__any((a) < 1.f)) { if (hi == 0) al_l[r32] = (a); asm volatile("s_waitcnt lgkmcnt(0)" ::: "memory"); \
    for (int d = 0; d < 4; ++d) for (int r = 0; r < 16; ++r) o[d][r] *= al_l[crow(r, hi)]; } } while (0)
  f32x16 pA0, pA1, pB0, pB1; float mnA, mnB, alA, alB; bf16x8 pa0, pa1, pa2, pa3; const int NT = seq / KVBLK;
  constexpr int SE = 0, SO = SDEPTH - 1;
  SLOAD(SE, 0); asm volatile("s_waitcnt vmcnt(0)" ::: "memory"); SWRITE(0, SE); __syncthreads();
  qkt(pA0, pA1, K_lds, qr, r32, hi); partialSM(pA0, pA1, m_reg, mnA, alA);
  SLOAD(SO, KVBLK); if constexpr (SDEPTH == 2) { if (2 < NT) SLOAD(SE, 2 * KVBLK); }
  SWAIT(); SWRITE(1, SO); __syncthreads();
  for (int j = 1; j + 1 < NT; j += 2) {
    SBAR(); qkt(pB0, pB1, (bf16*)((char*)K_lds + SHM_K), qr, r32, hi);
    finishSM(pA0, pA1, alA, l_reg, pa0, pa1, pa2, pa3); SBAR();
    SLOAD(SO, (j + SDEPTH) * KVBLK); SBAR();
    pv_d0(o, vb0, pa0, pa1, pa2, pa3); partialSM(pB0, pB1, m_reg, mnB, alB);
    __syncthreads(); SWAIT(); SWRITE(0, SE);
    RESC(alB); __syncthreads();
    SBAR(); qkt(pA0, pA1, K_lds, qr, r32, hi);
    finishSM(pB0, pB1, alB, l_reg, pa0, pa1, pa2, pa3); SBAR();
    if (SDEPTH == 1 || j + 3 < NT) SLOAD(SE, (j + 1 + SDEPTH) * KVBLK); SBAR();
    pv_d0(o, vb0 + (int)SHM_V, pa0, pa1, pa2, pa3); partialSM(pA0, pA1, m_reg, mnA, alA);
    __syncthreads(); SWAIT(); SWRITE(1, SO);
    RESC(alA); __syncthreads();
  }
  SBAR(); qkt(pB0, pB1, (bf16*)((char*)K_lds + SHM_K), qr, r32, hi);
  finishSM(pA0, pA1, alA, l_reg, pa0, pa1, pa2, pa3); SBAR();
  pv_d0(o, vb0, pa0, pa1, pa2, pa3); partialSM(pB0, pB1, m_reg, mnB, alB);
  __syncthreads(); RESC(alB);
  finishSM(pB0, pB1, alB, l_reg, pa0, pa1, pa2, pa3); SBAR();
  pv_d0(o, vb0 + (int)SHM_V, pa0, pa1, pa2, pa3);
  if (hi == 0) li_l[r32] = l_reg; asm volatile("s_waitcnt lgkmcnt(0)" ::: "memory");
  float rli[16];
#pragma unroll
  for (int r = 0; r < 16; ++r) rli[r] = __builtin_amdgcn_rcpf(li_l[crow(r, hi)]);
  unsigned short* Ow = Ob + (long)(wid * QBLK) * LDO;
#pragma unroll
  for (int r = 0; r < 16; ++r) { int orow = crow(r, hi);
    for (int d0 = 0; d0 < 4; ++d0) Ow[(long)orow * LDO + d0 * 32 + r32] = (unsigned short)(cvtpk(o[d0][r] * rli[r], 0.f) & 0xffffu); }
#undef SLOAD
#undef SWRITE
#undef SWAIT
#undef RESC
}

}

typedef const __attribute__((address_space(4))) unsigned char* kargp_t;
__device__ __forceinline__ unsigned char* karg_ptr(int byte_off) {
    kargp_t p = (kargp_t)__builtin_amdgcn_kernarg_segment_ptr(); asm volatile("" : "+s"(p));
    return *(unsigned char* const __attribute__((address_space(4)))*)(p + byte_off);
}
#define IN(k) ((const float*)karg_ptr(8 * (k)))
#define WS() (karg_ptr(168))
#define P_xlat ((float*)karg_ptr(160))
#define P_MOD ((float*)(WS() + WS_MOD))
#define P_xctx ((float*)(WS() + WS_XCTX))
#define P_GB ((float*)(WS() + WS_GB))
#define P_Wb ((bf16_t*)(WS() + WS_W))
#define P_BIG1 ((bf16_t*)(WS() + WS_BIG1))
#define P_BIG2 ((bf16_t*)(WS() + WS_BIG2))
#define MODL (P_MOD + (size_t)L * 17 * NMODC)
#define P_QKV ((bf16_t*)(WS() + WS_BIG1 + B1_QKV))
#define P_KB ((bf16_t*)(WS() + WS_BIG1 + B1_KB))
#define P_VB ((bf16_t*)(WS() + WS_BIG1 + B1_VB))
#define P_AO ((bf16_t*)(WS() + WS_BIG1 + B1_AO))

#define LAS __attribute__((address_space(3)))
typedef unsigned short bf16_t;
typedef short bf16x8 __attribute__((ext_vector_type(8)));
typedef float f32x4 __attribute__((ext_vector_type(4)));
typedef float f32x16 __attribute__((ext_vector_type(16)));
typedef unsigned u32x4 __attribute__((ext_vector_type(4)));
typedef unsigned u32x2 __attribute__((ext_vector_type(2)));

constexpr int DM = 1024, NB = 16, SEQ = 2048, CTXL = 256, NLAT = NB * SEQ, NCTX = NB * CTXL, MROWS = NLAT + NCTX;
constexpr int DFF = 2816, NMODC = 6 * DM, GIN1 = 4352, KVLEN = CTXL + SEQ;
constexpr float ALPHA = 1.6817928305074290f;
constexpr float EPS = 1e-6f;
constexpr int NTHR = 512, NWAVE = 8;

constexpr size_t WS_MOD  = 4096;
constexpr size_t WS_XCTX = WS_MOD + (size_t)4 * 17 * NMODC * 4;
constexpr size_t WS_GB   = WS_XCTX + (size_t)NCTX * DM * 4;
constexpr size_t WS_W    = WS_GB + (size_t)MROWS * 64 * 4;
constexpr size_t W_A = 0, W_Z = W_A + (size_t)GIN1 * 1024, W_O = W_Z + (size_t)2048 * 1024, W_F1 = W_O + (size_t)2048 * 1024, W_F2 = W_F1 + (size_t)5632 * 1024, W_END = W_F2 + (size_t)1024 * DFF;
constexpr size_t WS_BIG1 = WS_W + W_END * 2;
constexpr size_t WS_BIG2 = WS_BIG1 + (size_t)MROWS * 4096 * 2;
constexpr size_t WS_END  = WS_BIG2 + (size_t)MROWS * 2048 * 2;
constexpr size_t B1_QKV = 0, B1_KB = (size_t)MROWS * 1536 * 2, B1_VB = B1_KB + (size_t)NB * 2 * KVLEN * 128 * 2, B1_AO = B1_VB + (size_t)NB * 2 * KVLEN * 128 * 2;

constexpr int LDS_BYTES = 155648;

typedef float f32x2_t __attribute__((ext_vector_type(2))); typedef __bf16 bf16x2_t __attribute__((ext_vector_type(2)));
__device__ __forceinline__ unsigned cvtpk2(float lo, float hi) { f32x2_t v = {lo, hi}; bf16x2_t b = __builtin_convertvector(v, bf16x2_t); return __builtin_bit_cast(unsigned, b); }
__device__ __forceinline__ float bflo(unsigned u) { return __uint_as_float(u << 16); }
__device__ __forceinline__ float bfhi(unsigned u) { return __uint_as_float(u & 0xffff0000u); }
__device__ __forceinline__ float silu_f(float v) { return v / (1.f + __expf(-v)); }
template <int X> __device__ __forceinline__ float swzx(float v) { return __uint_as_float((unsigned)__builtin_amdgcn_ds_swizzle((int)__float_as_uint(v), (X << 10) | 0x1f)); }
__device__ __forceinline__ float wave_sum(float v) {
    v += swzx<1>(v); v += swzx<2>(v); v += swzx<4>(v); v += swzx<8>(v); v += swzx<16>(v);
    auto rr = __builtin_amdgcn_permlane32_swap(__float_as_uint(v), __float_as_uint(v), false, false);
    return __uint_as_float(rr[0]) + __uint_as_float(rr[1]);
}
__device__ __forceinline__ int crow(int r, int hi) { return (r & 3) + 8 * (r >> 2) + 4 * hi; }

struct EpiPlainBf16 {
    static constexpr bool PERM = false, AFTER_DRAIN = false;
    bf16_t* O; int ldc;
    __device__ __forceinline__ void operator()(const pg8::f32x4 (&acc)[2][2][4][2], const pg8::Unit& u, int wr, int wc, int fr, int fq) const {
        const int row0 = u.pm * 256 + wr * 64 + fr, col0 = u.pn * 256 + wc * 32 + fq * 4;
#pragma unroll
        for (int ai = 0; ai < 2; ++ai)
#pragma unroll
            for (int m = 0; m < 4; ++m) { bf16_t* rp = O + (size_t)(row0 + ai * 128 + m * 16) * ldc + col0;
#pragma unroll
                for (int bj = 0; bj < 2; ++bj)
#pragma unroll
                    for (int n = 0; n < 2; ++n) { const pg8::f32x4 v = acc[ai][bj][m][n]; u32x2 w; w.x = cvtpk2(v[0], v[1]); w.y = cvtpk2(v[2], v[3]); *(u32x2*)(rp + bj * 128 + n * 16) = w; } }
    }
};
struct EpiGdnIn {
    static constexpr bool PERM = false, AFTER_DRAIN = false;
    bf16_t* P; float* GB; const float* a_log; const float* dt_bias;
    __device__ __forceinline__ void operator()(const pg8::f32x4 (&acc)[2][2][4][2], const pg8::Unit& u, int wr, int wc, int fr, int fq) const {
        const int row0 = u.pm * 256 + wr * 64 + fr;
        if (u.pn < 16) {
            const int col0 = u.pn * 256 + wc * 32 + fq * 4;
#pragma unroll
            for (int ai = 0; ai < 2; ++ai)
#pragma unroll
                for (int m = 0; m < 4; ++m) { bf16_t* rp = P + (size_t)(row0 + ai * 128 + m * 16) * 4096 + col0;
#pragma unroll
                    for (int bj = 0; bj < 2; ++bj)
#pragma unroll
                        for (int n = 0; n < 2; ++n) { const pg8::f32x4 v = acc[ai][bj][m][n]; u32x2 w; w.x = cvtpk2(v[0], v[1]); w.y = cvtpk2(v[2], v[3]); *(u32x2*)(rp + bj * 128 + n * 16) = w; } }
        } else if (wc < 2) {
#pragma unroll
            for (int n = 0; n < 2; ++n) {
                const int col = wc * 32 + n * 16 + fq * 4;
                float al[4], db[4];
#pragma unroll
                for (int e = 0; e < 4; ++e) { const int idx = (col + e) & 31; al[e] = __expf(a_log[idx]); db[e] = dt_bias[idx]; }
#pragma unroll
                for (int ai = 0; ai < 2; ++ai)
#pragma unroll
                    for (int m = 0; m < 4; ++m) { const pg8::f32x4 v = acc[ai][0][m][n]; f32x4 o;
#pragma unroll
                        for (int e = 0; e < 4; ++e) {
                            if (col < 32) o[e] = 1.f / (1.f + __expf(-v[e]));
                            else { const float xx = v[e] + db[e]; const float sp = xx > 20.f ? xx : log1pf(__expf(xx)); o[e] = -al[e] * sp; } }
                        *(f32x4*)(GB + (size_t)(row0 + ai * 128 + m * 16) * 64 + col) = o; }
            }
        }
    }
};
struct EpiGateZ {
    static constexpr bool PERM = false, AFTER_DRAIN = false;
    bf16_t* Y;
    __device__ __forceinline__ void operator()(const pg8::f32x4 (&acc)[2][2][4][2], const pg8::Unit& u, int wr, int wc, int fr, int fq) const {
        const int row0 = u.pm * 256 + wr * 64 + fr, col0 = u.pn * 256 + wc * 32 + fq * 4;
#pragma unroll
        for (int ai = 0; ai < 2; ++ai)
#pragma unroll
            for (int m = 0; m < 4; ++m) { bf16_t* rp = Y + (size_t)(row0 + ai * 128 + m * 16) * 2048 + col0;
#pragma unroll
                for (int bj = 0; bj < 2; ++bj)
#pragma unroll
                    for (int n = 0; n < 2; ++n) { const pg8::f32x4 v = acc[ai][bj][m][n]; u32x2* p = (u32x2*)(rp + bj * 128 + n * 16); const u32x2 on = *p;
                        u32x2 w; w.x = cvtpk2(bflo(on.x) * silu_f(v[0]), bfhi(on.x) * silu_f(v[1])); w.y = cvtpk2(bflo(on.y) * silu_f(v[2]), bfhi(on.y) * silu_f(v[3])); *p = w; } }
    }
};
struct EpiResid {
    static constexpr bool PERM = false, AFTER_DRAIN = false;
    float* xlat; float* xctx; const float* gate;
    __device__ __forceinline__ void operator()(const pg8::f32x4 (&acc)[2][2][4][2], const pg8::Unit& u, int wr, int wc, int fr, int fq) const {
        const int pm = u.pm;
        float* xb = pm < 128 ? xlat + (size_t)pm * 256 * DM : xctx + (size_t)(pm - 128) * 256 * DM;
        const float* gp = gate + (size_t)(pm < 128 ? (pm >> 3) : 16) * NMODC;
        const int col0 = u.pn * 256 + wc * 32 + fq * 4, r0 = wr * 64 + fr;
#pragma unroll
        for (int bj = 0; bj < 2; ++bj)
#pragma unroll
            for (int n = 0; n < 2; ++n) { const int col = col0 + bj * 128 + n * 16; const f32x4 gv = *(const f32x4*)(gp + col);
#pragma unroll
                for (int ai = 0; ai < 2; ++ai)
#pragma unroll
                    for (int m = 0; m < 4; ++m) { float* p = xb + (size_t)(r0 + ai * 128 + m * 16) * DM + col; f32x4 xv = *(f32x4*)p; const pg8::f32x4 a = acc[ai][bj][m][n];
                        xv[0] = xv[0] * ALPHA + gv[0] * a[0]; xv[1] = xv[1] * ALPHA + gv[1] * a[1]; xv[2] = xv[2] * ALPHA + gv[2] * a[2]; xv[3] = xv[3] * ALPHA + gv[3] * a[3]; *(f32x4*)p = xv; } }
    }
};
struct EpiSwiglu {
    static constexpr bool PERM = false, AFTER_DRAIN = false;
    bf16_t* ACT;
    __device__ __forceinline__ void operator()(const pg8::f32x4 (&acc)[2][2][4][2], const pg8::Unit& u, int wr, int wc, int fr, int fq) const {
        const int row0 = u.pm * 256 + wr * 64 + fr, col0 = u.pn * 128 + wc * 16 + fq * 4;
#pragma unroll
        for (int ai = 0; ai < 2; ++ai)
#pragma unroll
            for (int m = 0; m < 4; ++m) { bf16_t* rp = ACT + (size_t)(row0 + ai * 128 + m * 16) * DFF + col0;
#pragma unroll
                for (int bj = 0; bj < 2; ++bj) { const pg8::f32x4 g = acc[ai][bj][m][0], uu = acc[ai][bj][m][1]; u32x2 w;
                    w.x = cvtpk2(silu_f(g[0]) * uu[0], silu_f(g[1]) * uu[1]); w.y = cvtpk2(silu_f(g[2]) * uu[2], silu_f(g[3]) * uu[3]); *(u32x2*)(rp + bj * 64) = w; } }
    }
};

__device__ __forceinline__ void phase_mod(const float* c, const float* c_ctx, const float* w_mod, const float* b_mod, float* MOD, LAS unsigned char* lds, int G, int bid) {
    const int tid = opaque_tid(), wave = tid >> 6, lane = tid & 63;
    LAS float* sc = (LAS float*)lds;
    LAS float* red = (LAS float*)(lds + 81920);
    if (bid < 384) {
        for (int idx = tid; idx < 17 * 1024; idx += NTHR) { const int row = idx >> 10, k = idx & 1023; const float v = row < 16 ? c[row * 1024 + k] : c_ctx[k]; sc[k * 20 + row] = v / (1.f + expf(-v)); }
    }
    __syncthreads();
    for (int item = bid; item < 384; item += G) {
        const int layer = item / 96, cgp = item % 96;
        const float* w = w_mod + (size_t)layer * 1024 * NMODC + cgp * 64 + lane;
        float acc[17];
#pragma unroll
        for (int r = 0; r < 17; ++r) acc[r] = 0.f;
        const int k0 = wave * 128;
#pragma unroll 4
        for (int k = k0; k < k0 + 128; ++k) { const float wv = w[(size_t)k * NMODC];
#pragma unroll
            for (int r = 0; r < 17; ++r) acc[r] += sc[k * 20 + r] * wv; }
#pragma unroll
        for (int r = 0; r < 17; ++r) red[(wave * 17 + r) * 64 + lane] = acc[r];
        __syncthreads();
        for (int idx = tid; idx < 17 * 64; idx += NTHR) { const int r = idx >> 6, l = idx & 63; float s = 0.f;
#pragma unroll
            for (int wv = 0; wv < 8; ++wv) s += red[(wv * 17 + r) * 64 + l];
            MOD[(size_t)(layer * 17 + r) * NMODC + cgp * 64 + l] = s + b_mod[layer * NMODC + cgp * 64 + l]; }
        __syncthreads();
    }
}

__device__ __forceinline__ int srcmap(int mode, int n, int off) {
    if (mode == 0) return n + off;
    if (mode == 1) return n < 4096 ? n : (n < 4160 ? n + 2048 : -1);
    return ((n >> 4) & 1) * DFF + ((n >> 5) << 4) + (n & 15);
}
__device__ __forceinline__ void transpose_item(const float* W, int Nsrc, bf16_t* WT, int K, int mode, int off, int nblk, LAS float* scr, int item, int lane) {
    const int kb = item / nblk, nb = item % nblk, k0 = 64 * kb, n0 = 32 * nb;
    const int sc = srcmap(mode, n0 + (lane & 31), off);
#pragma unroll 8
    for (int i = 0; i < 32; ++i) { const int kk = 2 * i + (lane >> 5); scr[kk * 33 + (lane & 31)] = sc >= 0 ? W[(size_t)(k0 + kk) * Nsrc + sc] : 0.f; }
    asm volatile("s_waitcnt lgkmcnt(0)" ::: "memory");
    const int c = lane & 7;
#pragma unroll
    for (int j = 0; j < 4; ++j) { const int n = (lane >> 3) + 8 * j; const LAS float* s = scr + (8 * c) * 33 + n;
        u32x4 o; o.x = cvtpk2(s[0 * 33], s[1 * 33]); o.y = cvtpk2(s[2 * 33], s[3 * 33]); o.z = cvtpk2(s[4 * 33], s[5 * 33]); o.w = cvtpk2(s[6 * 33], s[7 * 33]);
        *(u32x4*)(WT + (size_t)(n0 + n) * K + k0 + 8 * c) = o; }
    asm volatile("s_waitcnt lgkmcnt(0)" ::: "memory");
}
struct ConvJob { const float* W; bf16_t* WT; int Nsrc, K, mode, off, nblk, nitems; };
__device__ __forceinline__ void phase_convert(int L, bf16_t* Wb, LAS unsigned char* lds, int G, int bid) {
    const int tid_ = opaque_tid(), lane = tid_ & 63, wave = __builtin_amdgcn_readfirstlane(tid_ >> 6), gw = bid * NWAVE + wave, NGW = G * NWAVE;
    LAS float* scr = (LAS float*)(lds + wave * 8448);
    const int j = L >> 1;
    ConvJob jb[5]; int nj = 0;
    if (!(L & 1)) {
        jb[0] = ConvJob{IN(10) + (size_t)j * 1024 * 6208, Wb + W_A, 6208, 1024, 1, 0, GIN1 / 32, (GIN1 / 32) * 16};
        jb[1] = ConvJob{IN(10) + (size_t)j * 1024 * 6208, Wb + W_Z, 6208, 1024, 0, 4096, 64, 64 * 16};
        jb[2] = ConvJob{IN(15) + (size_t)j * 2048 * 1024, Wb + W_O, 1024, 2048, 0, 0, 32, 32 * 32};
        nj = 3;
    } else {
        jb[0] = ConvJob{IN(16) + (size_t)j * 1024 * 1536, Wb + W_A, 1536, 1024, 0, 0, 48, 48 * 16};
        jb[1] = ConvJob{IN(19) + (size_t)j * 1024 * 1024, Wb + W_O, 1024, 1024, 0, 0, 32, 32 * 16};
        jb[2] = ConvJob{IN(19), Wb + W_O, 1024, 1024, 0, 0, 32, 0};
        nj = 3;
    }
    jb[3] = ConvJob{IN(8) + (size_t)L * 1024 * 5632, Wb + W_F1, 5632, 1024, 2, 0, 176, 176 * 16};
    jb[4] = ConvJob{IN(9) + (size_t)L * DFF * 1024, Wb + W_F2, 1024, DFF, 0, 0, 32, 32 * 44};
    (void)nj;
    const int total = jb[0].nitems + jb[1].nitems + jb[2].nitems + jb[3].nitems + jb[4].nitems;
    for (int it = gw; it < total; it += NGW) {
        int r = it;
#pragma unroll
        for (int q = 0; q < 5; ++q) {
            if (r >= 0 && r < jb[q].nitems) { transpose_item(jb[q].W, jb[q].Nsrc, jb[q].WT, jb[q].K, jb[q].mode, jb[q].off, jb[q].nblk, scr, r, lane); r = -1; }
            else if (r >= 0) r -= jb[q].nitems;
        }
    }
}

__device__ __forceinline__ void phase_prep(const float* src_lat, const float* src_ctx, float* xlat, float* xctx, bool write_x, const float* lng, const float* lnb,
                                           bf16_t* H, const float* shift, const float* scale, int nrows, int G, int bid) {
    const int tid_ = opaque_tid(), lane = tid_ & 63, gw = bid * NWAVE + __builtin_amdgcn_readfirstlane(tid_ >> 6), NGW = G * NWAVE;
    for (int row = gw; row < nrows; row += NGW) {
        const bool islat = row < NLAT;
        const float* sp = islat ? src_lat + (size_t)row * DM : src_ctx + (size_t)(row - NLAT) * DM;
        f32x4 v[4];
#pragma unroll
        for (int j = 0; j < 4; ++j) v[j] = *(const f32x4*)(sp + 4 * lane + 256 * j);
        if (lng) {
            float s = 0.f;
#pragma unroll
            for (int j = 0; j < 4; ++j) s += (v[j][0] + v[j][1]) + (v[j][2] + v[j][3]);
            const float mean = wave_sum(s) * (1.f / DM); float s2 = 0.f;
#pragma unroll
            for (int j = 0; j < 4; ++j) { v[j] = v[j] - mean; s2 += (v[j][0] * v[j][0] + v[j][1] * v[j][1]) + (v[j][2] * v[j][2] + v[j][3] * v[j][3]); }
            const float rstd = rsqrtf(wave_sum(s2) * (1.f / DM) + EPS);
#pragma unroll
            for (int j = 0; j < 4; ++j) { const f32x4 g = *(const f32x4*)(lng + 4 * lane + 256 * j), bb = *(const f32x4*)(lnb + 4 * lane + 256 * j); v[j] = v[j] * rstd * g + bb; }
        }
        if (write_x) { float* xp = islat ? xlat + (size_t)row * DM : xctx + (size_t)(row - NLAT) * DM;
#pragma unroll
            for (int j = 0; j < 4; ++j) *(f32x4*)(xp + 4 * lane + 256 * j) = v[j]; }
        if (H) { const size_t mo = (size_t)(islat ? (row >> 11) : 16) * NMODC;
#pragma unroll
            for (int j = 0; j < 4; ++j) { const f32x4 sh = *(const f32x4*)(shift + mo + 4 * lane + 256 * j), scv = *(const f32x4*)(scale + mo + 4 * lane + 256 * j);
                const f32x4 h = v[j] * (scv + 1.f) + sh; u32x2 w; w.x = cvtpk2(h[0], h[1]); w.y = cvtpk2(h[2], h[3]); *(u32x2*)(H + (size_t)row * DM + 4 * lane + 256 * j) = w; } }
    }
}

__device__ __forceinline__ void phase_qkvpost(bf16_t* QKV, bf16_t* KB, bf16_t* VB, const float* qn, const float* kn, int G, int bid) {
    const int tid_ = opaque_tid(), lane = tid_ & 63, gw = bid * NWAVE + __builtin_amdgcn_readfirstlane(tid_ >> 6), NGW = G * NWAVE;
    const float L2T = 13.287712379549449f / 32.f;
    const int d0 = 2 * lane;
    const float f0 = exp2f(-(float)(d0 & 31) * L2T), f1 = exp2f(-(float)((d0 + 1) & 31) * L2T);
    const float qw0 = qn[d0], qw1 = qn[d0 + 1], kw0 = kn[d0], kw1 = kn[d0 + 1];
    for (int row = gw; row < MROWS; row += NGW) {
        const bool islat = row < NLAT;
        int b, pos; float c0 = 1.f, s0 = 0.f, c1 = 1.f, s1 = 0.f;
        if (islat) { b = row >> 11; const int t = row & 2047; pos = CTXL + t; const float p = (lane < 32) ? (float)(t >> 6) : (float)(t & 63); sincosf(p * f0, &s0, &c0); sincosf(p * f1, &s1, &c1); }
        else { const int r2 = row - NLAT; b = r2 >> 8; pos = r2 & 255; }
        bf16_t* base = QKV + (size_t)row * 1536 + d0;
#pragma unroll
        for (int head = 0; head < 12; ++head) {
            const unsigned raw = *(const unsigned*)(base + head * 128);
            float x0 = bflo(raw), x1 = bfhi(raw);
            if (head < 10) {
                const float ss = wave_sum(x0 * x0 + x1 * x1);
                const float rstd = rsqrtf(ss * (1.f / 128.f) + EPS);
                x0 *= rstd * (head < 8 ? qw0 : kw0); x1 *= rstd * (head < 8 ? qw1 : kw1);
                if (islat) {
                    float p0 = swzx<16>(x0), p1 = swzx<16>(x1);
                    if (!(lane & 16)) { p0 = -p0; p1 = -p1; }
                    x0 = x0 * c0 + p0 * s0; x1 = x1 * c1 + p1 * s1;
                }
            }
            const unsigned o = cvtpk2(x0, x1);
            if (head < 8) *(unsigned*)(base + head * 128) = o;
            else { const int kvh = (head - 8) & 1; bf16_t* dst = (head < 10 ? KB : VB) + ((size_t)(b * 2 + kvh) * KVLEN + pos) * 128 + d0; *(unsigned*)dst = o; }
        }
    }
}

#ifndef GDN_TRIVIAL
#define GDN_TRIVIAL 0
#endif
namespace gdn {
constexpr int SQ = 272;
constexpr int SK = 144;
constexpr int OFF_Q = 0, OFF_K = 17408  , OFF_KT = 35840, OFF_VT = 54272  , OFF_T1 = 72704, OFF_T2 = 81920,
              OFF_A = 91136  , OFF_QK = 108544, OFF_ST = 117760, OFF_SM = 152576, GDN_LDS = 154624;
static_assert(GDN_LDS <= LDS_BYTES, "lds");
__device__ __forceinline__ bf16x8 ldf(const LAS unsigned char* p) { return *(const LAS bf16x8*)p; }
__device__ __forceinline__ f32x16 mfma(bf16x8 a, bf16x8 b, f32x16 c) { return __builtin_amdgcn_mfma_f32_32x32x16_bf16(a, b, c, 0, 0, 0); }
__device__ __forceinline__ unsigned short bf1(float v) { return (unsigned short)(cvtpk2(v, 0.f) & 0xffffu); }

__device__ __forceinline__ void core(const bf16_t* __restrict__ P, const float* __restrict__ GB, const float* __restrict__ convw, const float* __restrict__ norm_g,
                                     bf16_t* O, LAS unsigned char* lds, int G, int bid) {
    const int tid0 = opaque_tid(), wave = __builtin_amdgcn_readfirstlane(tid0 >> 6);
#if GDN_TRIVIAL
    {
        for (size_t e8 = (size_t)bid * NTHR + tid0; e8 < (size_t)MROWS * 256; e8 += (size_t)G * NTHR) {
            const size_t row = e8 >> 8; const int c8 = (int)(e8 & 255) * 8;
            const u32x4 rw = *(const u32x4*)(P + row * 4096 + 2048 + c8);
            const float bt = GB[row * 64 + (c8 >> 7)] + GB[row * 64 + 32 + 16 + (c8 >> 7)];
            *(u32x4*)(O + row * 2048 + c8) = (u32x4){cvtpk2(bflo(rw.x) * bt, bfhi(rw.x) * bt), cvtpk2(bflo(rw.y) * bt, bfhi(rw.y) * bt), cvtpk2(bflo(rw.z) * bt, bfhi(rw.z) * bt), cvtpk2(bflo(rw.w) * bt, bfhi(rw.w) * bt)};
        }
        return;
    }
#endif
    LAS float* sm_gcum = (LAS float*)(lds + OFF_SM);
    LAS float* sm_beta = sm_gcum + 64;
    LAS float* sm_eg = sm_gcum + 128;
    LAS float* sm_e2 = sm_gcum + 192;
    LAS float* sm_egl = sm_gcum + 256;
    LAS float* Af = (LAS float*)(lds + OFF_A);
    const int ten = wave >> 1;
    const int ti = wave >> 2, tc = wave & 3, td = wave & 3;
    for (int item = bid; item < 256; item += G) {
        const int b = item >> 4, h = item & 15, hk = h >> 1;
        const int cgp0 = tid0 & 15;
        const int gcol0 = (ten == 0 ? hk * 128 : (ten == 1 ? 1024 + hk * 128 : 2048 + h * 128)) + cgp0 * 8;
        float cw[5][8];
        if (wave < 6) {
#pragma unroll
            for (int j = 0; j < 5; ++j) { const f32x4 a = *(const f32x4*)(convw + j * 4096 + gcol0), c = *(const f32x4*)(convw + j * 4096 + gcol0 + 4);
                cw[j][0] = a[0]; cw[j][1] = a[1]; cw[j][2] = a[2]; cw[j][3] = a[3]; cw[j][4] = c[0]; cw[j][5] = c[1]; cw[j][6] = c[2]; cw[j][7] = c[3]; }
        } else {
#pragma unroll
            for (int j = 0; j < 5; ++j)
#pragma unroll
                for (int e = 0; e < 8; ++e) cw[j][e] = 0.f;
        }
        for (int dir = 0; dir < 2; ++dir) {
            f32x16 S0, S1;
#pragma unroll
            for (int r = 0; r < 16; ++r) { S0[r] = 0.f; S1[r] = 0.f; }
            __syncthreads();
            for (int q = tid0; q < 34816 / 16; q += NTHR) *(LAS u32x4*)(lds + OFF_ST + q * 16) = (u32x4){0u, 0u, 0u, 0u};
            __syncthreads();
            for (int seqi = 0; seqi < 2; ++seqi) {
                const int T = seqi ? SEQ : CTXL; const int rowbase = seqi ? b * SEQ : NLAT + b * CTXL; const int nch = T >> 6;
                for (int n = 0; n < nch; ++n) {
                    const int c0 = dir ? T - 64 * (n + 1) : 64 * n;
                    int tid = tid0; asm volatile("" : "+v"(tid));
                    const int lane = tid & 63, l31 = lane & 31, hi = lane >> 5, idx = tid & 127, seg = idx >> 4, cgp = idx & 15;
                    const int gcol = (ten == 0 ? hk * 128 : (ten == 1 ? 1024 + hk * 128 : 2048 + h * 128)) + cgp * 8;
                    if (wave < 6) {
                        const int t0 = c0 + 8 * seg;
                        u32x4 raw[12];
#pragma unroll
                        for (int rr = 0; rr < 12; ++rr) { const int t = t0 - 2 + rr; raw[rr] = (t >= 0 && t < T) ? *(const u32x4*)(P + (size_t)(rowbase + t) * 4096 + gcol) : (u32x4){0u, 0u, 0u, 0u}; }
                        unsigned pk[8][4];
#pragma unroll
                        for (int tt = 0; tt < 8; ++tt) {
                            float y[8];
#pragma unroll
                            for (int e = 0; e < 8; ++e) y[e] = 0.f;
#pragma unroll
                            for (int j = 0; j < 5; ++j) { const u32x4 rw = raw[tt + j];
                                y[0] += bflo(rw.x) * cw[j][0]; y[1] += bfhi(rw.x) * cw[j][1]; y[2] += bflo(rw.y) * cw[j][2]; y[3] += bfhi(rw.y) * cw[j][3];
                                y[4] += bflo(rw.z) * cw[j][4]; y[5] += bfhi(rw.z) * cw[j][5]; y[6] += bflo(rw.w) * cw[j][6]; y[7] += bfhi(rw.w) * cw[j][7]; }
                            float ss = 0.f;
#pragma unroll
                            for (int e = 0; e < 8; ++e) { y[e] = silu_f(y[e]); ss += y[e] * y[e]; }
                            if (ten < 2) {
                                ss += swzx<1>(ss); ss += swzx<2>(ss); ss += swzx<4>(ss); ss += swzx<8>(ss);
                                const float sc = rsqrtf(ss + EPS) * (ten == 0 ? 0.08838834764831845f : 1.f);
#pragma unroll
                                for (int e = 0; e < 8; ++e) y[e] *= sc;
                            }
                            pk[tt][0] = cvtpk2(y[0], y[1]); pk[tt][1] = cvtpk2(y[2], y[3]); pk[tt][2] = cvtpk2(y[4], y[5]); pk[tt][3] = cvtpk2(y[6], y[7]);
                        }
                        if (ten < 2) {
                            LAS unsigned char* dst = lds + (ten == 0 ? OFF_Q : OFF_K) + cgp * 16;
#pragma unroll
                            for (int tt = 0; tt < 8; ++tt) { const int i = dir ? 63 - (8 * seg + tt) : 8 * seg + tt; *(LAS u32x4*)(dst + i * SQ) = (u32x4){pk[tt][0], pk[tt][1], pk[tt][2], pk[tt][3]}; }
                        }
                        if (ten >= 1) {
                            LAS unsigned char* dst = lds + (ten == 1 ? OFF_KT : OFF_VT) + (dir ? 56 - 8 * seg : 8 * seg) * 2;
#pragma unroll
                            for (int e = 0; e < 8; ++e) {
                                unsigned v[8];
#pragma unroll
                                for (int s = 0; s < 8; ++s) { const unsigned a = dir ? pk[7 - s][e >> 1] : pk[s][e >> 1]; v[s] = (e & 1) ? (a >> 16) : (a & 0xffffu); }
                                *(LAS u32x4*)(dst + (cgp * 8 + e) * SK) = (u32x4){v[0] | (v[1] << 16), v[2] | (v[3] << 16), v[4] | (v[5] << 16), v[6] | (v[7] << 16)};
                            }
                        }
                    } else if (wave == 6) {
                        const int t = dir ? c0 + 63 - lane : c0 + lane;
                        const float* gb = GB + (size_t)(rowbase + t) * 64;
                        const float beta = gb[dir * 16 + h]; const float g = gb[32 + dir * 16 + h];
                        float cs = g;
#pragma unroll
                        for (int off = 1; off < 64; off <<= 1) { const float v = __uint_as_float((unsigned)__builtin_amdgcn_ds_bpermute(((lane - off) & 63) << 2, (int)__float_as_uint(cs))); if (lane >= off) cs += v; }
                        const float glast = __uint_as_float((unsigned)__builtin_amdgcn_readlane((int)__float_as_uint(cs), 63));
                        sm_gcum[lane] = cs; sm_beta[lane] = beta; sm_eg[lane] = __expf(cs); sm_e2[lane] = __expf(glast - cs);
                        if (lane == 0) sm_egl[0] = __expf(glast);
                    }
                    __syncthreads();
                    if (wave < 4) {
                        const int ai = wave >> 1, aj = wave & 1;
                        if (!(ai == 0 && aj == 1)) {
                            f32x16 acc;
#pragma unroll
                            for (int r = 0; r < 16; ++r) acc[r] = 0.f;
#pragma unroll
                            for (int kk = 0; kk < 8; ++kk) acc = mfma(ldf(lds + OFF_K + (32 * ai + l31) * SQ + (16 * kk + 8 * hi) * 2), ldf(lds + OFF_K + (32 * aj + l31) * SQ + (16 * kk + 8 * hi) * 2), acc);
                            const int j = 32 * aj + l31; const float gj = sm_gcum[j];
#pragma unroll
                            for (int r = 0; r < 16; ++r) { const int i = 32 * ai + crow(r, hi); const float val = (i > j) ? sm_beta[i] * acc[r] * __expf(sm_gcum[i] - gj) : 0.f; Af[i * 68 + j] = val; }
                        }
                    } else {
                        const int w4 = wave - 4, aj = w4 >> 1, ai = w4 & 1;
                        f32x16 acc;
#pragma unroll
                        for (int r = 0; r < 16; ++r) acc[r] = 0.f;
                        if (!(aj == 1 && ai == 0)) {
#pragma unroll
                            for (int kk = 0; kk < 8; ++kk) acc = mfma(ldf(lds + OFF_K + (32 * aj + l31) * SQ + (16 * kk + 8 * hi) * 2), ldf(lds + OFF_Q + (32 * ai + l31) * SQ + (16 * kk + 8 * hi) * 2), acc);
                        }
                        const int i = 32 * ai + l31; const float gi = sm_gcum[i];
#pragma unroll
                        for (int g4 = 0; g4 < 4; ++g4) { const int j0 = 32 * aj + 8 * g4 + 4 * hi; float v[4];
#pragma unroll
                            for (int e = 0; e < 4; ++e) { const int j = j0 + e; v[e] = (i >= j) ? acc[4 * g4 + e] * __expf(gi - sm_gcum[j]) : 0.f; }
                            *(LAS u32x2*)(lds + OFF_QK + i * SK + j0 * 2) = (u32x2){cvtpk2(v[0], v[1]), cvtpk2(v[2], v[3])}; }
                    }
                    __syncthreads();
                    if (wave == 0) {
                        const int c = lane; const float cf = (float)c; const float bc = sm_beta[c], bce = bc * sm_eg[c];
                        const LAS float* Afl = Af; asm volatile("" : "+v"(Afl));
                        float x[64];
#pragma unroll
                        for (int i = 0; i < 64; ++i) {
                            float s = fmaxf(0.f, 1.f - fabsf(cf - (float)i));
#pragma unroll
                            for (int j = 0; j < i; ++j) s -= Afl[i * 68 + j] * x[j];
                            x[i] = s;
                            *(LAS unsigned short*)(lds + OFF_T1 + i * SK + c * 2) = bf1(s * bc);
                            *(LAS unsigned short*)(lds + OFF_T2 + i * SK + c * 2) = bf1(s * bce);
                        }
                    }
                    __syncthreads();
                    f32x16 au;
#pragma unroll
                    for (int r = 0; r < 16; ++r) au[r] = 0.f;
#pragma unroll
                    for (int kk = 0; kk < 4; ++kk) au = mfma(ldf(lds + OFF_T1 + (32 * ti + l31) * SK + (16 * kk + 8 * hi) * 2), ldf(lds + OFF_VT + (32 * tc + l31) * SK + (16 * kk + 8 * hi) * 2), au);
                    {
                        f32x16 aw;
#pragma unroll
                        for (int r = 0; r < 16; ++r) aw[r] = 0.f;
#pragma unroll
                        for (int kk = 0; kk < 4; ++kk) aw = mfma(ldf(lds + OFF_KT + (32 * td + l31) * SK + (16 * kk + 8 * hi) * 2), ldf(lds + OFF_T2 + (32 * ti + l31) * SK + (16 * kk + 8 * hi) * 2), aw);
                        const int i = 32 * ti + l31;
#pragma unroll
                        for (int g4 = 0; g4 < 4; ++g4) { const int d0 = 32 * td + 8 * g4 + 4 * hi;
                            *(LAS u32x2*)(lds + OFF_A + i * SQ + d0 * 2) = (u32x2){cvtpk2(-aw[4 * g4], -aw[4 * g4 + 1]), cvtpk2(-aw[4 * g4 + 2], -aw[4 * g4 + 3])}; }
                    }
                    __syncthreads();
#pragma unroll
                    for (int kk = 0; kk < 8; ++kk) au = mfma(ldf(lds + OFF_A + (32 * ti + l31) * SQ + (16 * kk + 8 * hi) * 2), ldf(lds + OFF_ST + (32 * tc + l31) * SQ + (16 * kk + 8 * hi) * 2), au);
                    {
                        const int c = 32 * tc + l31;
#pragma unroll
                        for (int g4 = 0; g4 < 4; ++g4) { const int i0 = 32 * ti + 8 * g4 + 4 * hi;
                            const f32x4 e2 = *(const LAS f32x4*)(sm_e2 + i0);
                            *(LAS u32x2*)(lds + OFF_VT + c * SK + i0 * 2) = (u32x2){cvtpk2(au[4 * g4], au[4 * g4 + 1]), cvtpk2(au[4 * g4 + 2], au[4 * g4 + 3])};
                            *(LAS u32x2*)(lds + OFF_K + c * SK + i0 * 2) = (u32x2){cvtpk2(au[4 * g4] * e2[0], au[4 * g4 + 1] * e2[1]), cvtpk2(au[4 * g4 + 2] * e2[2], au[4 * g4 + 3] * e2[3])}; }
                    }
                    __syncthreads();
                    f32x16 a1, a2;
#pragma unroll
                    for (int r = 0; r < 16; ++r) { a1[r] = 0.f; a2[r] = 0.f; }
#pragma unroll
                    for (int kk = 0; kk < 8; ++kk) a1 = mfma(ldf(lds + OFF_Q + (32 * ti + l31) * SQ + (16 * kk + 8 * hi) * 2), ldf(lds + OFF_ST + (32 * tc + l31) * SQ + (16 * kk + 8 * hi) * 2), a1);
#pragma unroll
                    for (int kk = 0; kk < 4; ++kk) a2 = mfma(ldf(lds + OFF_QK + (32 * ti + l31) * SK + (16 * kk + 8 * hi) * 2), ldf(lds + OFF_VT + (32 * tc + l31) * SK + (16 * kk + 8 * hi) * 2), a2);
#pragma unroll
                    for (int g4 = 0; g4 < 4; ++g4) { const f32x4 eg = *(const LAS f32x4*)(sm_eg + 32 * ti + 8 * g4 + 4 * hi);
#pragma unroll
                        for (int e = 0; e < 4; ++e) a2[4 * g4 + e] += a1[4 * g4 + e] * eg[e]; }
                    {
                        const float egl = sm_egl[0];
#pragma unroll
                        for (int r = 0; r < 16; ++r) { S0[r] *= egl; S1[r] *= egl; }
#pragma unroll
                        for (int kk = 0; kk < 4; ++kk) { const bf16x8 a = ldf(lds + OFF_KT + (32 * td + l31) * SK + (16 * kk + 8 * hi) * 2);
                            S0 = mfma(a, ldf(lds + OFF_K + (32 * (2 * ti) + l31) * SK + (16 * kk + 8 * hi) * 2), S0);
                            S1 = mfma(a, ldf(lds + OFF_K + (32 * (2 * ti + 1) + l31) * SK + (16 * kk + 8 * hi) * 2), S1); }
                    }
                    __syncthreads();
#pragma unroll
                    for (int g4 = 0; g4 < 4; ++g4) { const int d0 = 32 * td + 8 * g4 + 4 * hi;
                        *(LAS u32x2*)(lds + OFF_ST + (32 * (2 * ti) + l31) * SQ + d0 * 2) = (u32x2){cvtpk2(S0[4 * g4], S0[4 * g4 + 1]), cvtpk2(S0[4 * g4 + 2], S0[4 * g4 + 3])};
                        *(LAS u32x2*)(lds + OFF_ST + (32 * (2 * ti + 1) + l31) * SQ + d0 * 2) = (u32x2){cvtpk2(S1[4 * g4], S1[4 * g4 + 1]), cvtpk2(S1[4 * g4 + 2], S1[4 * g4 + 3])}; }
#pragma unroll
                    for (int r = 0; r < 16; ++r) *(LAS unsigned short*)(lds + OFF_A + (32 * ti + crow(r, hi)) * SQ + (32 * tc + l31) * 2) = bf1(a2[r]);
                    __syncthreads();
                    {
                        const int i = tid >> 3, cs = (tid & 7) * 16;
                        const int t = dir ? c0 + 63 - i : c0 + i;
                        bf16_t* gp = O + (size_t)(rowbase + t) * 2048 + h * 128 + cs;
                        const u32x4 s0 = *(const LAS u32x4*)(lds + OFF_A + i * SQ + cs * 2), s1 = *(const LAS u32x4*)(lds + OFF_A + i * SQ + cs * 2 + 16);
                        if (dir == 0) { *(u32x4*)gp = s0; *(u32x4*)(gp + 8) = s1; }
                        else {
                            const u32x4 p0 = *(const u32x4*)gp, p1 = *(const u32x4*)(gp + 8);
                            float v[16];
                            v[0] = bflo(s0.x) + bflo(p0.x); v[1] = bfhi(s0.x) + bfhi(p0.x); v[2] = bflo(s0.y) + bflo(p0.y); v[3] = bfhi(s0.y) + bfhi(p0.y);
                            v[4] = bflo(s0.z) + bflo(p0.z); v[5] = bfhi(s0.z) + bfhi(p0.z); v[6] = bflo(s0.w) + bflo(p0.w); v[7] = bfhi(s0.w) + bfhi(p0.w);
                            v[8] = bflo(s1.x) + bflo(p1.x); v[9] = bfhi(s1.x) + bfhi(p1.x); v[10] = bflo(s1.y) + bflo(p1.y); v[11] = bfhi(s1.y) + bfhi(p1.y);
                            v[12] = bflo(s1.z) + bflo(p1.z); v[13] = bfhi(s1.z) + bfhi(p1.z); v[14] = bflo(s1.w) + bflo(p1.w); v[15] = bfhi(s1.w) + bfhi(p1.w);
                            float ss = 0.f;
#pragma unroll
                            for (int e = 0; e < 16; ++e) ss += v[e] * v[e];
                            ss += swzx<1>(ss); ss += swzx<2>(ss); ss += swzx<4>(ss);
                            const float rstd = rsqrtf(ss * (1.f / 128.f) + EPS);
#pragma unroll
                            for (int e = 0; e < 16; ++e) v[e] *= rstd * norm_g[cs + e];
                            *(u32x4*)gp = (u32x4){cvtpk2(v[0], v[1]), cvtpk2(v[2], v[3]), cvtpk2(v[4], v[5]), cvtpk2(v[6], v[7])};
                            *(u32x4*)(gp + 8) = (u32x4){cvtpk2(v[8], v[9]), cvtpk2(v[10], v[11]), cvtpk2(v[12], v[13]), cvtpk2(v[14], v[15])};
                        }
                    }
                }
            }
        }
        __syncthreads();
    }
}
}

#ifndef EN_MOD
#define EN_MOD 1
#endif
#ifndef EN_GEMM
#define EN_GEMM 1
#endif
#ifndef EN_GDN
#define EN_GDN 1
#endif
#ifndef EN_ATT
#define EN_ATT 1
#endif
#ifndef EN_G1
#define EN_G1 1
#endif
#ifndef EN_G2
#define EN_G2 1
#endif
#ifndef EN_G3
#define EN_G3 1
#endif
#ifndef EN_G4
#define EN_G4 1
#endif
#ifndef EN_G5
#define EN_G5 1
#endif
#ifndef EN_G6
#define EN_G6 1
#endif
#define GSYNC() do { asm volatile("s_waitcnt vmcnt(0) lgkmcnt(0)" ::: "memory"); grid.sync(); __builtin_amdgcn_fence(__ATOMIC_ACQUIRE, "agent"); asm volatile("s_waitcnt vmcnt(0)" ::: "memory"); __syncthreads(); } while (0)
#ifndef DBG_MEMSET
#define DBG_MEMSET 0
#endif
struct Args { const float* in[20]; float* out; unsigned char* ws; };

__global__ void __launch_bounds__(NTHR, 2) fwd_megakernel(Args args) {
    extern __shared__ __attribute__((aligned(16))) unsigned char lds_raw[];
    cg::grid_group grid = cg::this_grid();
    LAS unsigned char* lds = (LAS unsigned char*)lds_raw;
    const int G = gridDim.x, bid = blockIdx.x;
#if EN_MOD
    phase_mod(IN(1), IN(3), IN(4), IN(5), P_MOD, lds, G, bid);
#endif
    __syncthreads();
    phase_convert(0, P_Wb, lds, G, bid);
    GSYNC();

    for (int L = 0; L < 4; ++L) {
        const bool is_gdn = !(L & 1), last = (L == 3);
        const int j = L >> 1;
        const int Mrows = last ? NLAT : MROWS;
        if (L == 0) phase_prep(IN(0), IN(2), P_xlat, P_xctx, true, nullptr, nullptr, P_BIG2, MODL, MODL + DM, MROWS, G, bid);
        else {
            phase_prep(P_xlat, P_xctx, P_xlat, P_xctx, true, IN(6) + (size_t)((L - 1) * 2 + 1) * DM, IN(7) + (size_t)((L - 1) * 2 + 1) * DM, P_BIG2, MODL, MODL + DM, MROWS, G, bid);
            phase_convert(L, P_Wb, lds, G, bid);
        }
        GSYNC();
        const bf16_t* mixA; int mixK;
        if (is_gdn) {
            {
                pg8::Gemm g{P_BIG2, P_Wb + W_A, MROWS, GIN1, 1024}; pg8::StaticOrder S; S.init(MROWS, GIN1, G, bid);
                EpiGdnIn E{P_BIG1, P_GB, IN(12) + j * 32, IN(13) + j * 32};
                if (EN_GEMM && EN_G1) pg8::gemm_phase<EpiGdnIn, pg8::StaticOrder, true, true>(lds, g, S, E);
            }
            GSYNC();
            if (EN_GDN) gdn::core(P_BIG1, P_GB, IN(11) + (size_t)j * 5 * 4096, IN(14) + j * 128, P_BIG2, lds, G, bid);
            GSYNC();
            phase_prep(P_xlat, P_xctx, P_xlat, P_xctx, false, nullptr, nullptr, P_BIG1, MODL, MODL + DM, MROWS, G, bid);
            GSYNC();
            {
                pg8::Gemm g{P_BIG1, P_Wb + W_Z, MROWS, 2048, 1024}; pg8::StaticOrder S; S.init(MROWS, 2048, G, bid);
                EpiGateZ E{P_BIG2};
                if (EN_GEMM && EN_G2) pg8::gemm_phase<EpiGateZ, pg8::StaticOrder, true, true>(lds, g, S, E);
            }
            GSYNC();
            mixA = P_BIG2; mixK = 2048;
        } else {
            {
                pg8::Gemm g{P_BIG2, P_Wb + W_A, MROWS, 1536, 1024}; pg8::StaticOrder S; S.init(MROWS, 1536, G, bid);
                EpiPlainBf16 E{P_QKV, 1536};
                if (EN_GEMM && EN_G3) pg8::gemm_phase<EpiPlainBf16, pg8::StaticOrder, true, true>(lds, g, S, E);
            }
            GSYNC();
            phase_qkvpost(P_QKV, P_KB, P_VB, IN(17) + j * 128, IN(18) + j * 128, G, bid);
            GSYNC();
            {
                const int total = 1024 + (last ? 0 : 128);
                for (int it = bid; it < total; it += G) {
                    const att::bf16 *Qp, *Kp, *Vp; unsigned short* Op; int seq;
                    if (it < 1024) {
                        const int rnd = it >> 8, b256 = it & 255, grp = rnd * 8 + (b256 & 7), within = b256 >> 3;
                        const int b = grp >> 1, kvh = grp & 1, gq = within >> 3, qb = within & 7, h = kvh * 4 + gq;
                        Qp = (const att::bf16*)(P_QKV + (size_t)(b * SEQ + qb * 256) * 1536 + h * 128);
                        Kp = (const att::bf16*)(P_KB + (size_t)(b * 2 + kvh) * KVLEN * 128); Vp = (const att::bf16*)(P_VB + (size_t)(b * 2 + kvh) * KVLEN * 128);
                        Op = P_AO + (size_t)(b * SEQ + qb * 256) * 1024 + h * 128; seq = KVLEN;
                    } else {
                        const int q = it - 1024, b = q >> 3, h = q & 7, kvh = h >> 2;
                        Qp = (const att::bf16*)(P_QKV + (size_t)(NLAT + b * CTXL) * 1536 + h * 128);
                        Kp = (const att::bf16*)(P_KB + (size_t)(b * 2 + kvh) * KVLEN * 128); Vp = (const att::bf16*)(P_VB + (size_t)(b * 2 + kvh) * KVLEN * 128);
                        Op = P_AO + (size_t)(NLAT + b * CTXL) * 1024 + h * 128; seq = CTXL;
                    }
                    if (EN_ATT) att::attn_dense_body<att::bf16, 1536, 128, 1024>(Qp, Kp, Vp, Op, seq, (char*)lds_raw);
                    __syncthreads();
                }
            }
            GSYNC();
            mixA = P_AO; mixK = 1024;
        }
        {
            pg8::Gemm g{mixA, P_Wb + W_O, Mrows, 1024, mixK}; pg8::StaticOrder S; S.init(Mrows, 1024, G, bid);
            EpiResid E{P_xlat, P_xctx, MODL + 2 * DM};
            if (EN_GEMM && EN_G4) pg8::gemm_phase<EpiResid, pg8::StaticOrder, true, true>(lds, g, S, E);
        }
        GSYNC();
        phase_prep(P_xlat, P_xctx, P_xlat, P_xctx, true, IN(6) + (size_t)(L * 2) * DM, IN(7) + (size_t)(L * 2) * DM, P_BIG2, MODL + 3 * DM, MODL + 4 * DM, Mrows, G, bid);
        GSYNC();
        {
            pg8::Gemm g{P_BIG2, P_Wb + W_F1, Mrows, 5632, 1024}; pg8::StaticOrder S; S.init(Mrows, 5632, G, bid);
            EpiSwiglu E{P_BIG1};
            if (EN_GEMM && EN_G5) pg8::gemm_phase<EpiSwiglu, pg8::StaticOrder, true, true>(lds, g, S, E);
        }
        GSYNC();
        {
            pg8::Gemm g{P_BIG1, P_Wb + W_F2, Mrows, 1024, DFF}; pg8::StaticOrder S; S.init(Mrows, 1024, G, bid);
            EpiResid E{P_xlat, P_xctx, MODL + 5 * DM};
            if (EN_GEMM && EN_G6) pg8::gemm_phase<EpiResid, pg8::StaticOrder, true, true>(lds, g, S, E);
        }
        GSYNC();
    }
    phase_prep(P_xlat, P_xctx, P_xlat, P_xctx, true, IN(6) + (size_t)7 * DM, IN(7) + (size_t)7 * DM, nullptr, nullptr, nullptr, NLAT, G, bid);
}

extern "C" void kernel_launch(void* const* d_in, const int* in_sizes, int n_in, void* d_out, int out_size, void* d_ws, size_t ws_size, hipStream_t stream) {
    static int grid = 0;
    if (grid == 0) {
        if (n_in != 20 || out_size != NLAT * DM || ws_size < WS_END) { fprintf(stderr, "kernel_launch: unexpected shapes: n_in %d out %d ws %zu (need %zu)\n", n_in, out_size, ws_size, (size_t)WS_END); grid = -1; return; }
        int dev = 0, cus = 0, per_cu = 0;
        hipGetDevice(&dev); hipDeviceGetAttribute(&cus, hipDeviceAttributeMultiprocessorCount, dev);
        if (hipFuncSetAttribute((const void*)fwd_megakernel, hipFuncAttributeMaxDynamicSharedMemorySize, LDS_BYTES) != hipSuccess) { fprintf(stderr, "kernel_launch: hipFuncSetAttribute failed\n"); grid = -1; return; }
        if (hipOccupancyMaxActiveBlocksPerMultiprocessor(&per_cu, (const void*)fwd_megakernel, NTHR, LDS_BYTES) != hipSuccess || per_cu < 1) { fprintf(stderr, "kernel_launch: occupancy query says %d\n", per_cu); per_cu = 1; }
        (void)hipGetLastError();
        grid = cus;
    }
    if (grid < 0) return;
    Args a{};
    for (int i = 0; i < 20; ++i) a.in[i] = (const float*)d_in[i];
    a.out = (float*)d_out; a.ws = (unsigned char*)d_ws;
#if DBG_MEMSET
    (void)hipMemsetAsync(d_ws, 0, WS_END, stream); (void)hipMemsetAsync(d_out, 0, (size_t)out_size * 4, stream);
#endif
    void* kargs[] = {&a};
    hipError_t e = hipLaunchCooperativeKernel((const void*)fwd_megakernel, dim3(grid), dim3(NTHR), kargs, LDS_BYTES, stream);
    if (e != hipSuccess) fprintf(stderr, "kernel_launch: cooperative launch failed: %s (grid %d)\n", hipGetErrorString(e), grid);
}
```

```cpp
#include <hip/hip_runtime.h>
#include <hip/hip_bf16.h>
#include <hip/hip_cooperative_groups.h>
#include <cstdio>
#include <cstdint>
#include <cmath>
namespace cg = cooperative_groups;
__device__ __forceinline__ int opaque_tid() { int t = threadIdx.x; asm volatile("" : "+v"(t)); return t; }
namespace pg8 {
#define PG8_LAS __attribute__((address_space(3)))
typedef unsigned short bf16_t;
typedef short bf16x8 __attribute__((ext_vector_type(8)));
typedef float f32x4 __attribute__((ext_vector_type(4)));
typedef unsigned u32x4 __attribute__((ext_vector_type(4)));
constexpr int BM = 256, BK = 64, HALF = 128, HTB = HALF * BK * 2  , STAGE_BYTES = 8 * HTB, NXCD = 8, WGM = 4;

__host__ __device__ __forceinline__ int lds_byte(int r, int c) { const int st = (r >> 4) * 2 + (c >> 5), rr = r & 15, cc = c & 31, ob = rr * 64 + cc * 2; return st * 1024 + (ob ^ (((ob >> 9) & 1) << 5)); }
__host__ __device__ __forceinline__ void stage_rc(int b, int& R, int& C) { const int st = b / 1024, sb = b % 1024, swz = sb ^ (((sb >> 9) & 1) << 5); R = (st >> 1) * 16 + swz / 64; C = (st & 1) * 32 + (swz % 64) / 2; }
__host__ __device__ __forceinline__ int perm32(int rho) { const int n = rho >> 4, i = rho & 15; return 8 * (i >> 2) + 4 * n + (i & 3); }

struct Unit { int pm, pn; };
struct Gemm { const bf16_t* A; const bf16_t* Bt; int M, N, K, lda; };

struct StaticOrder {
    int nM, nN, nwg, G, c;
    __host__ __device__ void init(int M, int N, int G_, int c_) { nM = M / BM; nN = N / BM; nwg = nM * nN; G = G_; c = c_; }
    __host__ __device__ bool next(int i, Unit& u) const {
        const long L = (long)i * G + c; if (L >= nwg) return false;
        int wgid = (int)L; { const int q = nwg / NXCD, r = nwg % NXCD, xcd = wgid % NXCD, off = wgid / NXCD; wgid = (xcd < r ? xcd * (q + 1) : r * (q + 1) + (xcd - r) * q) + off; }
        const int nig = WGM * nN, gid = wgid / nig, fm = gid * WGM, gsz = (nM - fm) < WGM ? (nM - fm) : WGM;
        u.pm = fm + ((wgid % nig) % gsz); u.pn = (wgid % nig) / gsz; return true;
    }
    __device__ __forceinline__ void a_ready(const Unit&) const {}
    __device__ __forceinline__ void done(const Unit&) const {}
};

__device__ __forceinline__ unsigned cvt_pk_bf16(float lo, float hi) { unsigned r; asm volatile("v_cvt_pk_bf16_f32 %0, %1, %2" : "=v"(r) : "v"(lo), "v"(hi)); return r; }
typedef float f32x2 __attribute__((ext_vector_type(2)));
__device__ __forceinline__ f32x2 gelu_pk(f32x2 v) {
    const f32x2 av = __builtin_elementwise_abs(v), d = av * 0.2316418882f + 1.0f;
    f32x2 t; t.x = __builtin_amdgcn_rcpf(d.x); t.y = __builtin_amdgcn_rcpf(d.y);
    f32x2 q = t * 0.5307027145f + (-0.7265760135f); q = q * t + 0.7107068705f; q = q * t + (-0.142248368f); q = q * t + 0.127414796f; q = q * t;
    const f32x2 s = (v * v) * (-0.72134752044f);
    f32x2 e; e.x = __builtin_amdgcn_exp2f(s.x); e.y = __builtin_amdgcn_exp2f(s.y);
    const f32x2 m = v * (q * e), r = v - m;
    f32x2 o; o.x = v.x < 0.f ? m.x : r.x; o.y = v.y < 0.f ? m.y : r.y; return o;
}

template <int ACT  > struct EpiBf16 {
    static constexpr bool PERM = true, AFTER_DRAIN = false; static_assert(ACT == 0 || ACT == 1, "EpiBf16: ACT is 0 (none) or 1 (gelu_pk)");
    bf16_t* O; int ldc; const float* bias; int split_cols; size_t split_stride; float scale0;
    __device__ __forceinline__ void operator()(const f32x4 (&acc)[2][2][4][2], const Unit& u, int wr, int wc, int fr, int fq) const {
        const int row0 = u.pm * BM + wr * 64 + fr; int colt = u.pn * BM; bf16_t* base = O;
        float sc = 1.f; if (split_cols) { const int t = colt / split_cols; base += (size_t)t * split_stride; colt -= t * split_cols; if (t == 0) sc = scale0; }
        const int col0 = colt + wc * 32 + 8 * fq, bcol0 = u.pn * BM + wc * 32 + 8 * fq;
        f32x4 bv[2][2];
#pragma unroll
        for (int bj = 0; bj < 2; ++bj)
#pragma unroll
            for (int n = 0; n < 2; ++n) bv[bj][n] = bias ? *(const f32x4*)(bias + bcol0 + bj * HALF + 4 * n) : (f32x4){0.f, 0.f, 0.f, 0.f};
#pragma unroll
        for (int ai = 0; ai < 2; ++ai)
#pragma unroll
            for (int m = 0; m < 4; ++m) { bf16_t* rowp = base + (size_t)(row0 + ai * HALF + m * 16) * ldc + col0;
#pragma unroll
                for (int bj = 0; bj < 2; ++bj) { f32x4 v0 = acc[ai][bj][m][0] + bv[bj][0], v1 = acc[ai][bj][m][1] + bv[bj][1];
                    if (ACT == 1) { f32x2 a = gelu_pk((f32x2){v0[0], v0[1]}), b = gelu_pk((f32x2){v0[2], v0[3]}), c = gelu_pk((f32x2){v1[0], v1[1]}), d = gelu_pk((f32x2){v1[2], v1[3]});
                        v0 = (f32x4){a.x, a.y, b.x, b.y}; v1 = (f32x4){c.x, c.y, d.x, d.y}; }
                    v0 = v0 * sc; v1 = v1 * sc; u32x4 w; w.x = cvt_pk_bf16(v0[0], v0[1]); w.y = cvt_pk_bf16(v0[2], v0[3]); w.z = cvt_pk_bf16(v1[0], v1[1]); w.w = cvt_pk_bf16(v1[2], v1[3]);
                    *(u32x4*)(rowp + bj * HALF) = w; } }
    }
};

struct PanelStats {
    unsigned* xbuf;
    unsigned* cnt;
    unsigned* tmo;
    int ntn; float eps;
    unsigned code;
    __device__ __forceinline__ bool run(const f32x4 (&v)[2][2][4][2], const Unit& u, int wr, int wc, int fr, int fq, PG8_LAS unsigned char* lds, int wid, int lane) const {
        typedef float f32x2v __attribute__((ext_vector_type(2)));
        PG8_LAS f32x2v* P = (PG8_LAS f32x2v*)lds;
        PG8_LAS f32x2v* S = (PG8_LAS f32x2v*)(lds + 8192);
        PG8_LAS unsigned* flag = (PG8_LAS unsigned*)(lds + 8192 + 2048);
#pragma unroll
        for (int ai = 0; ai < 2; ++ai)
#pragma unroll
            for (int m = 0; m < 4; ++m) {
                float s = 0.f;
#pragma unroll
                for (int bj = 0; bj < 2; ++bj)
#pragma unroll
                    for (int n = 0; n < 2; ++n) { const f32x4 x = v[ai][bj][m][n]; s += (x[0] + x[1]) + (x[2] + x[3]); }
                s += __shfl_xor(s, 16); s += __shfl_xor(s, 32);
                const float mw = s * (1.0f / 64.0f); float q = 0.f;
#pragma unroll
                for (int bj = 0; bj < 2; ++bj)
#pragma unroll
                    for (int n = 0; n < 2; ++n) { const f32x4 d = v[ai][bj][m][n] - mw; q += (d[0] * d[0] + d[1] * d[1]) + (d[2] * d[2] + d[3] * d[3]); }
                q += __shfl_xor(q, 16); q += __shfl_xor(q, 32);
                if (fq == 0) P[(ai * HALF + wr * 64 + m * 16 + fr) * 4 + wc] = (f32x2v){mw, q};
            }
        asm volatile("s_waitcnt lgkmcnt(0)" ::: "memory"); __builtin_amdgcn_s_barrier(); asm volatile("" ::: "memory");
#if defined(BROKEN_EXCHANGE_NO_WAIT)
#warning BROKEN CONTROL BUILD: the row-statistics exchange does not wait; results are wrong by design
        if (blockIdx.x >= 64) { const long long t0_ = clock64(); while (clock64() - t0_ < 60000) __builtin_amdgcn_s_sleep(8); }
#endif
        const int row = wid * 32 + (lane & 31);
        if (lane < 32) {
            const f32x2v a = P[row * 4 + 0], b = P[row * 4 + 1], c = P[row * 4 + 2], d = P[row * 4 + 3];
            const float mt = (a.x + b.x + c.x + d.x) * 0.25f;
            const float da = a.x - mt, db = b.x - mt, dc = c.x - mt, dd = d.x - mt;
            const float m2 = (a.y + b.y) + (c.y + d.y) + 64.0f * ((da * da + db * db) + (dc * dc + dd * dd));
            unsigned long long* slot = (unsigned long long*)xbuf + ((size_t)(u.pm * BM + row) * 4 + u.pn);
            __hip_atomic_store(slot, ((unsigned long long)__float_as_uint(m2) << 32) | __float_as_uint(mt), __ATOMIC_RELAXED, __HIP_MEMORY_SCOPE_AGENT);
        }
        asm volatile("s_waitcnt vmcnt(0)" ::: "memory");
        if (lane == 0) __hip_atomic_fetch_add(cnt + 64 * u.pm, 1u, __ATOMIC_RELAXED, __HIP_MEMORY_SCOPE_AGENT);
        if (wid == 0) {
            bool dead = false; const unsigned long long t0 = __builtin_amdgcn_s_memrealtime(); const unsigned want = 8u * (unsigned)ntn;
            for (;;) {
#if defined(BROKEN_EXCHANGE_NO_WAIT)
                break;
#endif
                if ((unsigned)__builtin_amdgcn_readfirstlane(__hip_atomic_load(cnt + 64 * u.pm, __ATOMIC_RELAXED, __HIP_MEMORY_SCOPE_AGENT)) >= want) break;
                if (__builtin_amdgcn_s_memrealtime() - t0 > 2000000ull) {
                    if (lane == 0) { unsigned expect = 0u; __hip_atomic_compare_exchange_strong(tmo + 1, &expect, code | (unsigned)(u.pm & 0xff), __ATOMIC_RELAXED, __ATOMIC_RELAXED, __HIP_MEMORY_SCOPE_AGENT);
                                     __hip_atomic_store(tmo, 1u, __ATOMIC_RELAXED, __HIP_MEMORY_SCOPE_AGENT); }
                    dead = true; break; }
                __builtin_amdgcn_s_sleep(2);
            }
            __builtin_amdgcn_fence(__ATOMIC_ACQUIRE, "agent");
            if (lane == 0) flag[0] = dead ? 1u : 0u;
        }
        asm volatile("s_waitcnt vmcnt(0) lgkmcnt(0)" ::: "memory"); __builtin_amdgcn_s_barrier(); asm volatile("" ::: "memory");
        const bool bad = flag[0] != 0u;
        if (lane < 32) {
            const unsigned long long* slot = (const unsigned long long*)xbuf + (size_t)(u.pm * BM + row) * 4; float mt[4], m2[4]; float ms = 0.f;
#pragma unroll
            for (int t = 0; t < 4; ++t) { if (t < ntn) { const unsigned long long w = __hip_atomic_load(slot + t, __ATOMIC_RELAXED, __HIP_MEMORY_SCOPE_AGENT); mt[t] = __uint_as_float((unsigned)w); m2[t] = __uint_as_float((unsigned)(w >> 32)); } else { mt[t] = 0.f; m2[t] = 0.f; } ms += mt[t]; }
            const float mean = ms / (float)ntn; float q = 0.f;
#pragma unroll
            for (int t = 0; t < 4; ++t) if (t < ntn) { const float dm = mt[t] - mean; q += m2[t] + 256.0f * dm * dm; }
            S[row] = (f32x2v){mean, 1.0f / sqrtf(q / (256.0f * (float)ntn) + eps)};
        }
        asm volatile("s_waitcnt lgkmcnt(0)" ::: "memory"); __builtin_amdgcn_s_barrier(); asm volatile("" ::: "memory");
        return bad;
    }
};
struct EpiLnRes {
    static constexpr bool PERM = false, AFTER_DRAIN = true;
    const float* base; float* out; int ldc; const float* bias; PanelStats st; unsigned poison;
    __device__ __forceinline__ void fused(f32x4 (&acc)[2][2][4][2], const Unit& u, int wr, int wc, int fr, int fq, PG8_LAS unsigned char* lds, int wid, int lane) const {
        typedef float f32x2v __attribute__((ext_vector_type(2)));
        const PG8_LAS f32x2v* S = (const PG8_LAS f32x2v*)(lds + 8192);
        const int col0 = u.pn * BM + wc * 32 + 4 * fq;
#pragma unroll
        for (int bj = 0; bj < 2; ++bj)
#pragma unroll
            for (int n = 0; n < 2; ++n) { const f32x4 bv = bias ? *(const f32x4*)(bias + col0 + bj * HALF + n * 16) : (f32x4){0.f, 0.f, 0.f, 0.f};
#pragma unroll
                for (int ai = 0; ai < 2; ++ai)
#pragma unroll
                    for (int m = 0; m < 4; ++m) acc[ai][bj][m][n] += bv; }
        f32x4 pre[4][2][2];
#pragma unroll
        for (int m = 0; m < 4; ++m) { const size_t off = (size_t)(u.pm * BM + wr * 64 + m * 16 + fr) * ldc + col0;
#pragma unroll
            for (int bj = 0; bj < 2; ++bj)
#pragma unroll
                for (int n = 0; n < 2; ++n) pre[m][bj][n] = *(const f32x4*)(base + off + bj * HALF + n * 16); }
        const bool bad = st.run(acc, u, wr, wc, fr, fq, lds, wid, lane) || poison != 0u;
        const float qnan = __builtin_nanf("");
#pragma unroll
        for (int ai = 0; ai < 2; ++ai)
#pragma unroll
            for (int m = 0; m < 4; ++m) { const int r = ai * HALF + wr * 64 + m * 16 + fr; const f32x2v sr = S[r]; const size_t off = (size_t)(u.pm * BM + r) * ldc + col0;
#pragma unroll
                for (int bj = 0; bj < 2; ++bj)
#pragma unroll
                    for (int n = 0; n < 2; ++n) { const f32x4 bs = ai == 0 ? pre[m][bj][n] : *(const f32x4*)(base + off + bj * HALF + n * 16); f32x4 o = bs + (acc[ai][bj][m][n] - sr.x) * sr.y;
                        if (bad) o = (f32x4){qnan, qnan, qnan, qnan}; *(f32x4*)(out + off + bj * HALF + n * 16) = o; }
                if (m & 1) asm volatile("" ::: "memory"); }
    }
};
struct EpiLnResLn {
    static constexpr bool PERM = false, AFTER_DRAIN = true;
    const float* base; float* out; bf16_t* xn; int ldc; const float* bias; PanelStats st1, st2; unsigned poison;
    __device__ __forceinline__ void fused(f32x4 (&acc)[2][2][4][2], const Unit& u, int wr, int wc, int fr, int fq, PG8_LAS unsigned char* lds, int wid, int lane) const {
        typedef float f32x2v __attribute__((ext_vector_type(2))); typedef unsigned u32x2v __attribute__((ext_vector_type(2)));
        const PG8_LAS f32x2v* S = (const PG8_LAS f32x2v*)(lds + 8192);
        const int col0 = u.pn * BM + wc * 32 + 4 * fq;
#pragma unroll
        for (int bj = 0; bj < 2; ++bj)
#pragma unroll
            for (int n = 0; n < 2; ++n) { const f32x4 bv = bias ? *(const f32x4*)(bias + col0 + bj * HALF + n * 16) : (f32x4){0.f, 0.f, 0.f, 0.f};
#pragma unroll
                for (int ai = 0; ai < 2; ++ai)
#pragma unroll
                    for (int m = 0; m < 4; ++m) acc[ai][bj][m][n] += bv; }
        bool bad = st1.run(acc, u, wr, wc, fr, fq, lds, wid, lane) || poison != 0u;
        const float qnan = __builtin_nanf("");
#pragma unroll
        for (int ai = 0; ai < 2; ++ai)
#pragma unroll
            for (int m = 0; m < 4; ++m) { const int r = ai * HALF + wr * 64 + m * 16 + fr; const f32x2v sr = S[r]; const size_t off = (size_t)(u.pm * BM + r) * ldc + col0;
#pragma unroll
                for (int bj = 0; bj < 2; ++bj)
#pragma unroll
                    for (int n = 0; n < 2; ++n) { const f32x4 bs = *(const f32x4*)(base + off + bj * HALF + n * 16); acc[ai][bj][m][n] = bs + (acc[ai][bj][m][n] - sr.x) * sr.y; }
                asm volatile("" : "+v"(acc[ai][0][m][0]), "+v"(acc[ai][0][m][1]), "+v"(acc[ai][1][m][0]), "+v"(acc[ai][1][m][1]));
                if (m & 1) asm volatile("" ::: "memory"); }
        const bool bad1 = bad;
        bad = st2.run(acc, u, wr, wc, fr, fq, lds, wid, lane) || bad;
#pragma unroll
        for (int ai = 0; ai < 2; ++ai)
#pragma unroll
            for (int m = 0; m < 4; ++m) { const int r = ai * HALF + wr * 64 + m * 16 + fr; const f32x2v sr = S[r]; const size_t off = (size_t)(u.pm * BM + r) * ldc + col0;
#pragma unroll
                for (int bj = 0; bj < 2; ++bj)
#pragma unroll
                    for (int n = 0; n < 2; ++n) { const f32x4 x1 = acc[ai][bj][m][n]; *(f32x4*)(out + off + bj * HALF + n * 16) = bad1 ? (f32x4){qnan, qnan, qnan, qnan} : x1;
                        const f32x4 o = (x1 - sr.x) * sr.y; u32x2v w; w.x = cvt_pk_bf16(o[0], o[1]); w.y = cvt_pk_bf16(o[2], o[3]);
                        if (bad) { w.x = 0x7fc07fc0u; w.y = 0x7fc07fc0u; } *(u32x2v*)(xn + off + bj * HALF + n * 16) = w; }
                asm volatile("" ::: "memory"); }
    }
};

template <class Epi, class Sched, bool ALIGN_EPI = false, bool SP2 = false>
__device__ __forceinline__ void gemm_phase(PG8_LAS unsigned char* lds, const Gemm g, const Sched& S, const Epi& E) {
    const int tid = opaque_tid(), wid = __builtin_amdgcn_readfirstlane(tid >> 6), lane = tid & 63, wr = wid >> 2, wc = wid & 3, fr = lane & 15, fq = lane >> 4;
    const int K = g.K, nt = K / BK;
    unsigned voffA[2], voffB[2];
#pragma unroll
    for (int i = 0; i < 2; ++i) { int R, C; stage_rc(tid * 16 + i * 8192, R, C); const int Rb = Epi::PERM ? ((R & ~31) + perm32(R & 31)) : R;
        voffA[i] = (unsigned)(R * g.lda + C) * 2u; voffB[i] = (unsigned)(Rb * K + C) * 2u; }
    const size_t kstep = (size_t)(BK * 2);
    const size_t hstep = (size_t)HALF * K * 2;
    const size_t tstep = 2 * hstep;
    const size_t hstepA = (size_t)HALF * g.lda * 2, tstepA = 2 * hstepA;
    const unsigned ldsw = (unsigned)wid * 1024u;
    const int aoff = lds_byte(wr * 64 + fr, fq * 8), boff = lds_byte(wc * 32 + fr, fq * 8);
#define PG8_SA(b, h) (((b) * 2 + (h)) * HTB)
#define PG8_SB(b, h) ((4 + (b) * 2 + (h)) * HTB)
#define PG8_STAGE(bufoff, gbase, voff) do { _Pragma("unroll") for (int _i = 0; _i < 2; ++_i) \
        __builtin_amdgcn_global_load_lds((const unsigned*)((const char*)(gbase) + (voff)[_i]), (PG8_LAS unsigned*)(lds + (bufoff) + ldsw + _i * 8192), 16, 0, 0); } while (0)
#define PG8_LDA(dst, b, h) do { _Pragma("unroll") for (int m = 0; m < 4; ++m) _Pragma("unroll") for (int k = 0; k < 2; ++k) dst[m][k] = *(const PG8_LAS bf16x8*)(lds + PG8_SA(b, h) + aoff + m * 2048 + k * 1024); } while (0)
#define PG8_LDB(dst, b, h) do { _Pragma("unroll") for (int n = 0; n < 2; ++n) _Pragma("unroll") for (int k = 0; k < 2; ++k) dst[n][k] = *(const PG8_LAS bf16x8*)(lds + PG8_SB(b, h) + boff + n * 2048 + k * 1024); } while (0)
#define PG8_MMA(ai, bj, At, Bt) do { __builtin_amdgcn_s_setprio(1); _Pragma("unroll") for (int m = 0; m < 4; ++m) _Pragma("unroll") for (int n = 0; n < 2; ++n) _Pragma("unroll") for (int k = 0; k < 2; ++k) \
        acc[ai][bj][m][n] = __builtin_amdgcn_mfma_f32_16x16x32_bf16(Bt[n][k], At[m][k], acc[ai][bj][m][n], 0, 0, 0); __builtin_amdgcn_s_setprio(0); } while (0)
#define PG8_WAIT_V(n) asm volatile("s_waitcnt vmcnt(" #n ")" ::: "memory")
#define PG8_WAIT_L(n) asm volatile("s_waitcnt lgkmcnt(" #n ")" ::: "memory")
#define PG8_BAR __builtin_amdgcn_s_barrier()
#define PG8_SCHED __builtin_amdgcn_sched_barrier(0)
    Unit cur, nxt; int ui = 0;
    if (!S.next(0, cur)) return;
    f32x4 acc[2][2][4][2];
#pragma unroll
    for (int a = 0; a < 2; ++a)
#pragma unroll
        for (int b = 0; b < 2; ++b)
#pragma unroll
            for (int m = 0; m < 4; ++m)
#pragma unroll
                for (int n = 0; n < 2; ++n) acc[a][b][m][n] = (f32x4){0.f, 0.f, 0.f, 0.f};
    bf16x8 At[4][2], B0[2][2], B1[2][2];
    const char* cA = (const char*)g.A + (size_t)cur.pm * tstepA; const char* cB = (const char*)g.Bt + (size_t)cur.pn * tstep;
    S.a_ready(cur);
    if constexpr (SP2) {
        PG8_STAGE(PG8_SB(0, 0), cB, voffB); PG8_STAGE(PG8_SB(0, 1), cB + hstep, voffB); PG8_STAGE(PG8_SA(0, 0), cA, voffA); PG8_STAGE(PG8_SA(0, 1), cA + hstepA, voffA);
        if (wr == 1) PG8_BAR;
        PG8_WAIT_V(2); PG8_BAR;
        PG8_STAGE(PG8_SB(1, 0), cB + kstep, voffB); PG8_STAGE(PG8_SA(1, 0), cA + kstep, voffA); PG8_STAGE(PG8_SB(1, 1), cB + hstep + kstep, voffB);
        PG8_WAIT_V(6); PG8_BAR;
    } else {
        PG8_STAGE(PG8_SB(0, 0), cB, voffB); PG8_STAGE(PG8_SA(0, 0), cA, voffA); PG8_STAGE(PG8_SB(0, 1), cB + hstep, voffB); PG8_STAGE(PG8_SA(0, 1), cA + hstepA, voffA);
        if (wr == 1) PG8_BAR;
        PG8_WAIT_V(4); PG8_BAR;
        PG8_STAGE(PG8_SB(1, 0), cB + kstep, voffB); PG8_STAGE(PG8_SA(1, 0), cA + kstep, voffA); PG8_STAGE(PG8_SB(1, 1), cB + hstep + kstep, voffB);
        PG8_WAIT_V(6); PG8_BAR;
    }
    for (;;) {
        const bool has_next = S.next(ui + 1, nxt);
        const char* nA = has_next ? (const char*)g.A + (size_t)nxt.pm * tstepA : cA; const char* nB = has_next ? (const char*)g.Bt + (size_t)nxt.pn * tstep : cB;
        for (int t = 0; t < nt; t += 2) {
            const bool last = (t == nt - 2);
            const char* a1 = cA + (size_t)(t + 1) * kstep;
            const char* a2 = last ? nA : cA + (size_t)(t + 2) * kstep; const char* b2 = last ? nB : cB + (size_t)(t + 2) * kstep;
            const char* a3 = a2 + kstep; const char* b3 = b2 + kstep;
            if (last && has_next) S.a_ready(nxt);
            if constexpr (SP2) {
            PG8_LDB(B0, 0, 0); PG8_LDB(B1, 0, 1); PG8_SCHED; PG8_LDA(At, 0, 0); PG8_STAGE(PG8_SA(1, 1), a1 + hstepA, voffA);
            PG8_WAIT_V(8); PG8_WAIT_L(0); PG8_BAR; PG8_MMA(0, 0, At, B0); PG8_MMA(0, 1, At, B1); PG8_BAR; PG8_SCHED;
            PG8_LDA(At, 0, 1); PG8_STAGE(PG8_SB(0, 0), b2, voffB); PG8_STAGE(PG8_SB(0, 1), b2 + hstep, voffB); PG8_STAGE(PG8_SA(0, 0), a2, voffA);
            PG8_WAIT_V(8); PG8_WAIT_L(0); PG8_BAR; PG8_MMA(1, 0, At, B0); PG8_MMA(1, 1, At, B1); PG8_BAR; PG8_SCHED;
            PG8_LDB(B0, 1, 0); PG8_LDB(B1, 1, 1); PG8_SCHED; PG8_LDA(At, 1, 0); PG8_STAGE(PG8_SA(0, 1), a2 + hstepA, voffA);
            PG8_WAIT_V(8); PG8_WAIT_L(0); PG8_BAR; PG8_MMA(0, 0, At, B0); PG8_MMA(0, 1, At, B1); PG8_BAR; PG8_SCHED;
            PG8_LDA(At, 1, 1); PG8_STAGE(PG8_SB(1, 0), b3, voffB); PG8_STAGE(PG8_SB(1, 1), b3 + hstep, voffB); PG8_STAGE(PG8_SA(1, 0), a3, voffA);
            PG8_WAIT_V(8); PG8_WAIT_L(0); PG8_BAR; PG8_MMA(1, 0, At, B0); PG8_MMA(1, 1, At, B1); PG8_BAR; PG8_SCHED;
            } else {
            PG8_LDB(B0, 0, 0); PG8_SCHED; PG8_LDA(At, 0, 0); PG8_STAGE(PG8_SA(1, 1), a1 + hstepA, voffA);
            PG8_WAIT_L(8); PG8_BAR; PG8_WAIT_L(0); PG8_MMA(0, 0, At, B0); PG8_BAR; PG8_SCHED;
            PG8_LDB(B1, 0, 1); PG8_STAGE(PG8_SB(0, 0), b2, voffB);
            PG8_BAR; PG8_WAIT_L(0); PG8_MMA(0, 1, At, B1); PG8_BAR;
            PG8_LDA(At, 0, 1); PG8_STAGE(PG8_SA(0, 0), a2, voffA);
            PG8_BAR; PG8_WAIT_L(0); PG8_MMA(1, 0, At, B0); PG8_BAR; PG8_SCHED;
            PG8_STAGE(PG8_SB(0, 1), b2 + hstep, voffB);
            PG8_WAIT_V(6); PG8_BAR; PG8_MMA(1, 1, At, B1); PG8_BAR;
            PG8_LDB(B0, 1, 0); PG8_SCHED; PG8_LDA(At, 1, 0); PG8_STAGE(PG8_SA(0, 1), a2 + hstepA, voffA);
            PG8_WAIT_L(8); PG8_BAR; PG8_WAIT_L(0); PG8_MMA(0, 0, At, B0); PG8_BAR; PG8_SCHED;
            PG8_LDB(B1, 1, 1); PG8_STAGE(PG8_SB(1, 0), b3, voffB);
            PG8_BAR; PG8_WAIT_L(0); PG8_MMA(0, 1, At, B1); PG8_BAR;
            PG8_LDA(At, 1, 1); PG8_STAGE(PG8_SA(1, 0), a3, voffA);
            PG8_BAR; PG8_WAIT_L(0); PG8_MMA(1, 0, At, B0); PG8_BAR; PG8_SCHED;
            PG8_STAGE(PG8_SB(1, 1), b3 + hstep, voffB);
            PG8_WAIT_V(6); PG8_BAR; PG8_MMA(1, 1, At, B1); PG8_BAR;
            }
        }
        if constexpr (ALIGN_EPI) { if (wr == 0) PG8_BAR; }
        if constexpr (!Epi::AFTER_DRAIN) { E(acc, cur, wr, wc, fr, fq); S.done(cur); }
        if (!has_next) break;
#pragma unroll
        for (int a = 0; a < 2; ++a)
#pragma unroll
            for (int b = 0; b < 2; ++b)
#pragma unroll
                for (int m = 0; m < 4; ++m)
#pragma unroll
                    for (int n = 0; n < 2; ++n) acc[a][b][m][n] = (f32x4){0.f, 0.f, 0.f, 0.f};
        cur = nxt; cA = nA; cB = nB; ++ui;
        if constexpr (ALIGN_EPI) { if (wr == 1) PG8_BAR; }
    }
    PG8_WAIT_V(0);
    if constexpr (!ALIGN_EPI) { if (wr == 0) PG8_BAR; }
    PG8_BAR;
    if constexpr (Epi::AFTER_DRAIN) { E.fused(acc, cur, wr, wc, fr, fq, lds, wid, lane); S.done(cur); }
#undef PG8_SA
#undef PG8_SB
#undef PG8_STAGE
#undef PG8_LDA
#undef PG8_LDB
#undef PG8_MMA
#undef PG8_WAIT_V
#undef PG8_WAIT_L
#undef PG8_BAR
#undef PG8_SCHED
}
}

namespace att {
using bf16 = __hip_bfloat16;
constexpr int D = 128, NW = 8, QBLK = 32, KVBLK = 64;
constexpr float SCALE = 0.088388347648318440f;
constexpr float THR = 8.f;
constexpr int SDEPTH = 2;
constexpr size_t SHM_V = KVBLK * D * 2, SHM_K = KVBLK * D * 2, SHM_ATTN = 2 * SHM_V + 2 * SHM_K + NW * 64 * 4;
using bf16x8 = __attribute__((ext_vector_type(8))) short;
using s16x4  = __attribute__((ext_vector_type(4))) short;
using f32x16 = __attribute__((ext_vector_type(16))) float;
using f32x8  = __attribute__((ext_vector_type(8))) float;
using u32x4  = __attribute__((ext_vector_type(4))) unsigned;
#define KSWZ(row, colB) ((row) * 256 + ((colB) ^ (((row) & 7) << 4)))
#define SBAR() __builtin_amdgcn_sched_barrier(0)
__device__ __forceinline__ int crow(int r, int hi) { return (r & 3) + 8 * (r >> 2) + 4 * hi; }
__device__ __forceinline__ unsigned cvtpk(float lo, float hi) {
  unsigned r; asm volatile("v_cvt_pk_bf16_f32 %0, %1, %2" : "=v"(r) : "v"(lo), "v"(hi)); return r;
}
template <typename TIn> struct Stage;
template <> struct Stage<bf16>  { using T = bf16x8;
  __device__ static __forceinline__ T ld8(const bf16* p) { return *reinterpret_cast<const bf16x8*>(p); }
  __device__ static __forceinline__ bf16x8 tobf(T x) { return x; } };
template <> struct Stage<float> { using T = f32x8;
  __device__ static __forceinline__ T ld8(const float* p) { return *reinterpret_cast<const f32x8*>(p); }
  __device__ static __forceinline__ bf16x8 tobf(T x) {
    u32x4 w = {cvtpk(x[0], x[1]), cvtpk(x[2], x[3]), cvtpk(x[4], x[5]), cvtpk(x[6], x[7])}; return *reinterpret_cast<bf16x8*>(&w); } };

__device__ __forceinline__ void partialSM(f32x16& p0, f32x16& p1, float& m_reg, float& mn, float& alpha) {
  constexpr float C = SCALE * 1.4426950408889634f;
  float pmax = p0[0]; for (int r = 1; r < 16; ++r) pmax = fmaxf(pmax, p0[r]); for (int r = 0; r < 16; ++r) pmax = fmaxf(pmax, p1[r]);
  { auto rr = __builtin_amdgcn_permlane32_swap(__float_as_uint(pmax), __float_as_uint(pmax), false, false);
    pmax = fmaxf(__uint_as_float(rr[0]), __uint_as_float(rr[1])); }
  if (__builtin_expect(__all(pmax - m_reg <= THR / SCALE), 1)) { mn = m_reg; alpha = 1.f; }
  else { mn = fmaxf(m_reg, pmax); alpha = __builtin_amdgcn_exp2f((m_reg - mn) * C); m_reg = mn; }
  float mnC = -mn * C;
  for (int r = 0; r < 16; ++r) p0[r] = fmaf(p0[r], C, mnC); for (int r = 0; r < 16; ++r) p1[r] = fmaf(p1[r], C, mnC);
  for (int r = 0; r < 16; ++r) p0[r] = __builtin_amdgcn_exp2f(p0[r]);
}
__device__ __forceinline__ void finishSM(f32x16& p0, f32x16& p1, float alpha, float& l_reg, bf16x8& pa0, bf16x8& pa1, bf16x8& pa2, bf16x8& pa3) {
  for (int r = 0; r < 16; ++r) p1[r] = __builtin_amdgcn_exp2f(p1[r]);
  float ps = 0; for (int r = 0; r < 16; ++r) ps += p0[r]; for (int r = 0; r < 16; ++r) ps += p1[r];
  { auto rr = __builtin_amdgcn_permlane32_swap(__float_as_uint(ps), __float_as_uint(ps), false, false);
    ps = __uint_as_float(rr[0]) + __uint_as_float(rr[1]); }
  l_reg = l_reg * alpha + ps;
#define PK4(P, BASE, OUT) do { unsigned a0 = cvtpk(P[BASE + 0], P[BASE + 1]), a1 = cvtpk(P[BASE + 2], P[BASE + 3]);   \
    unsigned b0 = cvtpk(P[BASE + 4], P[BASE + 5]), b1 = cvtpk(P[BASE + 6], P[BASE + 7]);                              \
    auto r0 = __builtin_amdgcn_permlane32_swap(a0, b0, false, false); auto r1 = __builtin_amdgcn_permlane32_swap(a1, b1, false, false); \
    u32x4 w = {r0[0], r1[0], r0[1], r1[1]}; OUT = *reinterpret_cast<bf16x8*>(&w); } while (0)
  PK4(p0, 0, pa0); PK4(p0, 8, pa1); PK4(p1, 0, pa2); PK4(p1, 8, pa3);
#undef PK4
}
__device__ __forceinline__ void qkt(f32x16& p0, f32x16& p1, const bf16* Ks, const bf16x8* qr, int r32, int hi) {
  p0 = f32x16{}; p1 = f32x16{};
  for (int d0 = 0; d0 < 8; ++d0) { int cb = (d0 * 16 + hi * 8) * 2;
    bf16x8 b0 = *reinterpret_cast<const bf16x8*>((const char*)Ks + KSWZ(r32, cb));
    bf16x8 b1 = *reinterpret_cast<const bf16x8*>((const char*)Ks + KSWZ(32 + r32, cb));
    p0 = __builtin_amdgcn_mfma_f32_32x32x16_bf16(b0, qr[d0], p0, 0, 0, 0);
    p1 = __builtin_amdgcn_mfma_f32_32x32x16_bf16(b1, qr[d0], p1, 0, 0, 0); }
}
__device__ __forceinline__ int v_st(int k, int c) { const int kk = (k & ~0xC) | ((k & 4) << 1) | ((k & 8) >> 1); return ((kk >> 3) * 4 + (c >> 5)) * 512 + ((kk & 7) * 32 + (c & 31)) * 2; }
__device__ __forceinline__ int v_rd_base(int lane) { return ((lane & 3) << 3) | (((lane >> 2) & 3) << 6) | (((lane >> 4) & 1) << 5) | (((lane >> 5) & 1) << 8); }
constexpr int v_rd_off(int d0, int ks, int half) { return d0 * 512 + ks * 4096 + half * 2048; }
template <int OFF> __device__ __forceinline__ s16x4 tr_read(int vb) {
  s16x4 r; asm volatile("ds_read_b64_tr_b16 %0, %1 offset:%2" : "=&v"(r) : "v"(vb), "i"(OFF) : "memory"); return r;
}
template <int D0> __device__ __forceinline__ void pv_one(f32x16& od, int vb, bf16x8 pa0, bf16x8 pa1, bf16x8 pa2, bf16x8 pa3) {
  const s16x4 l0 = tr_read<v_rd_off(D0, 0, 0)>(vb), h0 = tr_read<v_rd_off(D0, 0, 1)>(vb), l1 = tr_read<v_rd_off(D0, 1, 0)>(vb), h1 = tr_read<v_rd_off(D0, 1, 1)>(vb);
  const s16x4 l2 = tr_read<v_rd_off(D0, 2, 0)>(vb), h2 = tr_read<v_rd_off(D0, 2, 1)>(vb), l3 = tr_read<v_rd_off(D0, 3, 0)>(vb), h3 = tr_read<v_rd_off(D0, 3, 1)>(vb);
  asm volatile("s_waitcnt lgkmcnt(0)" ::: "memory"); SBAR();
#define PK(L, H) (bf16x8){L[0], L[1], L[2], L[3], H[0], H[1], H[2], H[3]}
  od = __builtin_amdgcn_mfma_f32_32x32x16_bf16(pa0, PK(l0, h0), od, 0, 0, 0);
  od = __builtin_amdgcn_mfma_f32_32x32x16_bf16(pa1, PK(l1, h1), od, 0, 0, 0);
  od = __builtin_amdgcn_mfma_f32_32x32x16_bf16(pa2, PK(l2, h2), od, 0, 0, 0);
  od = __builtin_amdgcn_mfma_f32_32x32x16_bf16(pa3, PK(l3, h3), od, 0, 0, 0);
#undef PK
}
__device__ __forceinline__ void pv_d0(f32x16* o, int vb, bf16x8 pa0, bf16x8 pa1, bf16x8 pa2, bf16x8 pa3) {
  pv_one<0>(o[0], vb, pa0, pa1, pa2, pa3); pv_one<1>(o[1], vb, pa0, pa1, pa2, pa3); pv_one<2>(o[2], vb, pa0, pa1, pa2, pa3); pv_one<3>(o[3], vb, pa0, pa1, pa2, pa3);
}

template <typename TQ, int LDQ, int LDK, int LDO>
__device__ __forceinline__ void attn_dense_body(const TQ* __restrict__ Qb, const bf16* __restrict__ Kh, const bf16* __restrict__ Vh,
                                                unsigned short* __restrict__ Ob, int seq, char* lds) {
  using St = Stage<bf16>; using SQ = Stage<TQ>;
  const int tid = opaque_tid(), wid = tid >> 6, lane = tid & 63, r32 = lane & 31, hi = lane >> 5;
  bf16* V_lds = (bf16*)lds; bf16* K_lds = (bf16*)(lds + 2 * SHM_V);
  float* ws = (float*)(lds + 2 * SHM_V + 2 * SHM_K) + wid * 64; float* li_l = ws; float* al_l = ws + 32;
  float m_reg = -1e30f, l_reg = 0; f32x16 o[4] = {}; bf16x8 qr[8];
  const TQ* Qw = Qb + (long)(wid * QBLK + r32) * LDQ + hi * 8;
#pragma unroll
  for (int d0 = 0; d0 < 8; ++d0) qr[d0] = SQ::tobf(SQ::ld8(Qw + d0 * 16));
  const int sr = tid >> 4, sc = (tid & 15) * 8, vst0 = v_st(sr, sc), vst1 = v_st(32 + sr, sc);
  const int vb0 = (int)(uintptr_t)V_lds + v_rd_base(lane);
  struct { typename St::T vs0, vs1, ks0, ks1; } sr_[SDEPTH];
#define SLOAD(i, k0) do { sr_[i].vs0 = St::ld8(&Vh[(long)((k0) + sr) * LDK + sc]); sr_[i].vs1 = St::ld8(&Vh[(long)((k0) + 32 + sr) * LDK + sc]); \
    sr_[i].ks0 = St::ld8(&Kh[(long)((k0) + sr) * LDK + sc]); sr_[i].ks1 = St::ld8(&Kh[(long)((k0) + 32 + sr) * LDK + sc]); } while (0)
#define SWRITE(b, i) do { *(bf16x8*)((char*)V_lds + (b) * SHM_V + vst0) = St::tobf(sr_[i].vs0);          \
    *(bf16x8*)((char*)V_lds + (b) * SHM_V + vst1) = St::tobf(sr_[i].vs1); int kc = sc * 2;               \
    *(bf16x8*)((char*)K_lds + (b) * SHM_K + KSWZ(sr, kc)) = St::tobf(sr_[i].ks0);                       \
    *(bf16x8*)((char*)K_lds + (b) * SHM_K + KSWZ(32 + sr, kc)) = St::tobf(sr_[i].ks1); } while (0)
#define SWAIT() do { if constexpr (SDEPTH == 2) asm volatile("s_waitcnt vmcnt(4)" ::: "memory"); else asm volatile("s_waitcnt vmcnt(0)" ::: "memory"); } while (0)
#define RESC(a) do { if (__any((a) < 1.f)) { if (hi == 0) al_l[r32] = (a); asm volatile("s_waitcnt lgkmcnt(0)" ::: "memory"); \
    for (int d = 0; d < 4; ++d) for (int r = 0; r < 16; ++r) o[d][r] *= al_l[crow(r, hi)]; } } while (0)
  f32x16 pA0, pA1, pB0, pB1; float mnA, mnB, alA, alB; bf16x8 pa0, pa1, pa2, pa3; const int NT = seq / KVBLK;
  constexpr int SE = 0, SO = SDEPTH - 1;
  SLOAD(SE, 0); asm volatile("s_waitcnt vmcnt(0)" ::: "memory"); SWRITE(0, SE); __syncthreads();
  qkt(pA0, pA1, K_lds, qr, r32, hi); partialSM(pA0, pA1, m_reg, mnA, alA);
  SLOAD(SO, KVBLK); if constexpr (SDEPTH == 2) { if (2 < NT) SLOAD(SE, 2 * KVBLK); }
  SWAIT(); SWRITE(1, SO); __syncthreads();
  for (int j = 1; j + 1 < NT; j += 2) {
    SBAR(); qkt(pB0, pB1, (bf16*)((char*)K_lds + SHM_K), qr, r32, hi);
    finishSM(pA0, pA1, alA, l_reg, pa0, pa1, pa2, pa3); SBAR();
    SLOAD(SO, (j + SDEPTH) * KVBLK); SBAR();
    pv_d0(o, vb0, pa0, pa1, pa2, pa3); partialSM(pB0, pB1, m_reg, mnB, alB);
    __syncthreads(); SWAIT(); SWRITE(0, SE);
    RESC(alB); __syncthreads();
    SBAR(); qkt(pA0, pA1, K_lds, qr, r32, hi);
    finishSM(pB0, pB1, alB, l_reg, pa0, pa1, pa2, pa3); SBAR();
    if (SDEPTH == 1 || j + 3 < NT) SLOAD(SE, (j + 1 + SDEPTH) * KVBLK); SBAR();
    pv_d0(o, vb0 + (int)SHM_V, pa0, pa1, pa2, pa3); partialSM(pA0, pA1, m_reg, mnA, alA);
    __syncthreads(); SWAIT(); SWRITE(1, SO);
    RESC(alA); __syncthreads();
  }
  SBAR(); qkt(pB0, pB1, (bf16*)((char*)K_lds + SHM_K), qr, r32, hi);
  finishSM(pA0, pA1, alA, l_reg, pa0, pa1, pa2, pa3); SBAR();
  pv_d0(o, vb0, pa0, pa1, pa2, pa3); partialSM(pB0, pB1, m_reg, mnB, alB);
  __syncthreads(); RESC(alB);
  finishSM(pB0, pB1, alB, l_reg, pa0, pa1, pa2, pa3); SBAR();
  pv_d0(o, vb0 + (int)SHM_V, pa0, pa1, pa2, pa3);
  if (hi == 0) li_l[r32] = l_reg; asm volatile("s_waitcnt lgkmcnt(0)" ::: "memory");
  float rli[16];
#pragma unroll
  for (int r = 0; r < 16; ++r) rli[r] = __builtin_amdgcn_rcpf(li_l[crow(r, hi)]);
  unsigned short* Ow = Ob + (long)(wid * QBLK) * LDO;
#pragma unroll
  for (int r = 0; r < 16; ++r) { int orow = crow(r, hi);
    for (int d0 = 0; d0 < 4; ++d0) Ow[(long)orow * LDO + d0 * 32 + r32] = (unsigned short)(cvtpk(o[d0][r] * rli[r], 0.f) & 0xffffu); }
#undef SLOAD
#undef SWRITE
#undef SWAIT
#undef RESC
}

}

typedef const __attribute__((address_space(4))) unsigned char* kargp_t;
__device__ __forceinline__ unsigned char* karg_ptr(int byte_off) {
    kargp_t p = (kargp_t)__builtin_amdgcn_kernarg_segment_ptr(); asm volatile("" : "+s"(p));
    return *(unsigned char* const __attribute__((address_space(4)))*)(p + byte_off);
}
#define IN(k) ((const float*)karg_ptr(8 * (k)))
#define WS() (karg_ptr(168))
#define P_xlat ((float*)karg_ptr(160))
#define P_MOD ((float*)(WS() + WS_MOD))
#define P_xctx ((float*)(WS() + WS_XCTX))
#define P_GB ((float*)(WS() + WS_GB))
#define P_Wb ((bf16_t*)(WS() + WS_W))
#define P_BIG1 ((bf16_t*)(WS() + WS_BIG1))
#define P_BIG2 ((bf16_t*)(WS() + WS_BIG2))
#define MODL (P_MOD + (size_t)L * 17 * NMODC)
#define P_QKV ((bf16_t*)(WS() + WS_BIG1 + B1_QKV))
#define P_KB ((bf16_t*)(WS() + WS_BIG1 + B1_KB))
#define P_VB ((bf16_t*)(WS() + WS_BIG1 + B1_VB))
#define P_AO ((bf16_t*)(WS() + WS_BIG1 + B1_AO))

#define LAS __attribute__((address_space(3)))
typedef unsigned short bf16_t;
typedef short bf16x8 __attribute__((ext_vector_type(8)));
typedef float f32x4 __attribute__((ext_vector_type(4)));
typedef float f32x16 __attribute__((ext_vector_type(16)));
typedef unsigned u32x4 __attribute__((ext_vector_type(4)));
typedef unsigned u32x2 __attribute__((ext_vector_type(2)));

constexpr int DM = 1024, NB = 16, SEQ = 2048, CTXL = 256, NLAT = NB * SEQ, NCTX = NB * CTXL, MROWS = NLAT + NCTX;
constexpr int DFF = 2816, NMODC = 6 * DM, GIN1 = 4352, KVLEN = CTXL + SEQ;
constexpr float ALPHA = 1.6817928305074290f;
constexpr float EPS = 1e-6f;
constexpr int NTHR = 512, NWAVE = 8;

constexpr size_t WS_BAR  = 0, WS_BAR_BYTES = 16384;
constexpr size_t WS_MOD  = WS_BAR_BYTES;
constexpr size_t WS_XCTX = WS_MOD + (size_t)4 * 17 * NMODC * 4;
constexpr size_t WS_GB   = WS_XCTX + (size_t)NCTX * DM * 4;
constexpr size_t WS_W    = WS_GB + (size_t)MROWS * 64 * 4;
constexpr size_t W_A = 0, W_Z = W_A + (size_t)GIN1 * 1024, W_O = W_Z + (size_t)2048 * 1024, W_F1 = W_O + (size_t)2048 * 1024, W_F2 = W_F1 + (size_t)5632 * 1024, W_END = W_F2 + (size_t)1024 * DFF;
constexpr size_t WS_BIG1 = WS_W + W_END * 2;
constexpr size_t WS_BIG2 = WS_BIG1 + (size_t)MROWS * 4096 * 2;
constexpr size_t WS_END  = WS_BIG2 + (size_t)MROWS * 2048 * 2;
constexpr size_t B1_QKV = 0, B1_KB = (size_t)MROWS * 1536 * 2, B1_VB = B1_KB + (size_t)NB * 2 * KVLEN * 128 * 2, B1_AO = B1_VB + (size_t)NB * 2 * KVLEN * 128 * 2;

constexpr int LDS_BYTES = 161792, LDS_XB = 155008, LDS_S2 = 155648;

typedef float f32x2_t __attribute__((ext_vector_type(2))); typedef __bf16 bf16x2_t __attribute__((ext_vector_type(2)));
__device__ __forceinline__ unsigned cvtpk2(float lo, float hi) { f32x2_t v = {lo, hi}; bf16x2_t b = __builtin_convertvector(v, bf16x2_t); return __builtin_bit_cast(unsigned, b); }
__device__ __forceinline__ float bflo(unsigned u) { return __uint_as_float(u << 16); }
__device__ __forceinline__ float bfhi(unsigned u) { return __uint_as_float(u & 0xffff0000u); }
__device__ __forceinline__ float silu_f(float v) { return v * __builtin_amdgcn_rcpf(1.f + __builtin_amdgcn_exp2f(v * -1.4426950408889634f)); }
template <int X> __device__ __forceinline__ float swzx(float v) { return __uint_as_float((unsigned)__builtin_amdgcn_ds_swizzle((int)__float_as_uint(v), (X << 10) | 0x1f)); }
__device__ __forceinline__ float wave_sum(float v) {
    v += swzx<1>(v); v += swzx<2>(v); v += swzx<4>(v); v += swzx<8>(v); v += swzx<16>(v);
    auto rr = __builtin_amdgcn_permlane32_swap(__float_as_uint(v), __float_as_uint(v), false, false);
    return __uint_as_float(rr[0]) + __uint_as_float(rr[1]);
}
__device__ __forceinline__ int crow(int r, int hi) { return (r & 3) + 8 * (r >> 2) + 4 * hi; }

struct EpiPlainBf16 {
    static constexpr bool PERM = true, AFTER_DRAIN = false;
    bf16_t* O; int ldc;
    __device__ __forceinline__ void operator()(const pg8::f32x4 (&acc)[2][2][4][2], const pg8::Unit& u, int wr, int wc, int fr, int fq) const {
        const int row0 = u.pm * 256 + wr * 64 + fr, col0 = u.pn * 256 + wc * 32 + fq * 8;
#pragma unroll
        for (int ai = 0; ai < 2; ++ai)
#pragma unroll
            for (int m = 0; m < 4; ++m) { bf16_t* rp = O + (size_t)(row0 + ai * 128 + m * 16) * ldc + col0;
#pragma unroll
                for (int bj = 0; bj < 2; ++bj) { const pg8::f32x4 v0 = acc[ai][bj][m][0], v1 = acc[ai][bj][m][1];
                    *(u32x4*)(rp + bj * 128) = (u32x4){cvtpk2(v0[0], v0[1]), cvtpk2(v0[2], v0[3]), cvtpk2(v1[0], v1[1]), cvtpk2(v1[2], v1[3])}; } }
    }
};
struct EpiGdnIn {
    static constexpr bool PERM = true, AFTER_DRAIN = false;
    bf16_t* P; float* GB; const float* a_log; const float* dt_bias;
    __device__ __forceinline__ void operator()(const pg8::f32x4 (&acc)[2][2][4][2], const pg8::Unit& u, int wr, int wc, int fr, int fq) const {
        const int row0 = u.pm * 256 + wr * 64 + fr;
        if (u.pn < 16) {
            const int col0 = u.pn * 256 + wc * 32 + fq * 8;
#pragma unroll
            for (int ai = 0; ai < 2; ++ai)
#pragma unroll
                for (int m = 0; m < 4; ++m) { bf16_t* rp = P + (size_t)(row0 + ai * 128 + m * 16) * 4096 + col0;
#pragma unroll
                    for (int bj = 0; bj < 2; ++bj) { const pg8::f32x4 v0 = acc[ai][bj][m][0], v1 = acc[ai][bj][m][1];
                        *(u32x4*)(rp + bj * 128) = (u32x4){cvtpk2(v0[0], v0[1]), cvtpk2(v0[2], v0[3]), cvtpk2(v1[0], v1[1]), cvtpk2(v1[2], v1[3])}; } }
        } else if (wc < 2) {
#pragma unroll
            for (int n = 0; n < 2; ++n) {
                const int col = wc * 32 + fq * 8 + n * 4;
                float al[4], db[4];
#pragma unroll
                for (int e = 0; e < 4; ++e) { const int idx = (col + e) & 31; al[e] = __expf(a_log[idx]); db[e] = dt_bias[idx]; }
#pragma unroll
                for (int ai = 0; ai < 2; ++ai)
#pragma unroll
                    for (int m = 0; m < 4; ++m) { const pg8::f32x4 v = acc[ai][0][m][n]; f32x4 o;
#pragma unroll
                        for (int e = 0; e < 4; ++e) {
                            if (col < 32) o[e] = 1.f / (1.f + __expf(-v[e]));
                            else { const float xx = v[e] + db[e]; const float sp = xx > 20.f ? xx : log1pf(__expf(xx)); o[e] = -al[e] * sp; } }
                        *(f32x4*)(GB + (size_t)(row0 + ai * 128 + m * 16) * 64 + col) = o; }
            }
        }
    }
};
struct EpiGateZ {
    static constexpr bool PERM = true, AFTER_DRAIN = false;
    bf16_t* Y;
    __device__ __forceinline__ void operator()(const pg8::f32x4 (&acc)[2][2][4][2], const pg8::Unit& u, int wr, int wc, int fr, int fq) const {
        asm volatile("" : "+v"(fr));
        const int row0 = u.pm * 256 + wr * 64 + fr, col0 = u.pn * 256 + wc * 32 + fq * 8;
#pragma unroll
        for (int ai = 0; ai < 2; ++ai) {
            u32x4 on[4][2];
#pragma unroll
            for (int m = 0; m < 4; ++m)
#pragma unroll
                for (int bj = 0; bj < 2; ++bj) on[m][bj] = *(const u32x4*)(Y + (size_t)(row0 + ai * 128 + m * 16) * 4096 + col0 + bj * 128);
#pragma unroll
            for (int m = 0; m < 4; ++m)
#pragma unroll
                for (int bj = 0; bj < 2; ++bj) { const pg8::f32x4 v0 = acc[ai][bj][m][0], v1 = acc[ai][bj][m][1]; const u32x4 o = on[m][bj];
                    *(u32x4*)(Y + (size_t)(row0 + ai * 128 + m * 16) * 4096 + col0 + bj * 128) =
                        (u32x4){cvtpk2(bflo(o.x) * silu_f(v0[0]), bfhi(o.x) * silu_f(v0[1])), cvtpk2(bflo(o.y) * silu_f(v0[2]), bfhi(o.y) * silu_f(v0[3])),
                                cvtpk2(bflo(o.z) * silu_f(v1[0]), bfhi(o.z) * silu_f(v1[1])), cvtpk2(bflo(o.w) * silu_f(v1[2]), bfhi(o.w) * silu_f(v1[3]))}; }
        }
    }
};
struct EpiResid {
    static constexpr bool PERM = true, AFTER_DRAIN = false;
    float* xlat; float* xctx; const float* gate; float alpha, gs;
    __device__ __forceinline__ void operator()(const pg8::f32x4 (&acc)[2][2][4][2], const pg8::Unit& u, int wr, int wc, int fr, int fq) const {
        asm volatile("" : "+v"(fr));
        const int pm = u.pm;
        float* xb = pm < 128 ? xlat + (size_t)pm * 256 * DM : xctx + (size_t)(pm - 128) * 256 * DM;
        const float* gp = gate + (size_t)(pm < 128 ? (pm >> 3) : 16) * NMODC;
        const int col0 = u.pn * 256 + wc * 32 + fq * 8, r0 = wr * 64 + fr;
#pragma unroll
        for (int bj = 0; bj < 2; ++bj) { const int col = col0 + bj * 128; const f32x4 g0 = *(const f32x4*)(gp + col) * gs, g1 = *(const f32x4*)(gp + col + 4) * gs;
#pragma unroll
            for (int ai = 0; ai < 2; ++ai) {
                f32x4 x0[4], x1[4];
#pragma unroll
                for (int m = 0; m < 4; ++m) { const float* p = xb + (size_t)(r0 + ai * 128 + m * 16) * DM + col; x0[m] = *(const f32x4*)p; x1[m] = *(const f32x4*)(p + 4); }
#pragma unroll
                for (int m = 0; m < 4; ++m) { float* p = xb + (size_t)(r0 + ai * 128 + m * 16) * DM + col; const pg8::f32x4 a0 = acc[ai][bj][m][0], a1 = acc[ai][bj][m][1]; f32x4 y0, y1;
#pragma unroll
                    for (int e = 0; e < 4; ++e) { y0[e] = x0[m][e] * alpha + g0[e] * a0[e]; y1[e] = x1[m][e] * alpha + g1[e] * a1[e]; }
                    *(f32x4*)p = y0; *(f32x4*)(p + 4) = y1; }
            }
        }
    }
};
struct EpiSwiglu {
    static constexpr bool PERM = true, AFTER_DRAIN = false;
    bf16_t* ACT;
    __device__ __forceinline__ void operator()(const pg8::f32x4 (&acc)[2][2][4][2], const pg8::Unit& u, int wr, int wc, int fr, int fq) const {
        const int row0 = u.pm * 256 + wr * 64 + fr, col0 = u.pn * 128 + wc * 32 + fq * 8;
#pragma unroll
        for (int ai = 0; ai < 2; ++ai)
#pragma unroll
            for (int m = 0; m < 4; ++m) { const pg8::f32x4 g0 = acc[ai][0][m][0], g1 = acc[ai][0][m][1], u0 = acc[ai][1][m][0], u1 = acc[ai][1][m][1];
                *(u32x4*)(ACT + (size_t)(row0 + ai * 128 + m * 16) * DFF + col0) = (u32x4){cvtpk2(silu_f(g0[0]) * u0[0], silu_f(g0[1]) * u0[1]), cvtpk2(silu_f(g0[2]) * u0[2], silu_f(g0[3]) * u0[3]),
                                                                                        cvtpk2(silu_f(g1[0]) * u1[0], silu_f(g1[1]) * u1[1]), cvtpk2(silu_f(g1[2]) * u1[2], silu_f(g1[3]) * u1[3])}; }
    }
};

__device__ __forceinline__ void phase_mod(const float* c, const float* c_ctx, const float* w_mod, const float* b_mod, float* MOD, LAS unsigned char* lds, int G, int bid) {
    const int tid = opaque_tid(), wave = tid >> 6, lane = tid & 63;
    LAS float* sc = (LAS float*)lds;
    LAS float* red = (LAS float*)(lds + 81920);
    if (bid < 384) {
        for (int idx = tid; idx < 17 * 1024; idx += NTHR) { const int row = idx >> 10, k = idx & 1023; const float v = row < 16 ? c[row * 1024 + k] : c_ctx[k]; sc[k * 20 + row] = v / (1.f + expf(-v)); }
    }
    __syncthreads();
    for (int item = bid; item < 384; item += G) {
        const int layer = item / 96, cgp = item % 96;
        const float* w = w_mod + (size_t)layer * 1024 * NMODC + cgp * 64 + lane;
        float acc[17];
#pragma unroll
        for (int r = 0; r < 17; ++r) acc[r] = 0.f;
        const int k0 = wave * 128;
        for (int kb = k0; kb < k0 + 128; kb += 16) {
            float wv[16];
#pragma unroll
            for (int q = 0; q < 16; ++q) wv[q] = w[(size_t)(kb + q) * NMODC];
#pragma unroll
            for (int q = 0; q < 16; ++q) {
#pragma unroll
                for (int r = 0; r < 17; ++r) acc[r] += sc[(kb + q) * 20 + r] * wv[q]; }
        }
#pragma unroll
        for (int r = 0; r < 17; ++r) red[(wave * 17 + r) * 64 + lane] = acc[r];
        __syncthreads();
        for (int idx = tid; idx < 17 * 64; idx += NTHR) { const int r = idx >> 6, l = idx & 63; float s = 0.f;
#pragma unroll
            for (int wv = 0; wv < 8; ++wv) s += red[(wv * 17 + r) * 64 + l];
            MOD[(size_t)(layer * 17 + r) * NMODC + cgp * 64 + l] = s + b_mod[layer * NMODC + cgp * 64 + l]; }
        __syncthreads();
    }
}

__device__ __forceinline__ int srcmap(int mode, int n, int off) {
    if (mode == 0) return n + off;
    if (mode == 1) return n < 4096 ? n : (n < 4160 ? n + 2048 : -1);
    return ((n >> 7) & 1) * DFF + ((n >> 8) << 7) + (n & 127);
}
__device__ __forceinline__ void transpose_item(const float* W, int Nsrc, bf16_t* WT, int K, int mode, int off, int nblk, LAS float* scr, int item, int lane) {
    const int kb = item / nblk, nb = item % nblk, k0 = 64 * kb, n0 = 32 * nb;
    const int sc = srcmap(mode, n0 + (lane & 31), off);
    float wv_[32];
#pragma unroll
    for (int i = 0; i < 32; ++i) { const int kk = 2 * i + (lane >> 5); wv_[i] = sc >= 0 ? W[(size_t)(k0 + kk) * Nsrc + sc] : 0.f; }
#pragma unroll
    for (int i = 0; i < 32; ++i) { const int kk = 2 * i + (lane >> 5); scr[kk * 33 + (lane & 31)] = wv_[i]; }
    asm volatile("s_waitcnt lgkmcnt(0)" ::: "memory");
    const int c = lane & 7;
#pragma unroll
    for (int j = 0; j < 4; ++j) { const int n = (lane >> 3) + 8 * j; const LAS float* s = scr + (8 * c) * 33 + n;
        u32x4 o; o.x = cvtpk2(s[0 * 33], s[1 * 33]); o.y = cvtpk2(s[2 * 33], s[3 * 33]); o.z = cvtpk2(s[4 * 33], s[5 * 33]); o.w = cvtpk2(s[6 * 33], s[7 * 33]);
        *(u32x4*)(WT + (size_t)(n0 + n) * K + k0 + 8 * c) = o; }
    asm volatile("s_waitcnt lgkmcnt(0)" ::: "memory");
}
struct ConvJob { const float* W; bf16_t* WT; int Nsrc, K, mode, off, nblk, nitems; };
__device__ __forceinline__ void phase_convert(int L, bf16_t* Wb, LAS unsigned char* lds, int G, int bid, int jobmask, int b0) {
    if (bid < b0) return;
    const int tid_ = opaque_tid(), lane = tid_ & 63, wave = __builtin_amdgcn_readfirstlane(tid_ >> 6), gw = (bid - b0) * NWAVE + wave, NGW = (G - b0) * NWAVE;
    LAS float* scr = (LAS float*)(lds + wave * 8448);
    const int j = L >> 1;
    ConvJob jb[5]; int nj = 0;
    if (!(L & 1)) {
        jb[0] = ConvJob{IN(10) + (size_t)j * 1024 * 6208, Wb + W_A, 6208, 1024, 1, 0, GIN1 / 32, (GIN1 / 32) * 16};
        jb[1] = ConvJob{IN(10) + (size_t)j * 1024 * 6208, Wb + W_Z, 6208, 1024, 0, 4096, 64, 64 * 16};
        jb[2] = ConvJob{IN(15) + (size_t)j * 2048 * 1024, Wb + W_O, 1024, 2048, 0, 0, 32, 32 * 32};
        nj = 3;
    } else {
        jb[0] = ConvJob{IN(16) + (size_t)j * 1024 * 1536, Wb + W_A, 1536, 1024, 0, 0, 48, 48 * 16};
        jb[1] = ConvJob{IN(19) + (size_t)j * 1024 * 1024, Wb + W_O, 1024, 1024, 0, 0, 32, 32 * 16};
        jb[2] = ConvJob{IN(19), Wb + W_O, 1024, 1024, 0, 0, 32, 0};
        nj = 3;
    }
    jb[3] = ConvJob{IN(8) + (size_t)L * 1024 * 5632, Wb + W_F1, 5632, 1024, 2, 0, 176, 176 * 16};
    jb[4] = ConvJob{IN(9) + (size_t)L * DFF * 1024, Wb + W_F2, 1024, DFF, 0, 0, 32, 32 * 44};
    (void)nj;
#pragma unroll
    for (int q = 0; q < 5; ++q) if (!((jobmask >> q) & 1)) jb[q].nitems = 0;
    const int total = jb[0].nitems + jb[1].nitems + jb[2].nitems + jb[3].nitems + jb[4].nitems;
    for (int it = gw; it < total; it += NGW) {
        int r = it;
#pragma unroll
        for (int q = 0; q < 5; ++q) {
            if (r >= 0 && r < jb[q].nitems) { transpose_item(jb[q].W, jb[q].Nsrc, jb[q].WT, jb[q].K, jb[q].mode, jb[q].off, jb[q].nblk, scr, r, lane); r = -1; }
            else if (r >= 0) r -= jb[q].nitems;
        }
    }
}

__device__ __forceinline__ void phase_prep(const float* src_lat, const float* src_ctx, float* xlat, float* xctx, bool write_x, const float* lng, const float* lnb,
                                           bf16_t* H, const float* shift, const float* scale, int nrows, int G, int bid) {
    const int tid_ = opaque_tid(), lane = tid_ & 63, gw = bid * NWAVE + __builtin_amdgcn_readfirstlane(tid_ >> 6), NGW = G * NWAVE;
    const int R = (nrows + NGW - 1) / NGW, rbeg = gw * R, rend = (rbeg + R < nrows) ? rbeg + R : nrows;
    f32x4 vn[4], g[4], bb[4], sh[4], scv[4];
#pragma unroll
    for (int j = 0; j < 4; ++j) { g[j] = (f32x4){1.f, 1.f, 1.f, 1.f}; bb[j] = (f32x4){0.f, 0.f, 0.f, 0.f}; sh[j] = bb[j]; scv[j] = bb[j]; vn[j] = bb[j]; }
    if (lng) {
#pragma unroll
        for (int j = 0; j < 4; ++j) { g[j] = *(const f32x4*)(lng + 4 * lane + 256 * j); bb[j] = *(const f32x4*)(lnb + 4 * lane + 256 * j); }
    }
    if (rbeg < rend) { const float* sp = rbeg < NLAT ? src_lat + (size_t)rbeg * DM : src_ctx + (size_t)(rbeg - NLAT) * DM;
#pragma unroll
        for (int j = 0; j < 4; ++j) vn[j] = *(const f32x4*)(sp + 4 * lane + 256 * j); }
    int curmod = -1;
    for (int row = rbeg; row < rend; ++row) {
        const bool islat = row < NLAT;
        f32x4 v[4];
#pragma unroll
        for (int j = 0; j < 4; ++j) v[j] = vn[j];
        if (row + 1 < rend) { const int rn = row + 1; const float* sp = rn < NLAT ? src_lat + (size_t)rn * DM : src_ctx + (size_t)(rn - NLAT) * DM;
#pragma unroll
            for (int j = 0; j < 4; ++j) vn[j] = *(const f32x4*)(sp + 4 * lane + 256 * j); }
        const int modrow = islat ? (row >> 11) : 16;
        if (H && modrow != curmod) { curmod = modrow; const size_t mo = (size_t)modrow * NMODC;
#pragma unroll
            for (int j = 0; j < 4; ++j) { sh[j] = *(const f32x4*)(shift + mo + 4 * lane + 256 * j); scv[j] = *(const f32x4*)(scale + mo + 4 * lane + 256 * j); } }
        if (lng) {
            float s = 0.f;
#pragma unroll
            for (int j = 0; j < 4; ++j) s += (v[j][0] + v[j][1]) + (v[j][2] + v[j][3]);
            const float mean = wave_sum(s) * (1.f / DM); float s2 = 0.f;
#pragma unroll
            for (int j = 0; j < 4; ++j) { v[j] = v[j] - mean; s2 += (v[j][0] * v[j][0] + v[j][1] * v[j][1]) + (v[j][2] * v[j][2] + v[j][3] * v[j][3]); }
            const float rstd = rsqrtf(wave_sum(s2) * (1.f / DM) + EPS);
#pragma unroll
            for (int j = 0; j < 4; ++j) v[j] = v[j] * rstd * g[j] + bb[j];
        }
        if (write_x) { float* xp = islat ? xlat + (size_t)row * DM : xctx + (size_t)(row - NLAT) * DM;
#pragma unroll
            for (int j = 0; j < 4; ++j) *(f32x4*)(xp + 4 * lane + 256 * j) = v[j]; }
        if (H) {
#pragma unroll
            for (int j = 0; j < 4; ++j) { const f32x4 h = v[j] * (scv[j] + 1.f) + sh[j]; u32x2 w; w.x = cvtpk2(h[0], h[1]); w.y = cvtpk2(h[2], h[3]); *(u32x2*)(H + (size_t)row * DM + 4 * lane + 256 * j) = w; } }
    }
}

__device__ __forceinline__ void phase_qkvpost(bf16_t* QKV, bf16_t* KB, bf16_t* VB, const float* qn, const float* kn, int G, int bid) {
    const int tid_ = opaque_tid(), lane = tid_ & 63, gw = bid * NWAVE + __builtin_amdgcn_readfirstlane(tid_ >> 6), NGW = G * NWAVE;
    const float L2T = 13.287712379549449f / 32.f;
    const int d0 = 2 * lane;
    const float f0 = exp2f(-(float)(d0 & 31) * L2T), f1 = exp2f(-(float)((d0 + 1) & 31) * L2T);
    const float qw0 = qn[d0], qw1 = qn[d0 + 1], kw0 = kn[d0], kw1 = kn[d0 + 1];
    unsigned rawn[12];
    if (gw < MROWS) {
#pragma unroll
        for (int head = 0; head < 12; ++head) rawn[head] = *(const unsigned*)(QKV + (size_t)gw * 1536 + d0 + head * 128);
    }
    for (int row = gw; row < MROWS; row += NGW) {
        const bool islat = row < NLAT;
        int b, pos; float c0 = 1.f, s0 = 0.f, c1 = 1.f, s1 = 0.f;
        unsigned rawc[12];
#pragma unroll
        for (int head = 0; head < 12; ++head) rawc[head] = rawn[head];
        if (row + NGW < MROWS) {
#pragma unroll
            for (int head = 0; head < 12; ++head) rawn[head] = *(const unsigned*)(QKV + (size_t)(row + NGW) * 1536 + d0 + head * 128);
        }
        if (islat) { b = row >> 11; const int t = row & 2047; pos = CTXL + t; const float p = (lane < 32) ? (float)(t >> 6) : (float)(t & 63); sincosf(p * f0, &s0, &c0); sincosf(p * f1, &s1, &c1); }
        else { const int r2 = row - NLAT; b = r2 >> 8; pos = r2 & 255; }
        bf16_t* base = QKV + (size_t)row * 1536 + d0;
        unsigned outv[12];
#pragma unroll
        for (int head = 0; head < 12; ++head) {
            const unsigned raw = rawc[head];
            float x0 = bflo(raw), x1 = bfhi(raw);
            if (head < 10) {
                const float ss = wave_sum(x0 * x0 + x1 * x1);
                const float rstd = rsqrtf(ss * (1.f / 128.f) + EPS);
                x0 *= rstd * (head < 8 ? qw0 : kw0); x1 *= rstd * (head < 8 ? qw1 : kw1);
                if (islat) {
                    float p0 = swzx<16>(x0), p1 = swzx<16>(x1);
                    if (!(lane & 16)) { p0 = -p0; p1 = -p1; }
                    x0 = x0 * c0 + p0 * s0; x1 = x1 * c1 + p1 * s1;
                }
            }
            outv[head] = cvtpk2(x0, x1);
        }
#pragma unroll
        for (int head = 0; head < 12; ++head) {
            if (head < 8) *(unsigned*)(base + head * 128) = outv[head];
            else { const int kvh = (head - 8) & 1; bf16_t* dst = (head < 10 ? KB : VB) + ((size_t)(b * 2 + kvh) * KVLEN + pos) * 128 + d0; *(unsigned*)dst = outv[head]; }
        }
    }
}


#ifndef GDN_TRIVIAL
#define GDN_TRIVIAL 0
#endif
namespace gdn {
#ifndef GDN_SB
#define GDN_SB 0
#endif
#if GDN_SB
#define SB_() __builtin_amdgcn_sched_barrier(0)
#else
#define SB_() do {} while (0)
#endif
constexpr int SQ = 272;
constexpr int SK = 144;
constexpr int OFF_Q = 0, OFF_K = 17408  , OFF_KT = 35840, OFF_VT = 54272  , OFF_T1 = 72704, OFF_T2 = 81920,
              OFF_A = 91136  , OFF_QK = 108544, OFF_ST = 117760, OFF_SM = 152576, GDN_LDS = 154624;
static_assert(GDN_LDS <= LDS_BYTES, "lds");
__device__ __forceinline__ bf16x8 ldf(const LAS unsigned char* p) { return *(const LAS bf16x8*)p; }
__device__ __forceinline__ f32x16 mfma(bf16x8 a, bf16x8 b, f32x16 c) { return __builtin_amdgcn_mfma_f32_32x32x16_bf16(a, b, c, 0, 0, 0); }
__device__ __forceinline__ unsigned short bf1(float v) { return (unsigned short)(cvtpk2(v, 0.f) & 0xffffu); }

__device__ __forceinline__ void conv_phase(const bf16_t* P, const float* __restrict__ convw, bf16_t* OUT, int which, int G, int bid) {
    const int tid = opaque_tid();
    const int gtid = bid * NTHR + tid, nthr = G * NTHR;
    const int cgc = gtid & 255, col = (which ? 2048 : 0) + cgc * 8;
    float cw[5][8];
#pragma unroll
    for (int j = 0; j < 5; ++j) { const f32x4 a = *(const f32x4*)(convw + j * 4096 + col), c = *(const f32x4*)(convw + j * 4096 + col + 4);
        cw[j][0] = a[0]; cw[j][1] = a[1]; cw[j][2] = a[2]; cw[j][3] = a[3]; cw[j][4] = c[0]; cw[j][5] = c[1]; cw[j][6] = c[2]; cw[j][7] = c[3]; }
    const float qs = (!which && col < 1024) ? 0.08838834764831845f : 1.f;
#define GDN_CONV_LOAD(dst, uu) do { const int r0_ = ((uu) >> 8) * 8; const bool il_ = r0_ < NLAT; const int t0_ = il_ ? (r0_ & 2047) : ((r0_ - NLAT) & 255); const int T_ = il_ ? SEQ : CTXL; \
        _Pragma("unroll") for (int rr = 0; rr < 12; ++rr) { const int t = t0_ - 2 + rr; dst[rr] = (t >= 0 && t < T_) ? *(const u32x4*)(P + (size_t)(r0_ - 2 + rr) * 4096 + col) : (u32x4){0u, 0u, 0u, 0u}; } } while (0)
    u32x4 raw[12], nxt[12];
    if (gtid < (MROWS / 8) * 256) GDN_CONV_LOAD(nxt, gtid);
    for (int u = gtid; u < (MROWS / 8) * 256; u += nthr) {
        const int row0 = (u >> 8) * 8;
#pragma unroll
        for (int rr = 0; rr < 12; ++rr) raw[rr] = nxt[rr];
        if (u + nthr < (MROWS / 8) * 256) GDN_CONV_LOAD(nxt, u + nthr);
#pragma unroll
        for (int tt = 0; tt < 8; ++tt) {
            float y[8];
#pragma unroll
            for (int e = 0; e < 8; ++e) y[e] = 0.f;
#pragma unroll
            for (int j = 0; j < 5; ++j) { const u32x4 rw = raw[tt + j];
                y[0] += bflo(rw.x) * cw[j][0]; y[1] += bfhi(rw.x) * cw[j][1]; y[2] += bflo(rw.y) * cw[j][2]; y[3] += bfhi(rw.y) * cw[j][3];
                y[4] += bflo(rw.z) * cw[j][4]; y[5] += bfhi(rw.z) * cw[j][5]; y[6] += bflo(rw.w) * cw[j][6]; y[7] += bfhi(rw.w) * cw[j][7]; }
            float ss = 0.f;
#pragma unroll
            for (int e = 0; e < 8; ++e) { y[e] = silu_f(y[e]); ss += y[e] * y[e]; }
            if (!which) {
                ss += swzx<1>(ss); ss += swzx<2>(ss); ss += swzx<4>(ss); ss += swzx<8>(ss);
                const float sc = rsqrtf(ss + EPS) * qs;
#pragma unroll
                for (int e = 0; e < 8; ++e) y[e] *= sc;
            }
            const u32x4 o = (u32x4){cvtpk2(y[0], y[1]), cvtpk2(y[2], y[3]), cvtpk2(y[4], y[5]), cvtpk2(y[6], y[7])};
            if (which) *(u32x4*)(OUT + (size_t)(row0 + tt) * 4096 + cgc * 8) = o; else *(u32x4*)(OUT + (size_t)(row0 + tt) * 2048 + cgc * 8) = o;
        }
    }
}

__device__ __forceinline__ void core(const bf16_t* QK, const bf16_t* PV, const float* __restrict__ GB, const float* __restrict__ norm_g,
                                     bf16_t* O, LAS unsigned char* lds, int G, int bid) {
    const int tid0 = opaque_tid(), wave = __builtin_amdgcn_readfirstlane(tid0 >> 6);
    LAS float* sm_gcum = (LAS float*)(lds + OFF_SM);
    LAS float* sm_beta = sm_gcum + 64;
    LAS float* sm_eg = sm_gcum + 128;
    LAS float* sm_e2 = sm_gcum + 192;
    LAS float* sm_egl = sm_gcum + 256;
    LAS float* Af = (LAS float*)(lds + OFF_A);
    const int ten = wave >> 1;
    const int ti = wave >> 2, tc = wave & 3, td = wave & 3;
    for (int item = bid; item < 256; item += G) {
        const int b = item >> 4, h = item & 15, hk = h >> 1;
        for (int dir = 0; dir < 2; ++dir) {
            f32x16 S0, S1;
#pragma unroll
            for (int r = 0; r < 16; ++r) { S0[r] = 0.f; S1[r] = 0.f; }
            __syncthreads();
            for (int q = tid0; q < 34816 / 16; q += NTHR) *(LAS u32x4*)(lds + OFF_ST + q * 16) = (u32x4){0u, 0u, 0u, 0u};
            __syncthreads();
            u32x4 pf[8];
#define GDN_PREFETCH(qq) do { if (wave < 6) { const int sq_ = (qq) >= 4, n_ = sq_ ? (qq) - 4 : (qq), T_ = sq_ ? SEQ : CTXL, rb_ = sq_ ? b * SEQ : NLAT + b * CTXL; \
        const int cc_ = dir ? T_ - 64 * (n_ + 1) : 64 * n_; const int pt_ = opaque_tid() & 127; \
        const bf16_t* sp_ = (ten == 2 ? PV + h * 128 : QK + ten * 1024 + hk * 128) + (ten ? (pt_ >> 3) : (pt_ & 15)) * 8; const size_t st_ = ten == 2 ? 4096 : 2048; \
        _Pragma("unroll") for (int tt_ = 0; tt_ < 8; ++tt_) pf[tt_] = *(const u32x4*)(sp_ + (size_t)(rb_ + cc_ + 8 * (ten ? (pt_ & 7) : (pt_ >> 4)) + tt_) * st_); } } while (0)
#pragma unroll
            for (int tt = 0; tt < 8; ++tt) pf[tt] = (u32x4){0u, 0u, 0u, 0u};
            GDN_PREFETCH(0);
            {
                for (int qc = 0; qc < 36; ++qc) {
                    const int seqi = qc >= 4, n = seqi ? qc - 4 : qc;
                    const int T = seqi ? SEQ : CTXL; const int rowbase = seqi ? b * SEQ : NLAT + b * CTXL;
                    const int c0 = dir ? T - 64 * (n + 1) : 64 * n;
                    int tid = tid0; asm volatile("" : "+v"(tid));
                    const int lane = tid & 63, l31 = lane & 31, hi = lane >> 5, idx = tid & 127, seg = ten ? (idx & 7) : (idx >> 4), cgp = ten ? (idx >> 3) : (idx & 15);
                    if (wave < 6) {
                        unsigned pk[8][4];
#pragma unroll
                        for (int tt = 0; tt < 8; ++tt) { pk[tt][0] = pf[tt].x; pk[tt][1] = pf[tt].y; pk[tt][2] = pf[tt].z; pk[tt][3] = pf[tt].w; }
                        if (ten < 2) {
                            LAS unsigned char* dst = lds + (ten == 0 ? OFF_Q : OFF_K) + cgp * 16;
#pragma unroll
                            for (int tt = 0; tt < 8; ++tt) { const int i = dir ? 63 - (8 * seg + tt) : 8 * seg + tt; *(LAS u32x4*)(dst + i * SQ) = (u32x4){pk[tt][0], pk[tt][1], pk[tt][2], pk[tt][3]}; }
                        }
                        if (ten >= 1) {
                            LAS unsigned char* dst = lds + (ten == 1 ? OFF_KT : OFF_VT) + (dir ? 56 - 8 * seg : 8 * seg) * 2;
#pragma unroll
                            for (int e = 0; e < 8; ++e) {
                                unsigned v[8];
#pragma unroll
                                for (int s = 0; s < 8; ++s) { const unsigned a = dir ? pk[7 - s][e >> 1] : pk[s][e >> 1]; v[s] = (e & 1) ? (a >> 16) : (a & 0xffffu); }
                                *(LAS u32x4*)(dst + (cgp * 8 + e) * SK) = (u32x4){v[0] | (v[1] << 16), v[2] | (v[3] << 16), v[4] | (v[5] << 16), v[6] | (v[7] << 16)};
                            }
                        }
                    } else if (wave == 6) {
                        const int t = dir ? c0 + 63 - lane : c0 + lane;
                        const float* gb = GB + (size_t)(rowbase + t) * 64;
                        const float beta = gb[dir * 16 + h]; const float g = gb[32 + dir * 16 + h];
                        float cs = g;
#pragma unroll
                        for (int off = 1; off < 64; off <<= 1) { const float v = __uint_as_float((unsigned)__builtin_amdgcn_ds_bpermute(((lane - off) & 63) << 2, (int)__float_as_uint(cs))); if (lane >= off) cs += v; }
                        const float glast = __uint_as_float((unsigned)__builtin_amdgcn_readlane((int)__float_as_uint(cs), 63));
                        sm_gcum[lane] = cs; sm_beta[lane] = beta; sm_eg[lane] = __expf(cs); sm_e2[lane] = __expf(glast - cs);
                        if (lane == 0) sm_egl[0] = __expf(glast);
                    }
                    __syncthreads();
                    if (qc + 1 < 36) GDN_PREFETCH(qc + 1);
                    if (wave < 2) __builtin_amdgcn_s_setprio(3);
                    if (wave < 4) {
                        if (wave < 2) {
                            const int bb = wave ? 32 : 0;
                            f32x16 acc;
#pragma unroll
                            for (int r = 0; r < 16; ++r) acc[r] = 0.f;
#pragma unroll
                            for (int kk = 0; kk < 8; ++kk) acc = mfma(ldf(lds + OFF_K + (bb + l31) * SQ + (16 * kk + 8 * hi) * 2), ldf(lds + OFF_K + (bb + l31) * SQ + (16 * kk + 8 * hi) * 2), acc);
                            const int j = bb + l31; const float gj = sm_gcum[j];
                            LAS float* Ab = (LAS float*)(lds + OFF_A + (wave ? 4608 : 0));
#pragma unroll
                            for (int r = 0; r < 16; ++r) { const int i = bb + crow(r, hi); const float val = (i > j) ? sm_beta[i] * acc[r] * __expf(sm_gcum[i] - gj) : 0.f; Ab[crow(r, hi) * 36 + l31] = val; }
                        } else if (wave == 2) {
                            f32x16 acc;
#pragma unroll
                            for (int r = 0; r < 16; ++r) acc[r] = 0.f;
#pragma unroll
                            for (int kk = 0; kk < 8; ++kk) acc = mfma(ldf(lds + OFF_K + l31 * SQ + (16 * kk + 8 * hi) * 2), ldf(lds + OFF_K + (32 + l31) * SQ + (16 * kk + 8 * hi) * 2), acc);
                            const int i = 32 + l31; const float gi = sm_gcum[i], bi = sm_beta[i];
#pragma unroll
                            for (int g4 = 0; g4 < 4; ++g4) { const int j0 = 8 * g4 + 4 * hi; float v[4];
#pragma unroll
                                for (int e = 0; e < 4; ++e) v[e] = bi * acc[4 * g4 + e] * __expf(gi - sm_gcum[j0 + e]);
                                *(LAS u32x2*)(lds + LDS_S2 + l31 * 64 + j0 * 2) = (u32x2){cvtpk2(v[0], v[1]), cvtpk2(v[2], v[3])}; }
                        }
                    } else {
                        const int w4 = wave - 4, aj = w4 >> 1, ai = w4 & 1;
                        f32x16 acc;
#pragma unroll
                        for (int r = 0; r < 16; ++r) acc[r] = 0.f;
                        if (!(aj == 1 && ai == 0)) {
#pragma unroll
                            for (int kk = 0; kk < 8; ++kk) acc = mfma(ldf(lds + OFF_K + (32 * aj + l31) * SQ + (16 * kk + 8 * hi) * 2), ldf(lds + OFF_Q + (32 * ai + l31) * SQ + (16 * kk + 8 * hi) * 2), acc);
                        }
                        const int i = 32 * ai + l31; const float gi = sm_gcum[i];
#pragma unroll
                        for (int g4 = 0; g4 < 4; ++g4) { const int j0 = 32 * aj + 8 * g4 + 4 * hi; float v[4];
#pragma unroll
                            for (int e = 0; e < 4; ++e) { const int j = j0 + e; v[e] = (i >= j) ? acc[4 * g4 + e] * __expf(gi - sm_gcum[j]) : 0.f; }
                            *(LAS u32x2*)(lds + OFF_QK + i * SK + j0 * 2) = (u32x2){cvtpk2(v[0], v[1]), cvtpk2(v[2], v[3])}; }
                    }
                    f32x16 a1;
#pragma unroll
                    for (int r = 0; r < 16; ++r) a1[r] = 0.f;
                    if (wave >= 2) {
#pragma unroll
                        for (int kk = 0; kk < 8; ++kk) a1 = mfma(ldf(lds + OFF_Q + (32 * ti + l31) * SQ + (16 * kk + 8 * hi) * 2), ldf(lds + OFF_ST + (32 * tc + l31) * SQ + (16 * kk + 8 * hi) * 2), a1);
                    }
                    if (wave < 2) {
                        const int c = l31, bb = 32 * wave;
                        const float cf = (float)c;
                        const LAS float* Ab = (const LAS float*)(lds + OFF_A + wave * 4608); asm volatile("" : "+v"(Ab));
                        f32x2_t xp[16];
#pragma unroll
                        for (int p = 0; p < 16; ++p) xp[p] = (f32x2_t){0.f, 0.f};
                        f32x4 rbA[8], rbB[8];
#define GDN_ROWLOAD(dst, row) do { _Pragma("unroll") for (int q_ = 0; q_ < ((row) + 3) / 4; ++q_) dst[q_] = *(const LAS f32x4*)(Ab + (row) * 36 + 4 * q_); } while (0)
#define GDN_ROWSOLVE(src, row) do { f32x2_t sA = (f32x2_t){fmaxf(0.f, 1.f - fabsf(cf - (float)(row))), 0.f}, sB = (f32x2_t){0.f, 0.f}; \
        _Pragma("unroll") for (int j4 = 0; j4 < (row); j4 += 4) { const f32x4 a = src[j4 >> 2]; sA -= (f32x2_t){a[0], a[1]} * xp[j4 >> 1]; sB -= (f32x2_t){a[2], a[3]} * xp[(j4 >> 1) + 1]; } \
        const float xr_ = (sA[0] + sA[1]) + (sB[0] + sB[1]); xp[(row) >> 1][(row) & 1] = xr_; } while (0)
#pragma unroll
                        for (int ii = 0; ii < 32; ii += 2) {
                            GDN_ROWLOAD(rbB, ii + 1);
                            GDN_ROWSOLVE(rbA, ii);
                            if (ii + 2 < 32) GDN_ROWLOAD(rbA, ii + 2);
                            GDN_ROWSOLVE(rbB, ii + 1);
                        }
#undef GDN_ROWLOAD
#undef GDN_ROWSOLVE
                        float x[32];
#pragma unroll
                        for (int p = 0; p < 16; ++p) { x[2 * p] = xp[p][0]; x[2 * p + 1] = xp[p][1]; }
                        const float bc = sm_beta[bb + c], bce = bc * sm_eg[bb + c];
                        if (hi == 0) {
#pragma unroll
                            for (int i = 0; i < 32; ++i) {
                                *(LAS unsigned short*)(lds + OFF_T1 + (bb + i) * SK + (bb + c) * 2) = bf1(x[i] * bc);
                                *(LAS unsigned short*)(lds + OFF_T2 + (bb + i) * SK + (bb + c) * 2) = bf1(x[i] * bce);
                            }
                            if (wave == 0) {
#pragma unroll
                                for (int i = 0; i < 32; ++i) { *(LAS unsigned short*)(lds + OFF_T1 + i * SK + (32 + c) * 2) = 0; *(LAS unsigned short*)(lds + OFF_T2 + i * SK + (32 + c) * 2) = 0; }
#pragma unroll
                                for (int q = 0; q < 4; ++q) *(LAS u32x4*)(lds + LDS_S2 + 2048 + c * 64 + q * 16) = (u32x4){cvtpk2(x[8 * q], x[8 * q + 1]), cvtpk2(x[8 * q + 2], x[8 * q + 3]), cvtpk2(x[8 * q + 4], x[8 * q + 5]), cvtpk2(x[8 * q + 6], x[8 * q + 7])};
                            } else {
#pragma unroll
                                for (int i = 0; i < 32; ++i) *(LAS unsigned short*)(lds + LDS_S2 + 4096 + i * 64 + c * 2) = bf1(x[i]);
                            }
                        }
                        __builtin_amdgcn_s_setprio(0);
                    }
                    __syncthreads();
                    if (wave < 2) {
#pragma unroll
                        for (int kk = 0; kk < 8; ++kk) a1 = mfma(ldf(lds + OFF_Q + (32 * ti + l31) * SQ + (16 * kk + 8 * hi) * 2), ldf(lds + OFF_ST + (32 * tc + l31) * SQ + (16 * kk + 8 * hi) * 2), a1);
                    }
                    if (wave >= 4) {
                        f32x16 y;
#pragma unroll
                        for (int r = 0; r < 16; ++r) y[r] = 0.f;
#pragma unroll
                        for (int kk = 0; kk < 2; ++kk) y = mfma(ldf(lds + LDS_S2 + l31 * 64 + (16 * kk + 8 * hi) * 2), ldf(lds + LDS_S2 + 2048 + l31 * 64 + (16 * kk + 8 * hi) * 2), y);
                        bf16x8 pa0, pa1;
#define GDN_PK4(P, BASE, OUT) do { const unsigned a0_ = cvtpk2(P[BASE + 0], P[BASE + 1]), a1_ = cvtpk2(P[BASE + 2], P[BASE + 3]), b0_ = cvtpk2(P[BASE + 4], P[BASE + 5]), b1_ = cvtpk2(P[BASE + 6], P[BASE + 7]); \
        auto r0_ = __builtin_amdgcn_permlane32_swap(a0_, b0_, false, false); auto r1_ = __builtin_amdgcn_permlane32_swap(a1_, b1_, false, false); \
        u32x4 w_ = {r0_[0], r1_[0], r0_[1], r1_[1]}; OUT = __builtin_bit_cast(bf16x8, w_); } while (0)
                        GDN_PK4(y, 0, pa0); GDN_PK4(y, 8, pa1);
#undef GDN_PK4
                        f32x16 zt;
#pragma unroll
                        for (int r = 0; r < 16; ++r) zt[r] = 0.f;
                        zt = mfma(pa0, ldf(lds + LDS_S2 + 4096 + l31 * 64 + (8 * hi) * 2), zt);
                        zt = mfma(pa1, ldf(lds + LDS_S2 + 4096 + l31 * 64 + (16 + 8 * hi) * 2), zt);
#pragma unroll
                        for (int g4 = 0; g4 < 4; ++g4) { const int c0 = 8 * g4 + 4 * hi;
                            const f32x4 b4 = *(const LAS f32x4*)(sm_beta + c0), e4 = *(const LAS f32x4*)(sm_eg + c0);
                            float t1[4], t2[4];
#pragma unroll
                            for (int e = 0; e < 4; ++e) { t1[e] = -zt[4 * g4 + e] * b4[e]; t2[e] = t1[e] * e4[e]; }
                            *(LAS u32x2*)(lds + OFF_T1 + (32 + l31) * SK + c0 * 2) = (u32x2){cvtpk2(t1[0], t1[1]), cvtpk2(t1[2], t1[3])};
                            *(LAS u32x2*)(lds + OFF_T2 + (32 + l31) * SK + c0 * 2) = (u32x2){cvtpk2(t2[0], t2[1]), cvtpk2(t2[2], t2[3])}; }
                    }
                    f32x16 au;
#pragma unroll
                    for (int r = 0; r < 16; ++r) au[r] = 0.f;
#pragma unroll
                    for (int kk = 0; kk < 4; ++kk) au = mfma(ldf(lds + OFF_T1 + (32 * ti + l31) * SK + (16 * kk + 8 * hi) * 2), ldf(lds + OFF_VT + (32 * tc + l31) * SK + (16 * kk + 8 * hi) * 2), au);
                    {
                        f32x16 aw;
#pragma unroll
                        for (int r = 0; r < 16; ++r) aw[r] = 0.f;
#pragma unroll
                        for (int kk = 0; kk < 4; ++kk) aw = mfma(ldf(lds + OFF_KT + (32 * td + l31) * SK + (16 * kk + 8 * hi) * 2), ldf(lds + OFF_T2 + (32 * ti + l31) * SK + (16 * kk + 8 * hi) * 2), aw);
                        const int i = 32 * ti + l31;
#pragma unroll
                        for (int g4 = 0; g4 < 4; ++g4) { const int d0 = 32 * td + 8 * g4 + 4 * hi;
                            *(LAS u32x2*)(lds + OFF_A + i * SQ + d0 * 2) = (u32x2){cvtpk2(-aw[4 * g4], -aw[4 * g4 + 1]), cvtpk2(-aw[4 * g4 + 2], -aw[4 * g4 + 3])}; }
                    }
                    __syncthreads();
#pragma unroll
                    for (int kk = 0; kk < 8; ++kk) au = mfma(ldf(lds + OFF_A + (32 * ti + l31) * SQ + (16 * kk + 8 * hi) * 2), ldf(lds + OFF_ST + (32 * tc + l31) * SQ + (16 * kk + 8 * hi) * 2), au);
                    {
                        const int c = 32 * tc + l31;
#pragma unroll
                        for (int g4 = 0; g4 < 4; ++g4) { const int i0 = 32 * ti + 8 * g4 + 4 * hi;
                            const f32x4 e2 = *(const LAS f32x4*)(sm_e2 + i0);
                            *(LAS u32x2*)(lds + OFF_VT + c * SK + i0 * 2) = (u32x2){cvtpk2(au[4 * g4], au[4 * g4 + 1]), cvtpk2(au[4 * g4 + 2], au[4 * g4 + 3])};
                            *(LAS u32x2*)(lds + OFF_K + c * SK + i0 * 2) = (u32x2){cvtpk2(au[4 * g4] * e2[0], au[4 * g4 + 1] * e2[1]), cvtpk2(au[4 * g4 + 2] * e2[2], au[4 * g4 + 3] * e2[3])}; }
                    }
                    __syncthreads();
                    f32x16 a2;
#pragma unroll
                    for (int r = 0; r < 16; ++r) a2[r] = 0.f;
#pragma unroll
                    for (int kk = 0; kk < 4; ++kk) a2 = mfma(ldf(lds + OFF_QK + (32 * ti + l31) * SK + (16 * kk + 8 * hi) * 2), ldf(lds + OFF_VT + (32 * tc + l31) * SK + (16 * kk + 8 * hi) * 2), a2);
#pragma unroll
                    for (int g4 = 0; g4 < 4; ++g4) { const f32x4 eg = *(const LAS f32x4*)(sm_eg + 32 * ti + 8 * g4 + 4 * hi);
#pragma unroll
                        for (int e = 0; e < 4; ++e) a2[4 * g4 + e] += a1[4 * g4 + e] * eg[e]; }
                    {
                        const float egl = sm_egl[0];
#pragma unroll
                        for (int r = 0; r < 16; ++r) { S0[r] *= egl; S1[r] *= egl; }
#pragma unroll
                        for (int kk = 0; kk < 4; ++kk) { const bf16x8 a = ldf(lds + OFF_KT + (32 * td + l31) * SK + (16 * kk + 8 * hi) * 2);
                            S0 = mfma(a, ldf(lds + OFF_K + (32 * (2 * ti) + l31) * SK + (16 * kk + 8 * hi) * 2), S0);
                            S1 = mfma(a, ldf(lds + OFF_K + (32 * (2 * ti + 1) + l31) * SK + (16 * kk + 8 * hi) * 2), S1); }
                    }
                    if (dir == 0) __syncthreads();
#pragma unroll
                    for (int g4 = 0; g4 < 4; ++g4) { const int d0 = 32 * td + 8 * g4 + 4 * hi;
                        *(LAS u32x2*)(lds + OFF_ST + (32 * (2 * ti) + l31) * SQ + d0 * 2) = (u32x2){cvtpk2(S0[4 * g4], S0[4 * g4 + 1]), cvtpk2(S0[4 * g4 + 2], S0[4 * g4 + 3])};
                        *(LAS u32x2*)(lds + OFF_ST + (32 * (2 * ti + 1) + l31) * SQ + d0 * 2) = (u32x2){cvtpk2(S1[4 * g4], S1[4 * g4 + 1]), cvtpk2(S1[4 * g4 + 2], S1[4 * g4 + 3])}; }
                    if (dir == 0) {
                        bf16_t* go = O + (size_t)(rowbase + c0 + 32 * ti) * 4096 + h * 128 + 32 * tc + l31;
#pragma unroll
                        for (int r = 0; r < 16; ++r) go[(size_t)crow(r, hi) * 4096] = bf1(a2[r]);
                    } else {
#pragma unroll
                        for (int r = 0; r < 16; ++r) *(LAS unsigned short*)(lds + OFF_A + (32 * ti + crow(r, hi)) * SQ + (32 * tc + l31) * 2) = bf1(a2[r]);
                        __syncthreads();
                    }
                    if (dir) {
                        const int i = tid >> 3, cs = (tid & 7) * 16;
                        const int t = dir ? c0 + 63 - i : c0 + i;
                        bf16_t* gp = O + (size_t)(rowbase + t) * 4096 + h * 128 + cs;
                        const u32x4 s0 = *(const LAS u32x4*)(lds + OFF_A + i * SQ + cs * 2), s1 = *(const LAS u32x4*)(lds + OFF_A + i * SQ + cs * 2 + 16);
                        if (dir == 0) { *(u32x4*)gp = s0; *(u32x4*)(gp + 8) = s1; }
                        else {
                            const u32x4 p0 = *(const u32x4*)gp, p1 = *(const u32x4*)(gp + 8);
                            float v[16];
                            v[0] = bflo(s0.x) + bflo(p0.x); v[1] = bfhi(s0.x) + bfhi(p0.x); v[2] = bflo(s0.y) + bflo(p0.y); v[3] = bfhi(s0.y) + bfhi(p0.y);
                            v[4] = bflo(s0.z) + bflo(p0.z); v[5] = bfhi(s0.z) + bfhi(p0.z); v[6] = bflo(s0.w) + bflo(p0.w); v[7] = bfhi(s0.w) + bfhi(p0.w);
                            v[8] = bflo(s1.x) + bflo(p1.x); v[9] = bfhi(s1.x) + bfhi(p1.x); v[10] = bflo(s1.y) + bflo(p1.y); v[11] = bfhi(s1.y) + bfhi(p1.y);
                            v[12] = bflo(s1.z) + bflo(p1.z); v[13] = bfhi(s1.z) + bfhi(p1.z); v[14] = bflo(s1.w) + bflo(p1.w); v[15] = bfhi(s1.w) + bfhi(p1.w);
                            float ss = 0.f;
#pragma unroll
                            for (int e = 0; e < 16; ++e) ss += v[e] * v[e];
                            ss += swzx<1>(ss); ss += swzx<2>(ss); ss += swzx<4>(ss);
                            const float rstd = rsqrtf(ss * (1.f / 128.f) + EPS);
#pragma unroll
                            for (int e = 0; e < 16; ++e) v[e] *= rstd * norm_g[cs + e];
                            *(u32x4*)gp = (u32x4){cvtpk2(v[0], v[1]), cvtpk2(v[2], v[3]), cvtpk2(v[4], v[5]), cvtpk2(v[6], v[7])};
                            *(u32x4*)(gp + 8) = (u32x4){cvtpk2(v[8], v[9]), cvtpk2(v[10], v[11]), cvtpk2(v[12], v[13]), cvtpk2(v[14], v[15])};
                        }
                    }
                }
            }
        }
        __syncthreads();
    }
}
}
#define XB_TMO      128
#define XB_XCNT(j)  (256  + 64 * (j))
#define XB_XSUB(j)  (1280 + 64 * (j))
#define XB_XGEN(j)  (2304 + 64 * (j))
#define XB_TOP      3328
#define XB_TOPGEN   3392
#define XCD_BAR_WORDS 3456
#define XB_SPIN_CAP (1u << 18)

__device__ __forceinline__ unsigned xb_ld(unsigned* p)              { return __hip_atomic_load(p, __ATOMIC_RELAXED, __HIP_MEMORY_SCOPE_AGENT); }
__device__ __forceinline__ unsigned xb_add(unsigned* p, unsigned v) { return __hip_atomic_fetch_add(p, v, __ATOMIC_RELAXED, __HIP_MEMORY_SCOPE_AGENT); }
__device__ __forceinline__ unsigned xb_xcc_id() { return (unsigned)__builtin_amdgcn_s_getreg((3 << 11) | 20) & 0xFu; }
#define XB_SPIN(cond, bar) do { unsigned _sp = 0; while (cond) { __builtin_amdgcn_s_sleep(1); \
    if ((++_sp & 255u) == 0u) { if (xb_ld(&(bar)[XB_TMO])) break; if (_sp > XB_SPIN_CAP) { atomicAdd(&(bar)[XB_TMO], 1u); break; } } } } while (0)

struct XcdBarrier {
    unsigned* bar; unsigned x;
    volatile LAS unsigned* st;
};

__device__ __forceinline__ XcdBarrier xcd_barrier_post(unsigned* bar, volatile LAS unsigned* st) {
    XcdBarrier b; b.bar = bar; b.x = xb_xcc_id(); b.st = st;
    if (threadIdx.x == 0) (void)xb_add(&bar[XB_XCNT(b.x)], 1u);
    return b;
}
__device__ __forceinline__ void xcd_barrier_complete(unsigned* bar, unsigned x, unsigned& nloc, unsigned& nx) {
    const unsigned G = gridDim.x * gridDim.y * gridDim.z;
    unsigned sum, cnt, mine, sp = 0u;
    for (;;) {
        sum = 0u; cnt = 0u; mine = 0u;
#pragma unroll
        for (unsigned j = 0; j < 16; ++j) { const unsigned c = xb_ld(&bar[XB_XCNT(j)]); sum += c; cnt += (c > 0u) ? 1u : 0u; mine = (j == x) ? c : mine; }
        if (sum == G) break;
        __builtin_amdgcn_s_sleep(1);
        if ((++sp & 255u) == 0u) { if (xb_ld(&bar[XB_TMO])) break; if (sp > XB_SPIN_CAP) { atomicAdd(&bar[XB_TMO], 1u); break; } }
    }
    nloc = mine > 0u ? mine : 1u; nx = cnt > 0u ? cnt : 1u;
}

__device__ __forceinline__ void xcd_barrier(const XcdBarrier& b) {
    asm volatile("s_waitcnt vmcnt(0)" ::: "memory");
    __syncthreads();
    if (threadIdx.x == 0) {
        unsigned* bar = b.bar;
        __builtin_amdgcn_s_waitcnt(0);
        unsigned nloc = b.st[0], nx = b.st[1];
        if (nloc == 0u) { xcd_barrier_complete(bar, b.x, nloc, nx); b.st[0] = nloc; b.st[1] = nx; }
        const unsigned old = xb_add(&bar[XB_XSUB(b.x)], 1u);
        const unsigned gen = old / nloc;
        if (old + 1u == (gen + 1u) * nloc) {
            __builtin_amdgcn_fence(__ATOMIC_RELEASE, "agent");
            asm volatile("s_waitcnt vmcnt(0)" ::: "memory");
            const unsigned og = xb_add(&bar[XB_TOP], 1u);
            const unsigned tg = og / nx;
            if (og + 1u == (tg + 1u) * nx) xb_add(&bar[XB_TOPGEN], 1u);
            else XB_SPIN(xb_ld(&bar[XB_TOPGEN]) == tg, bar);
            __builtin_amdgcn_fence(__ATOMIC_ACQUIRE, "agent");
            xb_add(&bar[XB_XGEN(b.x)], 1u);
            asm volatile("s_waitcnt vmcnt(0)" ::: "memory");
        } else {
            XB_SPIN(xb_ld(&bar[XB_XGEN(b.x)]) == gen, bar);
            __builtin_amdgcn_fence(__ATOMIC_ACQUIRE, "agent");
            asm volatile("s_waitcnt vmcnt(0)" ::: "memory");
        }
    }
    __syncthreads();
}

#ifndef EN_MOD
#define EN_MOD 1
#endif
#ifndef EN_GEMM
#define EN_GEMM 1
#endif
#ifndef EN_GDN
#define EN_GDN 1
#endif
#ifndef EN_ATT
#define EN_ATT 1
#endif
#ifndef EN_G1
#define EN_G1 1
#endif
#ifndef EN_G2
#define EN_G2 1
#endif
#ifndef EN_G3
#define EN_G3 1
#endif
#ifndef EN_G4
#define EN_G4 1
#endif
#ifndef EN_G5
#define EN_G5 1
#endif
#ifndef EN_G6
#define EN_G6 1
#endif
#define GSYNC() xcd_barrier(xbar)
#define GSYNC_CG() do { asm volatile("s_waitcnt vmcnt(0) lgkmcnt(0)" ::: "memory"); grid.sync(); __builtin_amdgcn_fence(__ATOMIC_ACQUIRE, "agent"); asm volatile("s_waitcnt vmcnt(0)" ::: "memory"); __syncthreads(); } while (0)
#ifndef DBG_MEMSET
#define DBG_MEMSET 0
#endif
#ifndef GDN_REPS
#define GDN_REPS 1
#endif
#ifndef SYNC_REPS
#define SYNC_REPS 1
#endif
#ifndef FFN1_REPS
#define FFN1_REPS 1
#endif
#ifndef ATT_REPS
#define ATT_REPS 1
#endif
#ifndef PR_REPS
#define PR_REPS 1
#endif
#ifndef PROBE_PREP
#define PROBE_PREP 0
#endif
#ifndef G1_REPS
#define G1_REPS 1
#endif
#ifndef PROBE_FFN2
#define PROBE_FFN2 0
#endif
#ifndef GEMM_ALIGN
#define GEMM_ALIGN true
#endif
#ifndef GEMM_SP2
#define GEMM_SP2 true
#endif
struct Args { const float* in[20]; float* out; unsigned char* ws; };

__global__ void __launch_bounds__(NTHR, 2) fwd_megakernel(Args args) {
    extern __shared__ __attribute__((aligned(16))) unsigned char lds_raw[];
    cg::grid_group grid = cg::this_grid();
    LAS unsigned char* lds = (LAS unsigned char*)lds_raw;
    const int G = gridDim.x, bid = blockIdx.x;
    if (threadIdx.x < 2) ((volatile LAS unsigned*)(lds + LDS_XB))[threadIdx.x] = 0u;
    __syncthreads();
    XcdBarrier xbar = xcd_barrier_post((unsigned*)(WS() + WS_BAR), (volatile LAS unsigned*)(lds + LDS_XB));
#if EN_MOD
    phase_mod(IN(1), IN(3), IN(4), IN(5), P_MOD, lds, G, bid);
#endif
    __syncthreads();
    phase_convert(0, P_Wb, lds, G, bid, 31, 0);
    GSYNC_CG();

    for (int L = 0; L < 4; ++L) {
        const bool is_gdn = !(L & 1), last = (L == 3);
        const int j = L >> 1;
        const int Mrows = last ? NLAT : MROWS;
        if (L == 0) phase_prep(IN(0), IN(2), P_xlat, P_xctx, true, nullptr, nullptr, P_BIG2, MODL, MODL + DM, MROWS, G, bid);
        else {
            phase_prep(P_xlat, P_xctx, P_xlat, P_xctx, true, IN(6) + (size_t)((L - 1) * 2 + 1) * DM, IN(7) + (size_t)((L - 1) * 2 + 1) * DM, P_BIG2, MODL, MODL + DM, MROWS, G, bid);
            phase_convert(L, P_Wb, lds, G, bid, 16, 0);
        }
        GSYNC();
        const bf16_t* mixA; int mixK, mixLda;
        if (is_gdn) {
            {
                pg8::Gemm g{P_BIG2, P_Wb + W_A, MROWS, GIN1, 1024, 1024}; pg8::StaticOrder S; S.init(MROWS, GIN1, G, bid);
                EpiGdnIn E{P_BIG1, P_GB, IN(12) + j * 32, IN(13) + j * 32};
                for (int gr_ = 0; gr_ < G1_REPS; ++gr_) pg8::gemm_phase<EpiGdnIn, pg8::StaticOrder, GEMM_ALIGN, GEMM_SP2>(lds, g, S, E);
            }
            GSYNC();
            for (int cr_ = 0; cr_ < PR_REPS; ++cr_) gdn::conv_phase(P_BIG1, IN(11) + (size_t)j * 5 * 4096, P_BIG2, 0, G, bid);
            GSYNC();
            for (int cr_ = 0; cr_ < PR_REPS; ++cr_) gdn::conv_phase(P_BIG1, IN(11) + (size_t)j * 5 * 4096, P_BIG1, 1, G, bid);
            GSYNC();
            for (int rep_ = 0; rep_ < GDN_REPS; ++rep_) gdn::core(P_BIG2, P_BIG1, P_GB, IN(14) + j * 128, P_BIG1 + 2048, lds, G, bid);
            GSYNC();
            for (int cr_ = 0; cr_ < PR_REPS; ++cr_) phase_prep(P_xlat, P_xctx, P_xlat, P_xctx, false, nullptr, nullptr, P_BIG2, MODL, MODL + DM, MROWS, G, bid);
            GSYNC();
            {
                pg8::Gemm g{P_BIG2, P_Wb + W_Z, MROWS, 2048, 1024, 1024}; pg8::StaticOrder S; S.init(MROWS, 2048, G, bid);
                EpiGateZ E{P_BIG1 + 2048};
                if (EN_GEMM && EN_G2) pg8::gemm_phase<EpiGateZ, pg8::StaticOrder, GEMM_ALIGN, GEMM_SP2>(lds, g, S, E);
            }
            GSYNC();
            mixA = P_BIG1 + 2048; mixK = 2048; mixLda = 4096;
        } else {
            {
                pg8::Gemm g{P_BIG2, P_Wb + W_A, MROWS, 1536, 1024, 1024}; pg8::StaticOrder S; S.init(MROWS, 1536, G, bid);
                EpiPlainBf16 E{P_QKV, 1536};
                if (EN_GEMM && EN_G3) pg8::gemm_phase<EpiPlainBf16, pg8::StaticOrder, GEMM_ALIGN, GEMM_SP2>(lds, g, S, E);
            }
            GSYNC();
            phase_qkvpost(P_QKV, P_KB, P_VB, IN(17) + j * 128, IN(18) + j * 128, G, bid);
            GSYNC();
            {
                const int total = 1024 + (last ? 0 : 128);
                for (int arep_ = 0; arep_ < ATT_REPS; ++arep_)
                for (int it = bid; it < total; it += G) {
                    const att::bf16 *Qp, *Kp, *Vp; unsigned short* Op; int seq;
                    if (it < 1024) {
                        const int rnd = it >> 8, b256 = it & 255, grp = rnd * 8 + (b256 & 7), within = b256 >> 3;
                        const int b = grp >> 1, kvh = grp & 1, gq = within >> 3, qb = within & 7, h = kvh * 4 + gq;
                        Qp = (const att::bf16*)(P_QKV + (size_t)(b * SEQ + qb * 256) * 1536 + h * 128);
                        Kp = (const att::bf16*)(P_KB + (size_t)(b * 2 + kvh) * KVLEN * 128); Vp = (const att::bf16*)(P_VB + (size_t)(b * 2 + kvh) * KVLEN * 128);
                        Op = P_AO + (size_t)(b * SEQ + qb * 256) * 1024 + h * 128; seq = KVLEN;
                    } else {
                        const int q = it - 1024, b = q >> 3, h = q & 7, kvh = h >> 2;
                        Qp = (const att::bf16*)(P_QKV + (size_t)(NLAT + b * CTXL) * 1536 + h * 128);
                        Kp = (const att::bf16*)(P_KB + (size_t)(b * 2 + kvh) * KVLEN * 128); Vp = (const att::bf16*)(P_VB + (size_t)(b * 2 + kvh) * KVLEN * 128);
                        Op = P_AO + (size_t)(NLAT + b * CTXL) * 1024 + h * 128; seq = CTXL;
                    }
                    if (EN_ATT) att::attn_dense_body<att::bf16, 1536, 128, 1024>(Qp, Kp, Vp, Op, seq, (char*)lds_raw);
                    __syncthreads();
                }
            }
            GSYNC();
            mixA = P_AO; mixK = 1024; mixLda = 1024;
        }
        {
            pg8::Gemm g{mixA, P_Wb + W_O, Mrows, 1024, mixK, mixLda}; pg8::StaticOrder S; S.init(Mrows, 1024, G, bid);
            EpiResid E{P_xlat, P_xctx, MODL + 2 * DM, ALPHA, 1.f};
            if (EN_GEMM && EN_G4) pg8::gemm_phase<EpiResid, pg8::StaticOrder, GEMM_ALIGN, GEMM_SP2>(lds, g, S, E);
        }
        GSYNC();
#if PROBE_PREP
        phase_prep(P_xlat, P_xctx, P_xlat, P_xctx, false, IN(6) + (size_t)(L * 2) * DM, IN(7) + (size_t)(L * 2) * DM, P_BIG1, MODL + 3 * DM, MODL + 4 * DM, Mrows, G, bid);
#endif
        phase_prep(P_xlat, P_xctx, P_xlat, P_xctx, true, IN(6) + (size_t)(L * 2) * DM, IN(7) + (size_t)(L * 2) * DM, P_BIG2, MODL + 3 * DM, MODL + 4 * DM, Mrows, G, bid);
        GSYNC();
        {
            pg8::Gemm g{P_BIG2, P_Wb + W_F1, Mrows, 5632, 1024, 1024}; pg8::StaticOrder S; S.init(Mrows, 5632, G, bid);
            EpiSwiglu E{P_BIG1};
            for (int rp_ = 0; rp_ < FFN1_REPS; ++rp_) pg8::gemm_phase<EpiSwiglu, pg8::StaticOrder, GEMM_ALIGN, GEMM_SP2>(lds, g, S, E);
        }
        GSYNC();
        {
            pg8::Gemm g{P_BIG1, P_Wb + W_F2, Mrows, 1024, DFF, DFF}; pg8::StaticOrder S; S.init(Mrows, 1024, G, bid);
#if PROBE_FFN2
            { EpiResid E0{P_xlat, P_xctx, MODL + 5 * DM, 1.f, 0.f}; pg8::gemm_phase<EpiResid, pg8::StaticOrder, GEMM_ALIGN, GEMM_SP2>(lds, g, S, E0); }
#endif
            EpiResid E{P_xlat, P_xctx, MODL + 5 * DM, ALPHA, 1.f};
            if (EN_GEMM && EN_G6) pg8::gemm_phase<EpiResid, pg8::StaticOrder, GEMM_ALIGN, GEMM_SP2>(lds, g, S, E);
            if (L < 3) { __syncthreads(); phase_convert(L + 1, P_Wb, lds, G, bid, 15, (G == 256 && Mrows == MROWS) ? 64 : 0); }
        }
        GSYNC();
    }
    phase_prep(P_xlat, P_xctx, P_xlat, P_xctx, true, IN(6) + (size_t)7 * DM, IN(7) + (size_t)7 * DM, nullptr, nullptr, nullptr, NLAT, G, bid);
}

extern "C" void kernel_launch(void* const* d_in, const int* in_sizes, int n_in, void* d_out, int out_size, void* d_ws, size_t ws_size, hipStream_t stream) {
    static int grid = 0;
    if (grid == 0) {
        if (n_in != 20 || out_size != NLAT * DM || ws_size < WS_END) { fprintf(stderr, "kernel_launch: unexpected shapes: n_in %d out %d ws %zu (need %zu)\n", n_in, out_size, ws_size, (size_t)WS_END); grid = -1; return; }
        int dev = 0, cus = 0, per_cu = 0;
        hipGetDevice(&dev); hipDeviceGetAttribute(&cus, hipDeviceAttributeMultiprocessorCount, dev);
        if (hipFuncSetAttribute((const void*)fwd_megakernel, hipFuncAttributeMaxDynamicSharedMemorySize, LDS_BYTES) != hipSuccess) { fprintf(stderr, "kernel_launch: hipFuncSetAttribute failed\n"); grid = -1; return; }
        if (hipOccupancyMaxActiveBlocksPerMultiprocessor(&per_cu, (const void*)fwd_megakernel, NTHR, LDS_BYTES) != hipSuccess || per_cu < 1) { fprintf(stderr, "kernel_launch: occupancy query says %d\n", per_cu); per_cu = 1; }
        (void)hipGetLastError();
        grid = cus;
    }
    if (grid < 0) return;
    Args a{};
    for (int i = 0; i < 20; ++i) a.in[i] = (const float*)d_in[i];
    a.out = (float*)d_out; a.ws = (unsigned char*)d_ws;
#if DBG_MEMSET
    (void)hipMemsetAsync(d_ws, 0, WS_END, stream); (void)hipMemsetAsync(d_out, 0, (size_t)out_size * 4, stream);
#endif
    (void)hipMemsetAsync((char*)d_ws + WS_BAR, 0, WS_BAR_BYTES, stream);
    void* kargs[] = {&a};
    hipError_t e = hipLaunchCooperativeKernel((const void*)fwd_megakernel, dim3(grid), dim3(NTHR), kargs, LDS_BYTES, stream);
    if (e != hipSuccess) fprintf(stderr, "kernel_launch: cooperative launch failed: %s (grid %d)\n", hipGetErrorString(e), grid);
}
```

```cpp
#include <hip/hip_runtime.h>
#include <hip/hip_bf16.h>
#include <hip/hip_cooperative_groups.h>
#include <cstdio>
#include <cstdint>
#include <cmath>
namespace cg = cooperative_groups;
__device__ __forceinline__ int opaque_tid() { int t = threadIdx.x; asm volatile("" : "+v"(t)); return t; }
namespace pg8 {
#define PG8_LAS __attribute__((address_space(3)))
typedef unsigned short bf16_t;
typedef short bf16x8 __attribute__((ext_vector_type(8)));
typedef float f32x4 __attribute__((ext_vector_type(4)));
typedef unsigned u32x4 __attribute__((ext_vector_type(4)));
constexpr int BM = 256, BK = 64, HALF = 128, HTB = HALF * BK * 2  , STAGE_BYTES = 8 * HTB, NXCD = 8, WGM = 4;

__host__ __device__ __forceinline__ int lds_byte(int r, int c) { const int st = (r >> 4) * 2 + (c >> 5), rr = r & 15, cc = c & 31, ob = rr * 64 + cc * 2; return st * 1024 + (ob ^ (((ob >> 9) & 1) << 5)); }
__host__ __device__ __forceinline__ void stage_rc(int b, int& R, int& C) { const int st = b / 1024, sb = b % 1024, swz = sb ^ (((sb >> 9) & 1) << 5); R = (st >> 1) * 16 + swz / 64; C = (st & 1) * 32 + (swz % 64) / 2; }
__host__ __device__ __forceinline__ int perm32(int rho) { const int n = rho >> 4, i = rho & 15; return 8 * (i >> 2) + 4 * n + (i & 3); }

struct Unit { int pm, pn; };
struct Gemm { const bf16_t* A; const bf16_t* Bt; int M, N, K, lda; };

struct StaticOrder {
    int nM, nN, nwg, G, c;
    __host__ __device__ void init(int M, int N, int G_, int c_) { nM = M / BM; nN = N / BM; nwg = nM * nN; G = G_; c = c_; }
    __host__ __device__ bool next(int i, Unit& u) const {
        const long L = (long)i * G + c; if (L >= nwg) return false;
        int wgid = (int)L; { const int q = nwg / NXCD, r = nwg % NXCD, xcd = wgid % NXCD, off = wgid / NXCD; wgid = (xcd < r ? xcd * (q + 1) : r * (q + 1) + (xcd - r) * q) + off; }
        const int nig = WGM * nN, gid = wgid / nig, fm = gid * WGM, gsz = (nM - fm) < WGM ? (nM - fm) : WGM;
        u.pm = fm + ((wgid % nig) % gsz); u.pn = (wgid % nig) / gsz; return true;
    }
    __device__ __forceinline__ void a_ready(const Unit&) const {}
    __device__ __forceinline__ void done(const Unit&) const {}
};

__device__ __forceinline__ unsigned cvt_pk_bf16(float lo, float hi) { unsigned r; asm volatile("v_cvt_pk_bf16_f32 %0, %1, %2" : "=v"(r) : "v"(lo), "v"(hi)); return r; }
typedef float f32x2 __attribute__((ext_vector_type(2)));
__device__ __forceinline__ f32x2 gelu_pk(f32x2 v) {
    const f32x2 av = __builtin_elementwise_abs(v), d = av * 0.2316418882f + 1.0f;
    f32x2 t; t.x = __builtin_amdgcn_rcpf(d.x); t.y = __builtin_amdgcn_rcpf(d.y);
    f32x2 q = t * 0.5307027145f + (-0.7265760135f); q = q * t + 0.7107068705f; q = q * t + (-0.142248368f); q = q * t + 0.127414796f; q = q * t;
    const f32x2 s = (v * v) * (-0.72134752044f);
    f32x2 e; e.x = __builtin_amdgcn_exp2f(s.x); e.y = __builtin_amdgcn_exp2f(s.y);
    const f32x2 m = v * (q * e), r = v - m;
    f32x2 o; o.x = v.x < 0.f ? m.x : r.x; o.y = v.y < 0.f ? m.y : r.y; return o;
}

template <int ACT  > struct EpiBf16 {
    static constexpr bool PERM = true, AFTER_DRAIN = false; static_assert(ACT == 0 || ACT == 1, "EpiBf16: ACT is 0 (none) or 1 (gelu_pk)");
    bf16_t* O; int ldc; const float* bias; int split_cols; size_t split_stride; float scale0;
    __device__ __forceinline__ void operator()(const f32x4 (&acc)[2][2][4][2], const Unit& u, int wr, int wc, int fr, int fq) const {
        const int row0 = u.pm * BM + wr * 64 + fr; int colt = u.pn * BM; bf16_t* base = O;
        float sc = 1.f; if (split_cols) { const int t = colt / split_cols; base += (size_t)t * split_stride; colt -= t * split_cols; if (t == 0) sc = scale0; }
        const int col0 = colt + wc * 32 + 8 * fq, bcol0 = u.pn * BM + wc * 32 + 8 * fq;
        f32x4 bv[2][2];
#pragma unroll
        for (int bj = 0; bj < 2; ++bj)
#pragma unroll
            for (int n = 0; n < 2; ++n) bv[bj][n] = bias ? *(const f32x4*)(bias + bcol0 + bj * HALF + 4 * n) : (f32x4){0.f, 0.f, 0.f, 0.f};
#pragma unroll
        for (int ai = 0; ai < 2; ++ai)
#pragma unroll
            for (int m = 0; m < 4; ++m) { bf16_t* rowp = base + (size_t)(row0 + ai * HALF + m * 16) * ldc + col0;
#pragma unroll
                for (int bj = 0; bj < 2; ++bj) { f32x4 v0 = acc[ai][bj][m][0] + bv[bj][0], v1 = acc[ai][bj][m][1] + bv[bj][1];
                    if (ACT == 1) { f32x2 a = gelu_pk((f32x2){v0[0], v0[1]}), b = gelu_pk((f32x2){v0[2], v0[3]}), c = gelu_pk((f32x2){v1[0], v1[1]}), d = gelu_pk((f32x2){v1[2], v1[3]});
                        v0 = (f32x4){a.x, a.y, b.x, b.y}; v1 = (f32x4){c.x, c.y, d.x, d.y}; }
                    v0 = v0 * sc; v1 = v1 * sc; u32x4 w; w.x = cvt_pk_bf16(v0[0], v0[1]); w.y = cvt_pk_bf16(v0[2], v0[3]); w.z = cvt_pk_bf16(v1[0], v1[1]); w.w = cvt_pk_bf16(v1[2], v1[3]);
                    *(u32x4*)(rowp + bj * HALF) = w; } }
    }
};

struct PanelStats {
    unsigned* xbuf;
    unsigned* cnt;
    unsigned* tmo;
    int ntn; float eps;
    unsigned code;
    __device__ __forceinline__ bool run(const f32x4 (&v)[2][2][4][2], const Unit& u, int wr, int wc, int fr, int fq, PG8_LAS unsigned char* lds, int wid, int lane) const {
        typedef float f32x2v __attribute__((ext_vector_type(2)));
        PG8_LAS f32x2v* P = (PG8_LAS f32x2v*)lds;
        PG8_LAS f32x2v* S = (PG8_LAS f32x2v*)(lds + 8192);
        PG8_LAS unsigned* flag = (PG8_LAS unsigned*)(lds + 8192 + 2048);
#pragma unroll
        for (int ai = 0; ai < 2; ++ai)
#pragma unroll
            for (int m = 0; m < 4; ++m) {
                float s = 0.f;
#pragma unroll
                for (int bj = 0; bj < 2; ++bj)
#pragma unroll
                    for (int n = 0; n < 2; ++n) { const f32x4 x = v[ai][bj][m][n]; s += (x[0] + x[1]) + (x[2] + x[3]); }
                s += __shfl_xor(s, 16); s += __shfl_xor(s, 32);
                const float mw = s * (1.0f / 64.0f); float q = 0.f;
#pragma unroll
                for (int bj = 0; bj < 2; ++bj)
#pragma unroll
                    for (int n = 0; n < 2; ++n) { const f32x4 d = v[ai][bj][m][n] - mw; q += (d[0] * d[0] + d[1] * d[1]) + (d[2] * d[2] + d[3] * d[3]); }
                q += __shfl_xor(q, 16); q += __shfl_xor(q, 32);
                if (fq == 0) P[(ai * HALF + wr * 64 + m * 16 + fr) * 4 + wc] = (f32x2v){mw, q};
            }
        asm volatile("s_waitcnt lgkmcnt(0)" ::: "memory"); __builtin_amdgcn_s_barrier(); asm volatile("" ::: "memory");
#if defined(BROKEN_EXCHANGE_NO_WAIT)
#warning BROKEN CONTROL BUILD: the row-statistics exchange does not wait; results are wrong by design
        if (blockIdx.x >= 64) { const long long t0_ = clock64(); while (clock64() - t0_ < 60000) __builtin_amdgcn_s_sleep(8); }
#endif
        const int row = wid * 32 + (lane & 31);
        if (lane < 32) {
            const f32x2v a = P[row * 4 + 0], b = P[row * 4 + 1], c = P[row * 4 + 2], d = P[row * 4 + 3];
            const float mt = (a.x + b.x + c.x + d.x) * 0.25f;
            const float da = a.x - mt, db = b.x - mt, dc = c.x - mt, dd = d.x - mt;
            const float m2 = (a.y + b.y) + (c.y + d.y) + 64.0f * ((da * da + db * db) + (dc * dc + dd * dd));
            unsigned long long* slot = (unsigned long long*)xbuf + ((size_t)(u.pm * BM + row) * 4 + u.pn);
            __hip_atomic_store(slot, ((unsigned long long)__float_as_uint(m2) << 32) | __float_as_uint(mt), __ATOMIC_RELAXED, __HIP_MEMORY_SCOPE_AGENT);
        }
        asm volatile("s_waitcnt vmcnt(0)" ::: "memory");
        if (lane == 0) __hip_atomic_fetch_add(cnt + 64 * u.pm, 1u, __ATOMIC_RELAXED, __HIP_MEMORY_SCOPE_AGENT);
        if (wid == 0) {
            bool dead = false; const unsigned long long t0 = __builtin_amdgcn_s_memrealtime(); const unsigned want = 8u * (unsigned)ntn;
            for (;;) {
#if defined(BROKEN_EXCHANGE_NO_WAIT)
                break;
#endif
                if ((unsigned)__builtin_amdgcn_readfirstlane(__hip_atomic_load(cnt + 64 * u.pm, __ATOMIC_RELAXED, __HIP_MEMORY_SCOPE_AGENT)) >= want) break;
                if (__builtin_amdgcn_s_memrealtime() - t0 > 2000000ull) {
                    if (lane == 0) { unsigned expect = 0u; __hip_atomic_compare_exchange_strong(tmo + 1, &expect, code | (unsigned)(u.pm & 0xff), __ATOMIC_RELAXED, __ATOMIC_RELAXED, __HIP_MEMORY_SCOPE_AGENT);
                                     __hip_atomic_store(tmo, 1u, __ATOMIC_RELAXED, __HIP_MEMORY_SCOPE_AGENT); }
                    dead = true; break; }
                __builtin_amdgcn_s_sleep(2);
            }
            __builtin_amdgcn_fence(__ATOMIC_ACQUIRE, "agent");
            if (lane == 0) flag[0] = dead ? 1u : 0u;
        }
        asm volatile("s_waitcnt vmcnt(0) lgkmcnt(0)" ::: "memory"); __builtin_amdgcn_s_barrier(); asm volatile("" ::: "memory");
        const bool bad = flag[0] != 0u;
        if (lane < 32) {
            const unsigned long long* slot = (const unsigned long long*)xbuf + (size_t)(u.pm * BM + row) * 4; float mt[4], m2[4]; float ms = 0.f;
#pragma unroll
            for (int t = 0; t < 4; ++t) { if (t < ntn) { const unsigned long long w = __hip_atomic_load(slot + t, __ATOMIC_RELAXED, __HIP_MEMORY_SCOPE_AGENT); mt[t] = __uint_as_float((unsigned)w); m2[t] = __uint_as_float((unsigned)(w >> 32)); } else { mt[t] = 0.f; m2[t] = 0.f; } ms += mt[t]; }
            const float mean = ms / (float)ntn; float q = 0.f;
#pragma unroll
            for (int t = 0; t < 4; ++t) if (t < ntn) { const float dm = mt[t] - mean; q += m2[t] + 256.0f * dm * dm; }
            S[row] = (f32x2v){mean, 1.0f / sqrtf(q / (256.0f * (float)ntn) + eps)};
        }
        asm volatile("s_waitcnt lgkmcnt(0)" ::: "memory"); __builtin_amdgcn_s_barrier(); asm volatile("" ::: "memory");
        return bad;
    }
};
struct EpiLnRes {
    static constexpr bool PERM = false, AFTER_DRAIN = true;
    const float* base; float* out; int ldc; const float* bias; PanelStats st; unsigned poison;
    __device__ __forceinline__ void fused(f32x4 (&acc)[2][2][4][2], const Unit& u, int wr, int wc, int fr, int fq, PG8_LAS unsigned char* lds, int wid, int lane) const {
        typedef float f32x2v __attribute__((ext_vector_type(2)));
        const PG8_LAS f32x2v* S = (const PG8_LAS f32x2v*)(lds + 8192);
        const int col0 = u.pn * BM + wc * 32 + 4 * fq;
#pragma unroll
        for (int bj = 0; bj < 2; ++bj)
#pragma unroll
            for (int n = 0; n < 2; ++n) { const f32x4 bv = bias ? *(const f32x4*)(bias + col0 + bj * HALF + n * 16) : (f32x4){0.f, 0.f, 0.f, 0.f};
#pragma unroll
                for (int ai = 0; ai < 2; ++ai)
#pragma unroll
                    for (int m = 0; m < 4; ++m) acc[ai][bj][m][n] += bv; }
        f32x4 pre[4][2][2];
#pragma unroll
        for (int m = 0; m < 4; ++m) { const size_t off = (size_t)(u.pm * BM + wr * 64 + m * 16 + fr) * ldc + col0;
#pragma unroll
            for (int bj = 0; bj < 2; ++bj)
#pragma unroll
                for (int n = 0; n < 2; ++n) pre[m][bj][n] = *(const f32x4*)(base + off + bj * HALF + n * 16); }
        const bool bad = st.run(acc, u, wr, wc, fr, fq, lds, wid, lane) || poison != 0u;
        const float qnan = __builtin_nanf("");
#pragma unroll
        for (int ai = 0; ai < 2; ++ai)
#pragma unroll
            for (int m = 0; m < 4; ++m) { const int r = ai * HALF + wr * 64 + m * 16 + fr; const f32x2v sr = S[r]; const size_t off = (size_t)(u.pm * BM + r) * ldc + col0;
#pragma unroll
                for (int bj = 0; bj < 2; ++bj)
#pragma unroll
                    for (int n = 0; n < 2; ++n) { const f32x4 bs = ai == 0 ? pre[m][bj][n] : *(const f32x4*)(base + off + bj * HALF + n * 16); f32x4 o = bs + (acc[ai][bj][m][n] - sr.x) * sr.y;
                        if (bad) o = (f32x4){qnan, qnan, qnan, qnan}; *(f32x4*)(out + off + bj * HALF + n * 16) = o; }
                if (m & 1) asm volatile("" ::: "memory"); }
    }
};
struct EpiLnResLn {
    static constexpr bool PERM = false, AFTER_DRAIN = true;
    const float* base; float* out; bf16_t* xn; int ldc; const float* bias; PanelStats st1, st2; unsigned poison;
    __device__ __forceinline__ void fused(f32x4 (&acc)[2][2][4][2], const Unit& u, int wr, int wc, int fr, int fq, PG8_LAS unsigned char* lds, int wid, int lane) const {
        typedef float f32x2v __attribute__((ext_vector_type(2))); typedef unsigned u32x2v __attribute__((ext_vector_type(2)));
        const PG8_LAS f32x2v* S = (const PG8_LAS f32x2v*)(lds + 8192);
        const int col0 = u.pn * BM + wc * 32 + 4 * fq;
#pragma unroll
        for (int bj = 0; bj < 2; ++bj)
#pragma unroll
            for (int n = 0; n < 2; ++n) { const f32x4 bv = bias ? *(const f32x4*)(bias + col0 + bj * HALF + n * 16) : (f32x4){0.f, 0.f, 0.f, 0.f};
#pragma unroll
                for (int ai = 0; ai < 2; ++ai)
#pragma unroll
                    for (int m = 0; m < 4; ++m) acc[ai][bj][m][n] += bv; }
        bool bad = st1.run(acc, u, wr, wc, fr, fq, lds, wid, lane) || poison != 0u;
        const float qnan = __builtin_nanf("");
#pragma unroll
        for (int ai = 0; ai < 2; ++ai)
#pragma unroll
            for (int m = 0; m < 4; ++m) { const int r = ai * HALF + wr * 64 + m * 16 + fr; const f32x2v sr = S[r]; const size_t off = (size_t)(u.pm * BM + r) * ldc + col0;
#pragma unroll
                for (int bj = 0; bj < 2; ++bj)
#pragma unroll
                    for (int n = 0; n < 2; ++n) { const f32x4 bs = *(const f32x4*)(base + off + bj * HALF + n * 16); acc[ai][bj][m][n] = bs + (acc[ai][bj][m][n] - sr.x) * sr.y; }
                asm volatile("" : "+v"(acc[ai][0][m][0]), "+v"(acc[ai][0][m][1]), "+v"(acc[ai][1][m][0]), "+v"(acc[ai][1][m][1]));
                if (m & 1) asm volatile("" ::: "memory"); }
        const bool bad1 = bad;
        bad = st2.run(acc, u, wr, wc, fr, fq, lds, wid, lane) || bad;
#pragma unroll
        for (int ai = 0; ai < 2; ++ai)
#pragma unroll
            for (int m = 0; m < 4; ++m) { const int r = ai * HALF + wr * 64 + m * 16 + fr; const f32x2v sr = S[r]; const size_t off = (size_t)(u.pm * BM + r) * ldc + col0;
#pragma unroll
                for (int bj = 0; bj < 2; ++bj)
#pragma unroll
                    for (int n = 0; n < 2; ++n) { const f32x4 x1 = acc[ai][bj][m][n]; *(f32x4*)(out + off + bj * HALF + n * 16) = bad1 ? (f32x4){qnan, qnan, qnan, qnan} : x1;
                        const f32x4 o = (x1 - sr.x) * sr.y; u32x2v w; w.x = cvt_pk_bf16(o[0], o[1]); w.y = cvt_pk_bf16(o[2], o[3]);
                        if (bad) { w.x = 0x7fc07fc0u; w.y = 0x7fc07fc0u; } *(u32x2v*)(xn + off + bj * HALF + n * 16) = w; }
                asm volatile("" ::: "memory"); }
    }
};

template <class Epi, class Sched, bool ALIGN_EPI = false, bool SP2 = false>
__device__ __forceinline__ void gemm_phase(PG8_LAS unsigned char* lds, const Gemm g, const Sched& S, const Epi& E) {
    const int tid = opaque_tid(), wid = __builtin_amdgcn_readfirstlane(tid >> 6), lane = tid & 63, wr = wid >> 2, wc = wid & 3, fr = lane & 15, fq = lane >> 4;
    const int K = g.K, nt = K / BK;
    unsigned voffA[2], voffB[2];
#pragma unroll
    for (int i = 0; i < 2; ++i) { int R, C; stage_rc(tid * 16 + i * 8192, R, C); const int Rb = Epi::PERM ? ((R & ~31) + perm32(R & 31)) : R;
        voffA[i] = (unsigned)(R * g.lda + C) * 2u; voffB[i] = (unsigned)(Rb * K + C) * 2u; }
    const size_t kstep = (size_t)(BK * 2);
    const size_t hstep = (size_t)HALF * K * 2;
    const size_t tstep = 2 * hstep;
    const size_t hstepA = (size_t)HALF * g.lda * 2, tstepA = 2 * hstepA;
    const unsigned ldsw = (unsigned)wid * 1024u;
    const int aoff = lds_byte(wr * 64 + fr, fq * 8), boff = lds_byte(wc * 32 + fr, fq * 8);
#define PG8_SA(b, h) (((b) * 2 + (h)) * HTB)
#define PG8_SB(b, h) ((4 + (b) * 2 + (h)) * HTB)
#define PG8_STAGE(bufoff, gbase, voff) do { _Pragma("unroll") for (int _i = 0; _i < 2; ++_i) \
        __builtin_amdgcn_global_load_lds((const unsigned*)((const char*)(gbase) + (voff)[_i]), (PG8_LAS unsigned*)(lds + (bufoff) + ldsw + _i * 8192), 16, 0, 0); } while (0)
#define PG8_LDA(dst, b, h) do { _Pragma("unroll") for (int m = 0; m < 4; ++m) _Pragma("unroll") for (int k = 0; k < 2; ++k) dst[m][k] = *(const PG8_LAS bf16x8*)(lds + PG8_SA(b, h) + aoff + m * 2048 + k * 1024); } while (0)
#define PG8_LDB(dst, b, h) do { _Pragma("unroll") for (int n = 0; n < 2; ++n) _Pragma("unroll") for (int k = 0; k < 2; ++k) dst[n][k] = *(const PG8_LAS bf16x8*)(lds + PG8_SB(b, h) + boff + n * 2048 + k * 1024); } while (0)
#define PG8_MMA(ai, bj, At, Bt) do { __builtin_amdgcn_s_setprio(1); _Pragma("unroll") for (int m = 0; m < 4; ++m) _Pragma("unroll") for (int n = 0; n < 2; ++n) _Pragma("unroll") for (int k = 0; k < 2; ++k) \
        acc[ai][bj][m][n] = __builtin_amdgcn_mfma_f32_16x16x32_bf16(Bt[n][k], At[m][k], acc[ai][bj][m][n], 0, 0, 0); __builtin_amdgcn_s_setprio(0); } while (0)
#define PG8_WAIT_V(n) asm volatile("s_waitcnt vmcnt(" #n ")" ::: "memory")
#define PG8_WAIT_L(n) asm volatile("s_waitcnt lgkmcnt(" #n ")" ::: "memory")
#define PG8_BAR __builtin_amdgcn_s_barrier()
#define PG8_SCHED __builtin_amdgcn_sched_barrier(0)
    Unit cur, nxt; int ui = 0;
    if (!S.next(0, cur)) return;
    f32x4 acc[2][2][4][2];
#pragma unroll
    for (int a = 0; a < 2; ++a)
#pragma unroll
        for (int b = 0; b < 2; ++b)
#pragma unroll
            for (int m = 0; m < 4; ++m)
#pragma unroll
                for (int n = 0; n < 2; ++n) acc[a][b][m][n] = (f32x4){0.f, 0.f, 0.f, 0.f};
    bf16x8 At[4][2], B0[2][2], B1[2][2];
    const char* cA = (const char*)g.A + (size_t)cur.pm * tstepA; const char* cB = (const char*)g.Bt + (size_t)cur.pn * tstep;
    S.a_ready(cur);
    if constexpr (SP2) {
        PG8_STAGE(PG8_SB(0, 0), cB, voffB); PG8_STAGE(PG8_SB(0, 1), cB + hstep, voffB); PG8_STAGE(PG8_SA(0, 0), cA, voffA); PG8_STAGE(PG8_SA(0, 1), cA + hstepA, voffA);
        if (wr == 1) PG8_BAR;
        PG8_WAIT_V(2); PG8_BAR;
        PG8_STAGE(PG8_SB(1, 0), cB + kstep, voffB); PG8_STAGE(PG8_SA(1, 0), cA + kstep, voffA); PG8_STAGE(PG8_SB(1, 1), cB + hstep + kstep, voffB);
        PG8_WAIT_V(6); PG8_BAR;
    } else {
        PG8_STAGE(PG8_SB(0, 0), cB, voffB); PG8_STAGE(PG8_SA(0, 0), cA, voffA); PG8_STAGE(PG8_SB(0, 1), cB + hstep, voffB); PG8_STAGE(PG8_SA(0, 1), cA + hstepA, voffA);
        if (wr == 1) PG8_BAR;
        PG8_WAIT_V(4); PG8_BAR;
        PG8_STAGE(PG8_SB(1, 0), cB + kstep, voffB); PG8_STAGE(PG8_SA(1, 0), cA + kstep, voffA); PG8_STAGE(PG8_SB(1, 1), cB + hstep + kstep, voffB);
        PG8_WAIT_V(6); PG8_BAR;
    }
    for (;;) {
        const bool has_next = S.next(ui + 1, nxt);
        const char* nA = has_next ? (const char*)g.A + (size_t)nxt.pm * tstepA : cA; const char* nB = has_next ? (const char*)g.Bt + (size_t)nxt.pn * tstep : cB;
        for (int t = 0; t < nt; t += 2) {
            const bool last = (t == nt - 2);
            const char* a1 = cA + (size_t)(t + 1) * kstep;
            const char* a2 = last ? nA : cA + (size_t)(t + 2) * kstep; const char* b2 = last ? nB : cB + (size_t)(t + 2) * kstep;
            const char* a3 = a2 + kstep; const char* b3 = b2 + kstep;
            if (last && has_next) S.a_ready(nxt);
            if constexpr (SP2) {
            PG8_LDB(B0, 0, 0); PG8_LDB(B1, 0, 1); PG8_SCHED; PG8_LDA(At, 0, 0); PG8_STAGE(PG8_SA(1, 1), a1 + hstepA, voffA);
            PG8_WAIT_V(8); PG8_WAIT_L(0); PG8_BAR; PG8_MMA(0, 0, At, B0); PG8_MMA(0, 1, At, B1); PG8_BAR; PG8_SCHED;
            PG8_LDA(At, 0, 1); PG8_STAGE(PG8_SB(0, 0), b2, voffB); PG8_STAGE(PG8_SB(0, 1), b2 + hstep, voffB); PG8_STAGE(PG8_SA(0, 0), a2, voffA);
            PG8_WAIT_V(8); PG8_WAIT_L(0); PG8_BAR; PG8_MMA(1, 0, At, B0); PG8_MMA(1, 1, At, B1); PG8_BAR; PG8_SCHED;
            PG8_LDB(B0, 1, 0); PG8_LDB(B1, 1, 1); PG8_SCHED; PG8_LDA(At, 1, 0); PG8_STAGE(PG8_SA(0, 1), a2 + hstepA, voffA);
            PG8_WAIT_V(8); PG8_WAIT_L(0); PG8_BAR; PG8_MMA(0, 0, At, B0); PG8_MMA(0, 1, At, B1); PG8_BAR; PG8_SCHED;
            PG8_LDA(At, 1, 1); PG8_STAGE(PG8_SB(1, 0), b3, voffB); PG8_STAGE(PG8_SB(1, 1), b3 + hstep, voffB); PG8_STAGE(PG8_SA(1, 0), a3, voffA);
            PG8_WAIT_V(8); PG8_WAIT_L(0); PG8_BAR; PG8_MMA(1, 0, At, B0); PG8_MMA(1, 1, At, B1); PG8_BAR; PG8_SCHED;
            } else {
            PG8_LDB(B0, 0, 0); PG8_SCHED; PG8_LDA(At, 0, 0); PG8_STAGE(PG8_SA(1, 1), a1 + hstepA, voffA);
            PG8_WAIT_L(8); PG8_BAR; PG8_WAIT_L(0); PG8_MMA(0, 0, At, B0); PG8_BAR; PG8_SCHED;
            PG8_LDB(B1, 0, 1); PG8_STAGE(PG8_SB(0, 0), b2, voffB);
            PG8_BAR; PG8_WAIT_L(0); PG8_MMA(0, 1, At, B1); PG8_BAR;
            PG8_LDA(At, 0, 1); PG8_STAGE(PG8_SA(0, 0), a2, voffA);
            PG8_BAR; PG8_WAIT_L(0); PG8_MMA(1, 0, At, B0); PG8_BAR; PG8_SCHED;
            PG8_STAGE(PG8_SB(0, 1), b2 + hstep, voffB);
            PG8_WAIT_V(6); PG8_BAR; PG8_MMA(1, 1, At, B1); PG8_BAR;
            PG8_LDB(B0, 1, 0); PG8_SCHED; PG8_LDA(At, 1, 0); PG8_STAGE(PG8_SA(0, 1), a2 + hstepA, voffA);
            PG8_WAIT_L(8); PG8_BAR; PG8_WAIT_L(0); PG8_MMA(0, 0, At, B0); PG8_BAR; PG8_SCHED;
            PG8_LDB(B1, 1, 1); PG8_STAGE(PG8_SB(1, 0), b3, voffB);
            PG8_BAR; PG8_WAIT_L(0); PG8_MMA(0, 1, At, B1); PG8_BAR;
            PG8_LDA(At, 1, 1); PG8_STAGE(PG8_SA(1, 0), a3, voffA);
            PG8_BAR; PG8_WAIT_L(0); PG8_MMA(1, 0, At, B0); PG8_BAR; PG8_SCHED;
            PG8_STAGE(PG8_SB(1, 1), b3 + hstep, voffB);
            PG8_WAIT_V(6); PG8_BAR; PG8_MMA(1, 1, At, B1); PG8_BAR;
            }
        }
        if constexpr (ALIGN_EPI) { if (wr == 0) PG8_BAR; }
        if constexpr (!Epi::AFTER_DRAIN) { E(acc, cur, wr, wc, fr, fq); S.done(cur); }
        if (!has_next) break;
#pragma unroll
        for (int a = 0; a < 2; ++a)
#pragma unroll
            for (int b = 0; b < 2; ++b)
#pragma unroll
                for (int m = 0; m < 4; ++m)
#pragma unroll
                    for (int n = 0; n < 2; ++n) acc[a][b][m][n] = (f32x4){0.f, 0.f, 0.f, 0.f};
        cur = nxt; cA = nA; cB = nB; ++ui;
        if constexpr (ALIGN_EPI) { if (wr == 1) PG8_BAR; }
    }
    PG8_WAIT_V(0);
    if constexpr (!ALIGN_EPI) { if (wr == 0) PG8_BAR; }
    PG8_BAR;
    if constexpr (Epi::AFTER_DRAIN) { E.fused(acc, cur, wr, wc, fr, fq, lds, wid, lane); S.done(cur); }
#undef PG8_SA
#undef PG8_SB
#undef PG8_STAGE
#undef PG8_LDA
#undef PG8_LDB
#undef PG8_MMA
#undef PG8_WAIT_V
#undef PG8_WAIT_L
#undef PG8_BAR
#undef PG8_SCHED
}
}

namespace att {
using bf16 = __hip_bfloat16;
constexpr int D = 128, NW = 8, QBLK = 32, KVBLK = 64;
constexpr float SCALE = 0.088388347648318440f;
constexpr float THR = 8.f;
constexpr int SDEPTH = 2;
constexpr size_t SHM_V = KVBLK * D * 2, SHM_K = KVBLK * D * 2, SHM_ATTN = 2 * SHM_V + 2 * SHM_K + NW * 64 * 4;
using bf16x8 = __attribute__((ext_vector_type(8))) short;
using s16x4  = __attribute__((ext_vector_type(4))) short;
using f32x16 = __attribute__((ext_vector_type(16))) float;
using f32x8  = __attribute__((ext_vector_type(8))) float;
using u32x4  = __attribute__((ext_vector_type(4))) unsigned;
#define KSWZ(row, colB) ((row) * 256 + ((colB) ^ (((row) & 7) << 4)))
#define SBAR() __builtin_amdgcn_sched_barrier(0)
__device__ __forceinline__ int crow(int r, int hi) { return (r & 3) + 8 * (r >> 2) + 4 * hi; }
__device__ __forceinline__ unsigned cvtpk(float lo, float hi) {
  unsigned r; asm volatile("v_cvt_pk_bf16_f32 %0, %1, %2" : "=v"(r) : "v"(lo), "v"(hi)); return r;
}
template <typename TIn> struct Stage;
template <> struct Stage<bf16>  { using T = bf16x8;
  __device__ static __forceinline__ T ld8(const bf16* p) { return *reinterpret_cast<const bf16x8*>(p); }
  __device__ static __forceinline__ bf16x8 tobf(T x) { return x; } };
template <> struct Stage<float> { using T = f32x8;
  __device__ static __forceinline__ T ld8(const float* p) { return *reinterpret_cast<const f32x8*>(p); }
  __device__ static __forceinline__ bf16x8 tobf(T x) {
    u32x4 w = {cvtpk(x[0], x[1]), cvtpk(x[2], x[3]), cvtpk(x[4], x[5]), cvtpk(x[6], x[7])}; return *reinterpret_cast<bf16x8*>(&w); } };

__device__ __forceinline__ void partialSM(f32x16& p0, f32x16& p1, float& m_reg, float& mn, float& alpha) {
  constexpr float C = SCALE * 1.4426950408889634f;
  float pmax = p0[0]; for (int r = 1; r < 16; ++r) pmax = fmaxf(pmax, p0[r]); for (int r = 0; r < 16; ++r) pmax = fmaxf(pmax, p1[r]);
  { auto rr = __builtin_amdgcn_permlane32_swap(__float_as_uint(pmax), __float_as_uint(pmax), false, false);
    pmax = fmaxf(__uint_as_float(rr[0]), __uint_as_float(rr[1])); }
  if (__builtin_expect(__all(pmax - m_reg <= THR / SCALE), 1)) { mn = m_reg; alpha = 1.f; }
  else { mn = fmaxf(m_reg, pmax); alpha = __builtin_amdgcn_exp2f((m_reg - mn) * C); m_reg = mn; }
  float mnC = -mn * C;
  for (int r = 0; r < 16; ++r) p0[r] = fmaf(p0[r], C, mnC); for (int r = 0; r < 16; ++r) p1[r] = fmaf(p1[r], C, mnC);
  for (int r = 0; r < 16; ++r) p0[r] = __builtin_amdgcn_exp2f(p0[r]);
}
__device__ __forceinline__ void finishSM(f32x16& p0, f32x16& p1, float alpha, float& l_reg, bf16x8& pa0, bf16x8& pa1, bf16x8& pa2, bf16x8& pa3) {
  for (int r = 0; r < 16; ++r) p1[r] = __builtin_amdgcn_exp2f(p1[r]);
  float ps = 0; for (int r = 0; r < 16; ++r) ps += p0[r]; for (int r = 0; r < 16; ++r) ps += p1[r];
  { auto rr = __builtin_amdgcn_permlane32_swap(__float_as_uint(ps), __float_as_uint(ps), false, false);
    ps = __uint_as_float(rr[0]) + __uint_as_float(rr[1]); }
  l_reg = l_reg * alpha + ps;
#define PK4(P, BASE, OUT) do { unsigned a0 = cvtpk(P[BASE + 0], P[BASE + 1]), a1 = cvtpk(P[BASE + 2], P[BASE + 3]);   \
    unsigned b0 = cvtpk(P[BASE + 4], P[BASE + 5]), b1 = cvtpk(P[BASE + 6], P[BASE + 7]);                              \
    auto r0 = __builtin_amdgcn_permlane32_swap(a0, b0, false, false); auto r1 = __builtin_amdgcn_permlane32_swap(a1, b1, false, false); \
    u32x4 w = {r0[0], r1[0], r0[1], r1[1]}; OUT = *reinterpret_cast<bf16x8*>(&w); } while (0)
  PK4(p0, 0, pa0); PK4(p0, 8, pa1); PK4(p1, 0, pa2); PK4(p1, 8, pa3);
#undef PK4
}
__device__ __forceinline__ void qkt(f32x16& p0, f32x16& p1, const bf16* Ks, const bf16x8* qr, int r32, int hi) {
  p0 = f32x16{}; p1 = f32x16{};
  for (int d0 = 0; d0 < 8; ++d0) { int cb = (d0 * 16 + hi * 8) * 2;
    bf16x8 b0 = *reinterpret_cast<const bf16x8*>((const char*)Ks + KSWZ(r32, cb));
    bf16x8 b1 = *reinterpret_cast<const bf16x8*>((const char*)Ks + KSWZ(32 + r32, cb));
    p0 = __builtin_amdgcn_mfma_f32_32x32x16_bf16(b0, qr[d0], p0, 0, 0, 0);
    p1 = __builtin_amdgcn_mfma_f32_32x32x16_bf16(b1, qr[d0], p1, 0, 0, 0); }
}
__device__ __forceinline__ int v_st(int k, int c) { const int kk = (k & ~0xC) | ((k & 4) << 1) | ((k & 8) >> 1); return ((kk >> 3) * 4 + (c >> 5)) * 512 + ((kk & 7) * 32 + (c & 31)) * 2; }
__device__ __forceinline__ int v_rd_base(int lane) { return ((lane & 3) << 3) | (((lane >> 2) & 3) << 6) | (((lane >> 4) & 1) << 5) | (((lane >> 5) & 1) << 8); }
constexpr int v_rd_off(int d0, int ks, int half) { return d0 * 512 + ks * 4096 + half * 2048; }
template <int OFF> __device__ __forceinline__ s16x4 tr_read(int vb) {
  s16x4 r; asm volatile("ds_read_b64_tr_b16 %0, %1 offset:%2" : "=&v"(r) : "v"(vb), "i"(OFF) : "memory"); return r;
}
template <int D0> __device__ __forceinline__ void pv_one(f32x16& od, int vb, bf16x8 pa0, bf16x8 pa1, bf16x8 pa2, bf16x8 pa3) {
  const s16x4 l0 = tr_read<v_rd_off(D0, 0, 0)>(vb), h0 = tr_read<v_rd_off(D0, 0, 1)>(vb), l1 = tr_read<v_rd_off(D0, 1, 0)>(vb), h1 = tr_read<v_rd_off(D0, 1, 1)>(vb);
  const s16x4 l2 = tr_read<v_rd_off(D0, 2, 0)>(vb), h2 = tr_read<v_rd_off(D0, 2, 1)>(vb), l3 = tr_read<v_rd_off(D0, 3, 0)>(vb), h3 = tr_read<v_rd_off(D0, 3, 1)>(vb);
  asm volatile("s_waitcnt lgkmcnt(0)" ::: "memory"); SBAR();
#define PK(L, H) (bf16x8){L[0], L[1], L[2], L[3], H[0], H[1], H[2], H[3]}
  od = __builtin_amdgcn_mfma_f32_32x32x16_bf16(pa0, PK(l0, h0), od, 0, 0, 0);
  od = __builtin_amdgcn_mfma_f32_32x32x16_bf16(pa1, PK(l1, h1), od, 0, 0, 0);
  od = __builtin_amdgcn_mfma_f32_32x32x16_bf16(pa2, PK(l2, h2), od, 0, 0, 0);
  od = __builtin_amdgcn_mfma_f32_32x32x16_bf16(pa3, PK(l3, h3), od, 0, 0, 0);
#undef PK
}
__device__ __forceinline__ void pv_d0(f32x16* o, int vb, bf16x8 pa0, bf16x8 pa1, bf16x8 pa2, bf16x8 pa3) {
  pv_one<0>(o[0], vb, pa0, pa1, pa2, pa3); pv_one<1>(o[1], vb, pa0, pa1, pa2, pa3); pv_one<2>(o[2], vb, pa0, pa1, pa2, pa3); pv_one<3>(o[3], vb, pa0, pa1, pa2, pa3);
}

template <typename TQ, int LDQ, int LDK, int LDO>
__device__ __forceinline__ void attn_dense_body(const TQ* __restrict__ Qb, const bf16* __restrict__ Kh, const bf16* __restrict__ Vh,
                                                unsigned short* __restrict__ Ob, int seq, char* lds) {
  using St = Stage<bf16>; using SQ = Stage<TQ>;
  const int tid = opaque_tid(), wid = tid >> 6, lane = tid & 63, r32 = lane & 31, hi = lane >> 5;
  bf16* V_lds = (bf16*)lds; bf16* K_lds = (bf16*)(lds + 2 * SHM_V);
  float* ws = (float*)(lds + 2 * SHM_V + 2 * SHM_K) + wid * 64; float* li_l = ws; float* al_l = ws + 32;
  float m_reg = -1e30f, l_reg = 0; f32x16 o[4] = {}; bf16x8 qr[8];
  const TQ* Qw = Qb + (long)(wid * QBLK + r32) * LDQ + hi * 8;
#pragma unroll
  for (int d0 = 0; d0 < 8; ++d0) qr[d0] = SQ::tobf(SQ::ld8(Qw + d0 * 16));
  const int sr = tid >> 4, sc = (tid & 15) * 8, vst0 = v_st(sr, sc), vst1 = v_st(32 + sr, sc);
  const int vb0 = (int)(uintptr_t)V_lds + v_rd_base(lane);
  struct { typename St::T vs0, vs1, ks0, ks1; } sr_[SDEPTH];
#define SLOAD(i, k0) do { sr_[i].vs0 = St::ld8(&Vh[(long)((k0) + sr) * LDK + sc]); sr_[i].vs1 = St::ld8(&Vh[(long)((k0) + 32 + sr) * LDK + sc]); \
    sr_[i].ks0 = St::ld8(&Kh[(long)((k0) + sr) * LDK + sc]); sr_[i].ks1 = St::ld8(&Kh[(long)((k0) + 32 + sr) * LDK + sc]); } while (0)
#define SWRITE(b, i) do { *(bf16x8*)((char*)V_lds + (b) * SHM_V + vst0) = St::tobf(sr_[i].vs0);          \
    *(bf16x8*)((char*)V_lds + (b) * SHM_V + vst1) = St::tobf(sr_[i].vs1); int kc = sc * 2;               \
    *(bf16x8*)((char*)K_lds + (b) * SHM_K + KSWZ(sr, kc)) = St::tobf(sr_[i].ks0);                       \
    *(bf16x8*)((char*)K_lds + (b) * SHM_K + KSWZ(32 + sr, kc)) = St::tobf(sr_[i].ks1); } while (0)
#define SWAIT() do { if constexpr (SDEPTH == 2) asm volatile("s_waitcnt vmcnt(4)" ::: "memory"); else asm volatile("s_waitcnt vmcnt(0)" ::: "memory"); } while (0)
#define RESC(a) do { if (__any((a) < 1.f)) { if (hi == 0) al_l[r32] = (a); asm volatile("s_waitcnt lgkmcnt(0)" ::: "memory"); \
    for (int d = 0; d < 4; ++d) for (int r = 0; r < 16; ++r) o[d][r] *= al_l[crow(r, hi)]; } } while (0)
  f32x16 pA0, pA1, pB0, pB1; float mnA, mnB, alA, alB; bf16x8 pa0, pa1, pa2, pa3; const int NT = seq / KVBLK;
  constexpr int SE = 0, SO = SDEPTH - 1;
  SLOAD(SE, 0); asm volatile("s_waitcnt vmcnt(0)" ::: "memory"); SWRITE(0, SE); __syncthreads();
  qkt(pA0, pA1, K_lds, qr, r32, hi); partialSM(pA0, pA1, m_reg, mnA, alA);
  SLOAD(SO, KVBLK); if constexpr (SDEPTH == 2) { if (2 < NT) SLOAD(SE, 2 * KVBLK); }
  SWAIT(); SWRITE(1, SO); __syncthreads();
  for (int j = 1; j + 1 < NT; j += 2) {
    SBAR(); qkt(pB0, pB1, (bf16*)((char*)K_lds + SHM_K), qr, r32, hi);
    finishSM(pA0, pA1, alA, l_reg, pa0, pa1, pa2, pa3); SBAR();
    SLOAD(SO, (j + SDEPTH) * KVBLK); SBAR();
    pv_d0(o, vb0, pa0, pa1, pa2, pa3); partialSM(pB0, pB1, m_reg, mnB, alB);
    __syncthreads(); SWAIT(); SWRITE(0, SE);
    RESC(alB); __syncthreads();
    SBAR(); qkt(pA0, pA1, K_lds, qr, r32, hi);
    finishSM(pB0, pB1, alB, l_reg, pa0, pa1, pa2, pa3); SBAR();
    if (SDEPTH == 1 || j + 3 < NT) SLOAD(SE, (j + 1 + SDEPTH) * KVBLK); SBAR();
    pv_d0(o, vb0 + (int)SHM_V, pa0, pa1, pa2, pa3); partialSM(pA0, pA1, m_reg, mnA, alA);
    __syncthreads(); SWAIT(); SWRITE(1, SO);
    RESC(alA); __syncthreads();
  }
  SBAR(); qkt(pB0, pB1, (bf16*)((char*)K_lds + SHM_K), qr, r32, hi);
  finishSM(pA0, pA1, alA, l_reg, pa0, pa1, pa2, pa3); SBAR();
  pv_d0(o, vb0, pa0, pa1, pa2, pa3); partialSM(pB0, pB1, m_reg, mnB, alB);
  __syncthreads(); RESC(alB);
  finishSM(pB0, pB1, alB, l_reg, pa0, pa1, pa2, pa3); SBAR();
  pv_d0(o, vb0 + (int)SHM_V, pa0, pa1, pa2, pa3);
  if (hi == 0) li_l[r32] = l_reg; asm volatile("s_waitcnt lgkmcnt(0)" ::: "memory");
  float rli[16];
#pragma unroll
  for (int r = 0; r < 16; ++r) rli[r] = __builtin_amdgcn_rcpf(li_l[crow(r, hi)]);
  unsigned short* Ow = Ob + (long)(wid * QBLK) * LDO;
#pragma unroll
  for (int r = 0; r < 16; ++r) { int orow = crow(r, hi);
    for (int d0 = 0; d0 < 4; ++d0) Ow[(long)orow * LDO + d0 * 32 + r32] = (unsigned short)(cvtpk(o[d0][r] * rli[r], 0.f) & 0xffffu); }
#undef SLOAD
#undef SWRITE
#undef SWAIT
#undef RESC
}

}

typedef const __attribute__((address_space(4))) unsigned char* kargp_t;
__device__ __forceinline__ unsigned char* karg_ptr(int byte_off) {
    kargp_t p = (kargp_t)__builtin_amdgcn_kernarg_segment_ptr(); asm volatile("" : "+s"(p));
    return *(unsigned char* const __attribute__((address_space(4)))*)(p + byte_off);
}
#define IN(k) ((const float*)karg_ptr(8 * (k)))
#define WS() (karg_ptr(168))
#define P_xlat ((float*)karg_ptr(160))
#define P_MOD ((float*)(WS() + WS_MOD))
#define P_xctx ((float*)(WS() + WS_XCTX))
#define P_GB ((float*)(WS() + WS_GB))
#define P_Wb ((bf16_t*)(WS() + WS_W))
#define P_BIG1 ((bf16_t*)(WS() + WS_BIG1))
#define P_BIG2 ((bf16_t*)(WS() + WS_BIG2))
#define MODL (P_MOD + (size_t)L * 17 * NMODC)
#define P_QKV ((bf16_t*)(WS() + WS_BIG1 + B1_QKV))
#define P_KB ((bf16_t*)(WS() + WS_BIG1 + B1_KB))
#define P_VB ((bf16_t*)(WS() + WS_BIG1 + B1_VB))
#define P_AO ((bf16_t*)(WS() + WS_BIG1 + B1_AO))

#define LAS __attribute__((address_space(3)))
typedef unsigned short bf16_t;
typedef short bf16x8 __attribute__((ext_vector_type(8)));
typedef float f32x4 __attribute__((ext_vector_type(4)));
typedef float f32x16 __attribute__((ext_vector_type(16)));
typedef unsigned u32x4 __attribute__((ext_vector_type(4)));
typedef unsigned u32x2 __attribute__((ext_vector_type(2)));

constexpr int DM = 1024, NB = 16, SEQ = 2048, CTXL = 256, NLAT = NB * SEQ, NCTX = NB * CTXL, MROWS = NLAT + NCTX;
constexpr int DFF = 2816, NMODC = 6 * DM, GIN1 = 4352, KVLEN = CTXL + SEQ;
constexpr float ALPHA = 1.6817928305074290f;
constexpr float EPS = 1e-6f;
constexpr int NTHR = 512, NWAVE = 8;

constexpr size_t WS_BAR  = 0, WS_BAR_BYTES = 16384;
constexpr size_t WS_MOD  = WS_BAR_BYTES;
constexpr size_t WS_XCTX = WS_MOD + (size_t)4 * 17 * NMODC * 4;
constexpr size_t WS_GB   = WS_XCTX + (size_t)NCTX * DM * 4;
constexpr size_t WS_W    = WS_GB + (size_t)MROWS * 64 * 4;
constexpr size_t W_A = 0, W_Z = W_A + (size_t)GIN1 * 1024, W_O = W_Z + (size_t)2048 * 1024, W_F1 = W_O + (size_t)2048 * 1024, W_F2 = W_F1 + (size_t)5632 * 1024, W_END = W_F2 + (size_t)1024 * DFF;
constexpr size_t WS_BIG1 = WS_W + W_END * 2;
constexpr size_t WS_BIG2 = WS_BIG1 + (size_t)MROWS * 4096 * 2;
constexpr size_t WS_END  = WS_BIG2 + (size_t)MROWS * 2048 * 2;
constexpr size_t B1_QKV = 0, B1_KB = (size_t)MROWS * 1536 * 2, B1_VB = B1_KB + (size_t)NB * 2 * KVLEN * 128 * 2, B1_AO = B1_VB + (size_t)NB * 2 * KVLEN * 128 * 2;

constexpr int LDS_BYTES = 161792, LDS_XB = 155008, LDS_S2 = 155648;

typedef float f32x2_t __attribute__((ext_vector_type(2))); typedef __bf16 bf16x2_t __attribute__((ext_vector_type(2)));
__device__ __forceinline__ unsigned cvtpk2(float lo, float hi) { f32x2_t v = {lo, hi}; bf16x2_t b = __builtin_convertvector(v, bf16x2_t); return __builtin_bit_cast(unsigned, b); }
__device__ __forceinline__ float bflo(unsigned u) { return __uint_as_float(u << 16); }
__device__ __forceinline__ float bfhi(unsigned u) { return __uint_as_float(u & 0xffff0000u); }
__device__ __forceinline__ float silu_f(float v) { return v * __builtin_amdgcn_rcpf(1.f + __builtin_amdgcn_exp2f(v * -1.4426950408889634f)); }
template <int X> __device__ __forceinline__ float swzx(float v) { return __uint_as_float((unsigned)__builtin_amdgcn_ds_swizzle((int)__float_as_uint(v), (X << 10) | 0x1f)); }
__device__ __forceinline__ float wave_sum(float v) {
    v += swzx<1>(v); v += swzx<2>(v); v += swzx<4>(v); v += swzx<8>(v); v += swzx<16>(v);
    auto rr = __builtin_amdgcn_permlane32_swap(__float_as_uint(v), __float_as_uint(v), false, false);
    return __uint_as_float(rr[0]) + __uint_as_float(rr[1]);
}
__device__ __forceinline__ int crow(int r, int hi) { return (r & 3) + 8 * (r >> 2) + 4 * hi; }

struct EpiPlainBf16 {
    static constexpr bool PERM = true, AFTER_DRAIN = false;
    bf16_t* O; int ldc;
    __device__ __forceinline__ void operator()(const pg8::f32x4 (&acc)[2][2][4][2], const pg8::Unit& u, int wr, int wc, int fr, int fq) const {
        const int row0 = u.pm * 256 + wr * 64 + fr, col0 = u.pn * 256 + wc * 32 + fq * 8;
#pragma unroll
        for (int ai = 0; ai < 2; ++ai)
#pragma unroll
            for (int m = 0; m < 4; ++m) { bf16_t* rp = O + (size_t)(row0 + ai * 128 + m * 16) * ldc + col0;
#pragma unroll
                for (int bj = 0; bj < 2; ++bj) { const pg8::f32x4 v0 = acc[ai][bj][m][0], v1 = acc[ai][bj][m][1];
                    *(u32x4*)(rp + bj * 128) = (u32x4){cvtpk2(v0[0], v0[1]), cvtpk2(v0[2], v0[3]), cvtpk2(v1[0], v1[1]), cvtpk2(v1[2], v1[3])}; } }
    }
};
struct EpiGdnIn {
    static constexpr bool PERM = true, AFTER_DRAIN = false;
    bf16_t* P; float* GB; const float* a_log; const float* dt_bias;
    __device__ __forceinline__ void operator()(const pg8::f32x4 (&acc)[2][2][4][2], const pg8::Unit& u, int wr, int wc, int fr, int fq) const {
        const int row0 = u.pm * 256 + wr * 64 + fr;
        if (u.pn < 16) {
            const int col0 = u.pn * 256 + wc * 32 + fq * 8;
#pragma unroll
            for (int ai = 0; ai < 2; ++ai)
#pragma unroll
                for (int m = 0; m < 4; ++m) { bf16_t* rp = P + (size_t)(row0 + ai * 128 + m * 16) * 4096 + col0;
#pragma unroll
                    for (int bj = 0; bj < 2; ++bj) { const pg8::f32x4 v0 = acc[ai][bj][m][0], v1 = acc[ai][bj][m][1];
                        *(u32x4*)(rp + bj * 128) = (u32x4){cvtpk2(v0[0], v0[1]), cvtpk2(v0[2], v0[3]), cvtpk2(v1[0], v1[1]), cvtpk2(v1[2], v1[3])}; } }
        } else if (wc < 2) {
#pragma unroll
            for (int n = 0; n < 2; ++n) {
                const int col = wc * 32 + fq * 8 + n * 4;
                float al[4], db[4];
#pragma unroll
                for (int e = 0; e < 4; ++e) { const int idx = (col + e) & 31; al[e] = __expf(a_log[idx]); db[e] = dt_bias[idx]; }
#pragma unroll
                for (int ai = 0; ai < 2; ++ai)
#pragma unroll
                    for (int m = 0; m < 4; ++m) { const pg8::f32x4 v = acc[ai][0][m][n]; f32x4 o;
#pragma unroll
                        for (int e = 0; e < 4; ++e) {
                            if (col < 32) o[e] = 1.f / (1.f + __expf(-v[e]));
                            else { const float xx = v[e] + db[e]; const float sp = xx > 20.f ? xx : log1pf(__expf(xx)); o[e] = -al[e] * sp; } }
                        *(f32x4*)(GB + (size_t)(row0 + ai * 128 + m * 16) * 64 + col) = o; }
            }
        }
    }
};
struct EpiGateZ {
    static constexpr bool PERM = true, AFTER_DRAIN = false;
    bf16_t* Y;
    __device__ __forceinline__ void operator()(const pg8::f32x4 (&acc)[2][2][4][2], const pg8::Unit& u, int wr, int wc, int fr, int fq) const {
        asm volatile("" : "+v"(fr));
        const int row0 = u.pm * 256 + wr * 64 + fr, col0 = u.pn * 256 + wc * 32 + fq * 8;
#pragma unroll
        for (int ai = 0; ai < 2; ++ai) {
            u32x4 on[4][2];
#pragma unroll
            for (int m = 0; m < 4; ++m)
#pragma unroll
                for (int bj = 0; bj < 2; ++bj) on[m][bj] = *(const u32x4*)(Y + (size_t)(row0 + ai * 128 + m * 16) * 4096 + col0 + bj * 128);
#pragma unroll
            for (int m = 0; m < 4; ++m)
#pragma unroll
                for (int bj = 0; bj < 2; ++bj) { const pg8::f32x4 v0 = acc[ai][bj][m][0], v1 = acc[ai][bj][m][1]; const u32x4 o = on[m][bj];
                    *(u32x4*)(Y + (size_t)(row0 + ai * 128 + m * 16) * 4096 + col0 + bj * 128) =
                        (u32x4){cvtpk2(bflo(o.x) * silu_f(v0[0]), bfhi(o.x) * silu_f(v0[1])), cvtpk2(bflo(o.y) * silu_f(v0[2]), bfhi(o.y) * silu_f(v0[3])),
                                cvtpk2(bflo(o.z) * silu_f(v1[0]), bfhi(o.z) * silu_f(v1[1])), cvtpk2(bflo(o.w) * silu_f(v1[2]), bfhi(o.w) * silu_f(v1[3]))}; }
        }
    }
};
struct EpiResid {
    static constexpr bool PERM = true, AFTER_DRAIN = false;
    float* xlat; float* xctx; const float* gate; float alpha, gs;
    __device__ __forceinline__ void operator()(const pg8::f32x4 (&acc)[2][2][4][2], const pg8::Unit& u, int wr, int wc, int fr, int fq) const {
        asm volatile("" : "+v"(fr));
        const int pm = u.pm;
        float* xb = pm < 128 ? xlat + (size_t)pm * 256 * DM : xctx + (size_t)(pm - 128) * 256 * DM;
        const float* gp = gate + (size_t)(pm < 128 ? (pm >> 3) : 16) * NMODC;
        const int col0 = u.pn * 256 + wc * 32 + fq * 8, r0 = wr * 64 + fr;
#pragma unroll
        for (int bj = 0; bj < 2; ++bj) { const int col = col0 + bj * 128; const f32x4 g0 = *(const f32x4*)(gp + col) * gs, g1 = *(const f32x4*)(gp + col + 4) * gs;
#pragma unroll
            for (int ai = 0; ai < 2; ++ai) {
                f32x4 x0[4], x1[4];
#pragma unroll
                for (int m = 0; m < 4; ++m) { const float* p = xb + (size_t)(r0 + ai * 128 + m * 16) * DM + col; x0[m] = *(const f32x4*)p; x1[m] = *(const f32x4*)(p + 4); }
#pragma unroll
                for (int m = 0; m < 4; ++m) { float* p = xb + (size_t)(r0 + ai * 128 + m * 16) * DM + col; const pg8::f32x4 a0 = acc[ai][bj][m][0], a1 = acc[ai][bj][m][1]; f32x4 y0, y1;
#pragma unroll
                    for (int e = 0; e < 4; ++e) { y0[e] = x0[m][e] * alpha + g0[e] * a0[e]; y1[e] = x1[m][e] * alpha + g1[e] * a1[e]; }
                    *(f32x4*)p = y0; *(f32x4*)(p + 4) = y1; }
            }
        }
    }
};
struct EpiSwiglu {
    static constexpr bool PERM = true, AFTER_DRAIN = false;
    bf16_t* ACT;
    __device__ __forceinline__ void operator()(const pg8::f32x4 (&acc)[2][2][4][2], const pg8::Unit& u, int wr, int wc, int fr, int fq) const {
        const int row0 = u.pm * 256 + wr * 64 + fr, col0 = u.pn * 128 + wc * 32 + fq * 8;
#pragma unroll
        for (int ai = 0; ai < 2; ++ai)
#pragma unroll
            for (int m = 0; m < 4; ++m) { const pg8::f32x4 g0 = acc[ai][0][m][0], g1 = acc[ai][0][m][1], u0 = acc[ai][1][m][0], u1 = acc[ai][1][m][1];
                *(u32x4*)(ACT + (size_t)(row0 + ai * 128 + m * 16) * DFF + col0) = (u32x4){cvtpk2(silu_f(g0[0]) * u0[0], silu_f(g0[1]) * u0[1]), cvtpk2(silu_f(g0[2]) * u0[2], silu_f(g0[3]) * u0[3]),
                                                                                        cvtpk2(silu_f(g1[0]) * u1[0], silu_f(g1[1]) * u1[1]), cvtpk2(silu_f(g1[2]) * u1[2], silu_f(g1[3]) * u1[3])}; }
    }
};

__device__ __forceinline__ void phase_mod(const float* c, const float* c_ctx, const float* w_mod, const float* b_mod, float* MOD, LAS unsigned char* lds, int G, int bid) {
    const int tid = opaque_tid(), wave = tid >> 6, lane = tid & 63;
    LAS float* sc = (LAS float*)lds;
    LAS float* red = (LAS float*)(lds + 81920);
    if (bid < 384) {
        for (int idx = tid; idx < 17 * 1024; idx += NTHR) { const int row = idx >> 10, k = idx & 1023; const float v = row < 16 ? c[row * 1024 + k] : c_ctx[k]; sc[k * 20 + row] = v / (1.f + expf(-v)); }
    }
    __syncthreads();
    for (int item = bid; item < 384; item += G) {
        const int layer = item / 96, cgp = item % 96;
        const float* w = w_mod + (size_t)layer * 1024 * NMODC + cgp * 64 + lane;
        float acc[17];
#pragma unroll
        for (int r = 0; r < 17; ++r) acc[r] = 0.f;
        const int k0 = wave * 128;
        for (int kb = k0; kb < k0 + 128; kb += 16) {
            float wv[16];
#pragma unroll
            for (int q = 0; q < 16; ++q) wv[q] = __builtin_nontemporal_load(&w[(size_t)(kb + q) * NMODC]);
#pragma unroll
            for (int q = 0; q < 16; ++q) {
#pragma unroll
                for (int r = 0; r < 17; ++r) acc[r] += sc[(kb + q) * 20 + r] * wv[q]; }
        }
#pragma unroll
        for (int r = 0; r < 17; ++r) red[(wave * 17 + r) * 64 + lane] = acc[r];
        __syncthreads();
        for (int idx = tid; idx < 17 * 64; idx += NTHR) { const int r = idx >> 6, l = idx & 63; float s = 0.f;
#pragma unroll
            for (int wv = 0; wv < 8; ++wv) s += red[(wv * 17 + r) * 64 + l];
            MOD[(size_t)(layer * 17 + r) * NMODC + cgp * 64 + l] = s + b_mod[layer * NMODC + cgp * 64 + l]; }
        __syncthreads();
    }
}

__device__ __forceinline__ int srcmap(int mode, int n, int off) {
    if (mode == 0) return n + off;
    if (mode == 1) return n < 4096 ? n : (n < 4160 ? n + 2048 : -1);
    return ((n >> 7) & 1) * DFF + ((n >> 8) << 7) + (n & 127);
}
__device__ __forceinline__ void transpose_item(const float* W, int Nsrc, bf16_t* WT, int K, int mode, int off, int nblk, LAS float* scr, int item, int lane) {
    const int kb = item / nblk, nb = item % nblk, k0 = 64 * kb, n0 = 32 * nb;
    const int sc = srcmap(mode, n0 + (lane & 31), off);
    float wv_[32];
#pragma unroll
    for (int i = 0; i < 32; ++i) { const int kk = 2 * i + (lane >> 5); wv_[i] = sc >= 0 ? __builtin_nontemporal_load(&W[(size_t)(k0 + kk) * Nsrc + sc]) : 0.f; }
#pragma unroll
    for (int i = 0; i < 32; ++i) { const int kk = 2 * i + (lane >> 5); scr[kk * 33 + (lane & 31)] = wv_[i]; }
    asm volatile("s_waitcnt lgkmcnt(0)" ::: "memory");
    const int c = lane & 7;
#pragma unroll
    for (int j = 0; j < 4; ++j) { const int n = (lane >> 3) + 8 * j; const LAS float* s = scr + (8 * c) * 33 + n;
        u32x4 o; o.x = cvtpk2(s[0 * 33], s[1 * 33]); o.y = cvtpk2(s[2 * 33], s[3 * 33]); o.z = cvtpk2(s[4 * 33], s[5 * 33]); o.w = cvtpk2(s[6 * 33], s[7 * 33]);
        *(u32x4*)(WT + (size_t)(n0 + n) * K + k0 + 8 * c) = o; }
    asm volatile("s_waitcnt lgkmcnt(0)" ::: "memory");
}
struct ConvJob { const float* W; bf16_t* WT; int Nsrc, K, mode, off, nblk, nitems; };
__device__ __forceinline__ void phase_convert(int L, bf16_t* Wb, LAS unsigned char* lds, int G, int bid, int jobmask, int b0) {
    if (bid < b0) return;
    const int tid_ = opaque_tid(), lane = tid_ & 63, wave = __builtin_amdgcn_readfirstlane(tid_ >> 6), gw = (bid - b0) * NWAVE + wave, NGW = (G - b0) * NWAVE;
    LAS float* scr = (LAS float*)(lds + wave * 8448);
    const int j = L >> 1;
    ConvJob jb[5]; int nj = 0;
    if (!(L & 1)) {
        jb[0] = ConvJob{IN(10) + (size_t)j * 1024 * 6208, Wb + W_A, 6208, 1024, 1, 0, GIN1 / 32, (GIN1 / 32) * 16};
        jb[1] = ConvJob{IN(10) + (size_t)j * 1024 * 6208, Wb + W_Z, 6208, 1024, 0, 4096, 64, 64 * 16};
        jb[2] = ConvJob{IN(15) + (size_t)j * 2048 * 1024, Wb + W_O, 1024, 2048, 0, 0, 32, 32 * 32};
        nj = 3;
    } else {
        jb[0] = ConvJob{IN(16) + (size_t)j * 1024 * 1536, Wb + W_A, 1536, 1024, 0, 0, 48, 48 * 16};
        jb[1] = ConvJob{IN(19) + (size_t)j * 1024 * 1024, Wb + W_O, 1024, 1024, 0, 0, 32, 32 * 16};
        jb[2] = ConvJob{IN(19), Wb + W_O, 1024, 1024, 0, 0, 32, 0};
        nj = 3;
    }
    jb[3] = ConvJob{IN(8) + (size_t)L * 1024 * 5632, Wb + W_F1, 5632, 1024, 2, 0, 176, 176 * 16};
    jb[4] = ConvJob{IN(9) + (size_t)L * DFF * 1024, Wb + W_F2, 1024, DFF, 0, 0, 32, 32 * 44};
    (void)nj;
#pragma unroll
    for (int q = 0; q < 5; ++q) if (!((jobmask >> q) & 1)) jb[q].nitems = 0;
    const int total = jb[0].nitems + jb[1].nitems + jb[2].nitems + jb[3].nitems + jb[4].nitems;
    for (int it = gw; it < total; it += NGW) {
        int r = it;
#pragma unroll
        for (int q = 0; q < 5; ++q) {
            if (r >= 0 && r < jb[q].nitems) { transpose_item(jb[q].W, jb[q].Nsrc, jb[q].WT, jb[q].K, jb[q].mode, jb[q].off, jb[q].nblk, scr, r, lane); r = -1; }
            else if (r >= 0) r -= jb[q].nitems;
        }
    }
}

__device__ __forceinline__ void phase_prep(const float* src_lat, const float* src_ctx, float* xlat, float* xctx, bool write_x, const float* lng, const float* lnb,
                                           bf16_t* H, const float* shift, const float* scale, int nrows, int G, int bid) {
    const int tid_ = opaque_tid(), lane = tid_ & 63, gw = bid * NWAVE + __builtin_amdgcn_readfirstlane(tid_ >> 6), NGW = G * NWAVE;
    const int R = (nrows + NGW - 1) / NGW, rbeg = gw * R, rend = (rbeg + R < nrows) ? rbeg + R : nrows;
    f32x4 vn[4], g[4], bb[4], sh[4], scv[4];
#pragma unroll
    for (int j = 0; j < 4; ++j) { g[j] = (f32x4){1.f, 1.f, 1.f, 1.f}; bb[j] = (f32x4){0.f, 0.f, 0.f, 0.f}; sh[j] = bb[j]; scv[j] = bb[j]; vn[j] = bb[j]; }
    if (lng) {
#pragma unroll
        for (int j = 0; j < 4; ++j) { g[j] = *(const f32x4*)(lng + 4 * lane + 256 * j); bb[j] = *(const f32x4*)(lnb + 4 * lane + 256 * j); }
    }
    if (rbeg < rend) { const float* sp = rbeg < NLAT ? src_lat + (size_t)rbeg * DM : src_ctx + (size_t)(rbeg - NLAT) * DM;
#pragma unroll
        for (int j = 0; j < 4; ++j) vn[j] = *(const f32x4*)(sp + 4 * lane + 256 * j); }
    int curmod = -1;
    for (int row = rbeg; row < rend; ++row) {
        const bool islat = row < NLAT;
        f32x4 v[4];
#pragma unroll
        for (int j = 0; j < 4; ++j) v[j] = vn[j];
        if (row + 1 < rend) { const int rn = row + 1; const float* sp = rn < NLAT ? src_lat + (size_t)rn * DM : src_ctx + (size_t)(rn - NLAT) * DM;
#pragma unroll
            for (int j = 0; j < 4; ++j) vn[j] = *(const f32x4*)(sp + 4 * lane + 256 * j); }
        const int modrow = islat ? (row >> 11) : 16;
        if (H && modrow != curmod) { curmod = modrow; const size_t mo = (size_t)modrow * NMODC;
#pragma unroll
            for (int j = 0; j < 4; ++j) { sh[j] = *(const f32x4*)(shift + mo + 4 * lane + 256 * j); scv[j] = *(const f32x4*)(scale + mo + 4 * lane + 256 * j); } }
        if (lng) {
            float s = 0.f;
#pragma unroll
            for (int j = 0; j < 4; ++j) s += (v[j][0] + v[j][1]) + (v[j][2] + v[j][3]);
            const float mean = wave_sum(s) * (1.f / DM); float s2 = 0.f;
#pragma unroll
            for (int j = 0; j < 4; ++j) { v[j] = v[j] - mean; s2 += (v[j][0] * v[j][0] + v[j][1] * v[j][1]) + (v[j][2] * v[j][2] + v[j][3] * v[j][3]); }
            const float rstd = rsqrtf(wave_sum(s2) * (1.f / DM) + EPS);
#pragma unroll
            for (int j = 0; j < 4; ++j) v[j] = v[j] * rstd * g[j] + bb[j];
        }
        if (write_x) { float* xp = islat ? xlat + (size_t)row * DM : xctx + (size_t)(row - NLAT) * DM;
#pragma unroll
            for (int j = 0; j < 4; ++j) *(f32x4*)(xp + 4 * lane + 256 * j) = v[j]; }
        if (H) {
#pragma unroll
            for (int j = 0; j < 4; ++j) { const f32x4 h = v[j] * (scv[j] + 1.f) + sh[j]; u32x2 w; w.x = cvtpk2(h[0], h[1]); w.y = cvtpk2(h[2], h[3]); *(u32x2*)(H + (size_t)row * DM + 4 * lane + 256 * j) = w; } }
    }
}

__device__ __forceinline__ void phase_qkvpost(bf16_t* QKV, bf16_t* KB, bf16_t* VB, const float* qn, const float* kn, int G, int bid) {
    const int tid_ = opaque_tid(), lane = tid_ & 63, gw = bid * NWAVE + __builtin_amdgcn_readfirstlane(tid_ >> 6), NGW = G * NWAVE;
    const float L2T = 13.287712379549449f / 32.f;
    const int d0 = 2 * lane;
    const float f0 = exp2f(-(float)(d0 & 31) * L2T), f1 = exp2f(-(float)((d0 + 1) & 31) * L2T);
    const float qw0 = qn[d0], qw1 = qn[d0 + 1], kw0 = kn[d0], kw1 = kn[d0 + 1];
    unsigned rawn[12];
    if (gw < MROWS) {
#pragma unroll
        for (int head = 0; head < 12; ++head) rawn[head] = *(const unsigned*)(QKV + (size_t)gw * 1536 + d0 + head * 128);
    }
    for (int row = gw; row < MROWS; row += NGW) {
        const bool islat = row < NLAT;
        int b, pos; float c0 = 1.f, s0 = 0.f, c1 = 1.f, s1 = 0.f;
        unsigned rawc[12];
#pragma unroll
        for (int head = 0; head < 12; ++head) rawc[head] = rawn[head];
        if (row + NGW < MROWS) {
#pragma unroll
            for (int head = 0; head < 12; ++head) rawn[head] = *(const unsigned*)(QKV + (size_t)(row + NGW) * 1536 + d0 + head * 128);
        }
        if (islat) { b = row >> 11; const int t = row & 2047; pos = CTXL + t; const float p = (lane < 32) ? (float)(t >> 6) : (float)(t & 63); sincosf(p * f0, &s0, &c0); sincosf(p * f1, &s1, &c1); }
        else { const int r2 = row - NLAT; b = r2 >> 8; pos = r2 & 255; }
        bf16_t* base = QKV + (size_t)row * 1536 + d0;
        unsigned outv[12];
#pragma unroll
        for (int head = 0; head < 12; ++head) {
            const unsigned raw = rawc[head];
            float x0 = bflo(raw), x1 = bfhi(raw);
            if (head < 10) {
                const float ss = wave_sum(x0 * x0 + x1 * x1);
                const float rstd = rsqrtf(ss * (1.f / 128.f) + EPS);
                x0 *= rstd * (head < 8 ? qw0 : kw0); x1 *= rstd * (head < 8 ? qw1 : kw1);
                if (islat) {
                    float p0 = swzx<16>(x0), p1 = swzx<16>(x1);
                    if (!(lane & 16)) { p0 = -p0; p1 = -p1; }
                    x0 = x0 * c0 + p0 * s0; x1 = x1 * c1 + p1 * s1;
                }
            }
            outv[head] = cvtpk2(x0, x1);
        }
#pragma unroll
        for (int head = 0; head < 12; ++head) {
            if (head < 8) *(unsigned*)(base + head * 128) = outv[head];
            else { const int kvh = (head - 8) & 1; bf16_t* dst = (head < 10 ? KB : VB) + ((size_t)(b * 2 + kvh) * KVLEN + pos) * 128 + d0; *(unsigned*)dst = outv[head]; }
        }
    }
}


#ifndef GDN_TRIVIAL
#define GDN_TRIVIAL 0
#endif
namespace gdn {
#ifndef GDN_SB
#define GDN_SB 0
#endif
#if GDN_SB
#define SB_() __builtin_amdgcn_sched_barrier(0)
#else
#define SB_() do {} while (0)
#endif
constexpr int SQ = 272;
constexpr int SK = 144;
constexpr int OFF_Q = 0, OFF_K = 17408  , OFF_KT = 35840, OFF_VT = 54272  , OFF_T1 = 72704, OFF_T2 = 81920,
              OFF_A = 91136  , OFF_QK = 108544, OFF_ST = 117760, OFF_SM = 152576, GDN_LDS = 154624;
static_assert(GDN_LDS <= LDS_BYTES, "lds");
__device__ __forceinline__ bf16x8 ldf(const LAS unsigned char* p) { return *(const LAS bf16x8*)p; }
__device__ __forceinline__ f32x16 mfma(bf16x8 a, bf16x8 b, f32x16 c) { return __builtin_amdgcn_mfma_f32_32x32x16_bf16(a, b, c, 0, 0, 0); }
__device__ __forceinline__ unsigned short bf1(float v) { return (unsigned short)(cvtpk2(v, 0.f) & 0xffffu); }

__device__ __forceinline__ void conv_phase(const bf16_t* P, const float* __restrict__ convw, bf16_t* OUT, int which, int G, int bid) {
    const int tid = opaque_tid();
    const int gtid = bid * NTHR + tid, nthr = G * NTHR;
    const int cgc = gtid & 255, col = (which ? 2048 : 0) + cgc * 8;
    float cw[5][8];
#pragma unroll
    for (int j = 0; j < 5; ++j) { const f32x4 a = *(const f32x4*)(convw + j * 4096 + col), c = *(const f32x4*)(convw + j * 4096 + col + 4);
        cw[j][0] = a[0]; cw[j][1] = a[1]; cw[j][2] = a[2]; cw[j][3] = a[3]; cw[j][4] = c[0]; cw[j][5] = c[1]; cw[j][6] = c[2]; cw[j][7] = c[3]; }
    const float qs = (!which && col < 1024) ? 0.08838834764831845f : 1.f;
#define GDN_CONV_LOAD(dst, uu) do { const int r0_ = ((uu) >> 8) * 8; const bool il_ = r0_ < NLAT; const int t0_ = il_ ? (r0_ & 2047) : ((r0_ - NLAT) & 255); const int T_ = il_ ? SEQ : CTXL; \
        _Pragma("unroll") for (int rr = 0; rr < 12; ++rr) { const int t = t0_ - 2 + rr; dst[rr] = (t >= 0 && t < T_) ? *(const u32x4*)(P + (size_t)(r0_ - 2 + rr) * 4096 + col) : (u32x4){0u, 0u, 0u, 0u}; } } while (0)
    u32x4 raw[12], nxt[12];
    if (gtid < (MROWS / 8) * 256) GDN_CONV_LOAD(nxt, gtid);
    for (int u = gtid; u < (MROWS / 8) * 256; u += nthr) {
        const int row0 = (u >> 8) * 8;
#pragma unroll
        for (int rr = 0; rr < 12; ++rr) raw[rr] = nxt[rr];
        if (u + nthr < (MROWS / 8) * 256) GDN_CONV_LOAD(nxt, u + nthr);
#pragma unroll
        for (int tt = 0; tt < 8; ++tt) {
            float y[8];
#pragma unroll
            for (int e = 0; e < 8; ++e) y[e] = 0.f;
#pragma unroll
            for (int j = 0; j < 5; ++j) { const u32x4 rw = raw[tt + j];
                y[0] += bflo(rw.x) * cw[j][0]; y[1] += bfhi(rw.x) * cw[j][1]; y[2] += bflo(rw.y) * cw[j][2]; y[3] += bfhi(rw.y) * cw[j][3];
                y[4] += bflo(rw.z) * cw[j][4]; y[5] += bfhi(rw.z) * cw[j][5]; y[6] += bflo(rw.w) * cw[j][6]; y[7] += bfhi(rw.w) * cw[j][7]; }
            float ss = 0.f;
#pragma unroll
            for (int e = 0; e < 8; ++e) { y[e] = silu_f(y[e]); ss += y[e] * y[e]; }
            if (!which) {
                ss += swzx<1>(ss); ss += swzx<2>(ss); ss += swzx<4>(ss); ss += swzx<8>(ss);
                const float sc = rsqrtf(ss + EPS) * qs;
#pragma unroll
                for (int e = 0; e < 8; ++e) y[e] *= sc;
            }
            const u32x4 o = (u32x4){cvtpk2(y[0], y[1]), cvtpk2(y[2], y[3]), cvtpk2(y[4], y[5]), cvtpk2(y[6], y[7])};
            if (which) *(u32x4*)(OUT + (size_t)(row0 + tt) * 4096 + cgc * 8) = o; else *(u32x4*)(OUT + (size_t)(row0 + tt) * 2048 + cgc * 8) = o;
        }
    }
}

__device__ __forceinline__ void core(const bf16_t* QK, const bf16_t* PV, const float* __restrict__ GB, const float* __restrict__ norm_g,
                                     bf16_t* O, LAS unsigned char* lds, int G, int bid) {
    const int tid0 = opaque_tid(), wave = __builtin_amdgcn_readfirstlane(tid0 >> 6);
    LAS float* sm_gcum = (LAS float*)(lds + OFF_SM);
    LAS float* sm_beta = sm_gcum + 64;
    LAS float* sm_eg = sm_gcum + 128;
    LAS float* sm_e2 = sm_gcum + 192;
    LAS float* sm_egl = sm_gcum + 256;
    LAS float* Af = (LAS float*)(lds + OFF_A);
    const int ten = wave >> 1;
    const int ti = wave >> 2, tc = wave & 3, td = wave & 3;
    for (int item = bid; item < 256; item += G) {
        const int b = item >> 4, h = item & 15, hk = h >> 1;
        for (int dir = 0; dir < 2; ++dir) {
            f32x16 S0, S1;
#pragma unroll
            for (int r = 0; r < 16; ++r) { S0[r] = 0.f; S1[r] = 0.f; }
            __syncthreads();
            for (int q = tid0; q < 34816 / 16; q += NTHR) *(LAS u32x4*)(lds + OFF_ST + q * 16) = (u32x4){0u, 0u, 0u, 0u};
            __syncthreads();
            u32x4 pf[8];
#define GDN_PREFETCH(qq) do { if (wave < 6) { const int sq_ = (qq) >= 4, n_ = sq_ ? (qq) - 4 : (qq), T_ = sq_ ? SEQ : CTXL, rb_ = sq_ ? b * SEQ : NLAT + b * CTXL; \
        const int cc_ = dir ? T_ - 64 * (n_ + 1) : 64 * n_; const int pt_ = opaque_tid() & 127; \
        const bf16_t* sp_ = (ten == 2 ? PV + h * 128 : QK + ten * 1024 + hk * 128) + (ten ? (pt_ >> 3) : (pt_ & 15)) * 8; const size_t st_ = ten == 2 ? 4096 : 2048; \
        _Pragma("unroll") for (int tt_ = 0; tt_ < 8; ++tt_) pf[tt_] = *(const u32x4*)(sp_ + (size_t)(rb_ + cc_ + 8 * (ten ? (pt_ & 7) : (pt_ >> 4)) + tt_) * st_); } } while (0)
#pragma unroll
            for (int tt = 0; tt < 8; ++tt) pf[tt] = (u32x4){0u, 0u, 0u, 0u};
            GDN_PREFETCH(0);
            {
                for (int qc = 0; qc < 36; ++qc) {
                    const int seqi = qc >= 4, n = seqi ? qc - 4 : qc;
                    const int T = seqi ? SEQ : CTXL; const int rowbase = seqi ? b * SEQ : NLAT + b * CTXL;
                    const int c0 = dir ? T - 64 * (n + 1) : 64 * n;
                    int tid = tid0; asm volatile("" : "+v"(tid));
                    const int lane = tid & 63, l31 = lane & 31, hi = lane >> 5, idx = tid & 127, seg = ten ? (idx & 7) : (idx >> 4), cgp = ten ? (idx >> 3) : (idx & 15);
                    if (wave < 6) {
                        unsigned pk[8][4];
#pragma unroll
                        for (int tt = 0; tt < 8; ++tt) { pk[tt][0] = pf[tt].x; pk[tt][1] = pf[tt].y; pk[tt][2] = pf[tt].z; pk[tt][3] = pf[tt].w; }
                        if (ten < 2) {
                            LAS unsigned char* dst = lds + (ten == 0 ? OFF_Q : OFF_K) + cgp * 16;
#pragma unroll
                            for (int tt = 0; tt < 8; ++tt) { const int i = dir ? 63 - (8 * seg + tt) : 8 * seg + tt; *(LAS u32x4*)(dst + i * SQ) = (u32x4){pk[tt][0], pk[tt][1], pk[tt][2], pk[tt][3]}; }
                        }
                        if (ten >= 1) {
                            LAS unsigned char* dst = lds + (ten == 1 ? OFF_KT : OFF_VT) + (dir ? 56 - 8 * seg : 8 * seg) * 2;
#pragma unroll
                            for (int e = 0; e < 8; ++e) {
                                unsigned v[8];
#pragma unroll
                                for (int s = 0; s < 8; ++s) { const unsigned a = dir ? pk[7 - s][e >> 1] : pk[s][e >> 1]; v[s] = (e & 1) ? (a >> 16) : (a & 0xffffu); }
                                *(LAS u32x4*)(dst + (cgp * 8 + e) * SK) = (u32x4){v[0] | (v[1] << 16), v[2] | (v[3] << 16), v[4] | (v[5] << 16), v[6] | (v[7] << 16)};
                            }
                        }
                    } else if (wave == 6) {
                        const int t = dir ? c0 + 63 - lane : c0 + lane;
                        const float* gb = GB + (size_t)(rowbase + t) * 64;
                        const float beta = gb[dir * 16 + h]; const float g = gb[32 + dir * 16 + h];
                        float cs = g;
#pragma unroll
                        for (int off = 1; off < 64; off <<= 1) { const float v = __uint_as_float((unsigned)__builtin_amdgcn_ds_bpermute(((lane - off) & 63) << 2, (int)__float_as_uint(cs))); if (lane >= off) cs += v; }
                        const float glast = __uint_as_float((unsigned)__builtin_amdgcn_readlane((int)__float_as_uint(cs), 63));
                        sm_gcum[lane] = cs; sm_beta[lane] = beta; sm_eg[lane] = __expf(cs); sm_e2[lane] = __expf(glast - cs);
                        if (lane == 0) sm_egl[0] = __expf(glast);
                    }
                    __syncthreads();
                    if (qc + 1 < 36) GDN_PREFETCH(qc + 1);
                    if (wave < 4) {
                        if (wave < 2) {
                            const int bb = wave ? 32 : 0;
                            f32x16 acc;
#pragma unroll
                            for (int r = 0; r < 16; ++r) acc[r] = 0.f;
#pragma unroll
                            for (int kk = 0; kk < 8; ++kk) acc = mfma(ldf(lds + OFF_K + (bb + l31) * SQ + (16 * kk + 8 * hi) * 2), ldf(lds + OFF_K + (bb + l31) * SQ + (16 * kk + 8 * hi) * 2), acc);
                            const int j = bb + l31; const float gj = sm_gcum[j];
                            LAS float* Ab = (LAS float*)(lds + OFF_A + (wave ? 4608 : 0));
#pragma unroll
                            for (int r = 0; r < 16; ++r) { const int i = bb + crow(r, hi); const float val = (i > j) ? sm_beta[i] * acc[r] * __expf(sm_gcum[i] - gj) : 0.f; Ab[crow(r, hi) * 36 + l31] = val; }
                        } else if (wave == 2) {
                            f32x16 acc;
#pragma unroll
                            for (int r = 0; r < 16; ++r) acc[r] = 0.f;
#pragma unroll
                            for (int kk = 0; kk < 8; ++kk) acc = mfma(ldf(lds + OFF_K + l31 * SQ + (16 * kk + 8 * hi) * 2), ldf(lds + OFF_K + (32 + l31) * SQ + (16 * kk + 8 * hi) * 2), acc);
                            const int i = 32 + l31; const float gi = sm_gcum[i], bi = sm_beta[i];
#pragma unroll
                            for (int g4 = 0; g4 < 4; ++g4) { const int j0 = 8 * g4 + 4 * hi; float v[4];
#pragma unroll
                                for (int e = 0; e < 4; ++e) v[e] = bi * acc[4 * g4 + e] * __expf(gi - sm_gcum[j0 + e]);
                                *(LAS u32x2*)(lds + LDS_S2 + l31 * 64 + j0 * 2) = (u32x2){cvtpk2(v[0], v[1]), cvtpk2(v[2], v[3])}; }
                        }
                    } else {
                        const int w4 = wave - 4, aj = w4 >> 1, ai = w4 & 1;
                        f32x16 acc;
#pragma unroll
                        for (int r = 0; r < 16; ++r) acc[r] = 0.f;
                        if (!(aj == 1 && ai == 0)) {
#pragma unroll
                            for (int kk = 0; kk < 8; ++kk) acc = mfma(ldf(lds + OFF_K + (32 * aj + l31) * SQ + (16 * kk + 8 * hi) * 2), ldf(lds + OFF_Q + (32 * ai + l31) * SQ + (16 * kk + 8 * hi) * 2), acc);
                        }
                        const int i = 32 * ai + l31; const float gi = sm_gcum[i];
#pragma unroll
                        for (int g4 = 0; g4 < 4; ++g4) { const int j0 = 32 * aj + 8 * g4 + 4 * hi; float v[4];
#pragma unroll
                            for (int e = 0; e < 4; ++e) { const int j = j0 + e; v[e] = (i >= j) ? acc[4 * g4 + e] * __expf(gi - sm_gcum[j]) : 0.f; }
                            *(LAS u32x2*)(lds + OFF_QK + i * SK + j0 * 2) = (u32x2){cvtpk2(v[0], v[1]), cvtpk2(v[2], v[3])}; }
                    }
                    f32x16 a1;
#pragma unroll
                    for (int r = 0; r < 16; ++r) a1[r] = 0.f;
                    if (wave >= 2) {
#pragma unroll
                        for (int kk = 0; kk < 8; ++kk) a1 = mfma(ldf(lds + OFF_Q + (32 * ti + l31) * SQ + (16 * kk + 8 * hi) * 2), ldf(lds + OFF_ST + (32 * tc + l31) * SQ + (16 * kk + 8 * hi) * 2), a1);
                    }
                    if (wave < 2) {
                        const int c = l31, bb = 32 * wave;
                        const float cf = (float)c;
                        const LAS float* Ab = (const LAS float*)(lds + OFF_A + wave * 4608); asm volatile("" : "+v"(Ab));
                        f32x2_t xp[16];
#pragma unroll
                        for (int p = 0; p < 16; ++p) xp[p] = (f32x2_t){0.f, 0.f};
                        f32x4 rbA[8], rbB[8];
#define GDN_ROWLOAD(dst, row) do { _Pragma("unroll") for (int q_ = 0; q_ < ((row) + 3) / 4; ++q_) dst[q_] = *(const LAS f32x4*)(Ab + (row) * 36 + 4 * q_); } while (0)
#define GDN_ROWSOLVE(src, row) do { f32x2_t sA = (f32x2_t){fmaxf(0.f, 1.f - fabsf(cf - (float)(row))), 0.f}, sB = (f32x2_t){0.f, 0.f}; \
        _Pragma("unroll") for (int j4 = 0; j4 < (row); j4 += 4) { const f32x4 a = src[j4 >> 2]; sA -= (f32x2_t){a[0], a[1]} * xp[j4 >> 1]; sB -= (f32x2_t){a[2], a[3]} * xp[(j4 >> 1) + 1]; } \
        const float xr_ = (sA[0] + sA[1]) + (sB[0] + sB[1]); xp[(row) >> 1][(row) & 1] = xr_; } while (0)
#pragma unroll
                        for (int ii = 0; ii < 32; ii += 2) {
                            GDN_ROWLOAD(rbB, ii + 1);
                            GDN_ROWSOLVE(rbA, ii);
                            if (ii + 2 < 32) GDN_ROWLOAD(rbA, ii + 2);
                            GDN_ROWSOLVE(rbB, ii + 1);
                        }
#undef GDN_ROWLOAD
#undef GDN_ROWSOLVE
                        float x[32];
#pragma unroll
                        for (int p = 0; p < 16; ++p) { x[2 * p] = xp[p][0]; x[2 * p + 1] = xp[p][1]; }
                        const float bc = sm_beta[bb + c], bce = bc * sm_eg[bb + c];
                        if (hi == 0) {
#pragma unroll
                            for (int i = 0; i < 32; ++i) {
                                *(LAS unsigned short*)(lds + OFF_T1 + (bb + i) * SK + (bb + c) * 2) = bf1(x[i] * bc);
                                *(LAS unsigned short*)(lds + OFF_T2 + (bb + i) * SK + (bb + c) * 2) = bf1(x[i] * bce);
                            }
                            if (wave == 0) {
#pragma unroll
                                for (int i = 0; i < 32; ++i) { *(LAS unsigned short*)(lds + OFF_T1 + i * SK + (32 + c) * 2) = 0; *(LAS unsigned short*)(lds + OFF_T2 + i * SK + (32 + c) * 2) = 0; }
#pragma unroll
                                for (int q = 0; q < 4; ++q) *(LAS u32x4*)(lds + LDS_S2 + 2048 + c * 64 + q * 16) = (u32x4){cvtpk2(x[8 * q], x[8 * q + 1]), cvtpk2(x[8 * q + 2], x[8 * q + 3]), cvtpk2(x[8 * q + 4], x[8 * q + 5]), cvtpk2(x[8 * q + 6], x[8 * q + 7])};
                            } else {
#pragma unroll
                                for (int i = 0; i < 32; ++i) *(LAS unsigned short*)(lds + LDS_S2 + 4096 + i * 64 + c * 2) = bf1(x[i]);
                            }
                        }
                    }
                    __syncthreads();
                    if (wave < 2) {
#pragma unroll
                        for (int kk = 0; kk < 8; ++kk) a1 = mfma(ldf(lds + OFF_Q + (32 * ti + l31) * SQ + (16 * kk + 8 * hi) * 2), ldf(lds + OFF_ST + (32 * tc + l31) * SQ + (16 * kk + 8 * hi) * 2), a1);
                    }
                    if (wave >= 4) {
                        f32x16 y;
#pragma unroll
                        for (int r = 0; r < 16; ++r) y[r] = 0.f;
#pragma unroll
                        for (int kk = 0; kk < 2; ++kk) y = mfma(ldf(lds + LDS_S2 + l31 * 64 + (16 * kk + 8 * hi) * 2), ldf(lds + LDS_S2 + 2048 + l31 * 64 + (16 * kk + 8 * hi) * 2), y);
                        bf16x8 pa0, pa1;
#define GDN_PK4(P, BASE, OUT) do { const unsigned a0_ = cvtpk2(P[BASE + 0], P[BASE + 1]), a1_ = cvtpk2(P[BASE + 2], P[BASE + 3]), b0_ = cvtpk2(P[BASE + 4], P[BASE + 5]), b1_ = cvtpk2(P[BASE + 6], P[BASE + 7]); \
        auto r0_ = __builtin_amdgcn_permlane32_swap(a0_, b0_, false, false); auto r1_ = __builtin_amdgcn_permlane32_swap(a1_, b1_, false, false); \
        u32x4 w_ = {r0_[0], r1_[0], r0_[1], r1_[1]}; OUT = __builtin_bit_cast(bf16x8, w_); } while (0)
                        GDN_PK4(y, 0, pa0); GDN_PK4(y, 8, pa1);
#undef GDN_PK4
                        f32x16 zt;
#pragma unroll
                        for (int r = 0; r < 16; ++r) zt[r] = 0.f;
                        zt = mfma(pa0, ldf(lds + LDS_S2 + 4096 + l31 * 64 + (8 * hi) * 2), zt);
                        zt = mfma(pa1, ldf(lds + LDS_S2 + 4096 + l31 * 64 + (16 + 8 * hi) * 2), zt);
#pragma unroll
                        for (int g4 = 0; g4 < 4; ++g4) { const int c0 = 8 * g4 + 4 * hi;
                            const f32x4 b4 = *(const LAS f32x4*)(sm_beta + c0), e4 = *(const LAS f32x4*)(sm_eg + c0);
                            float t1[4], t2[4];
#pragma unroll
                            for (int e = 0; e < 4; ++e) { t1[e] = -zt[4 * g4 + e] * b4[e]; t2[e] = t1[e] * e4[e]; }
                            *(LAS u32x2*)(lds + OFF_T1 + (32 + l31) * SK + c0 * 2) = (u32x2){cvtpk2(t1[0], t1[1]), cvtpk2(t1[2], t1[3])};
                            *(LAS u32x2*)(lds + OFF_T2 + (32 + l31) * SK + c0 * 2) = (u32x2){cvtpk2(t2[0], t2[1]), cvtpk2(t2[2], t2[3])}; }
                    }
                    f32x16 au;
#pragma unroll
                    for (int r = 0; r < 16; ++r) au[r] = 0.f;
#pragma unroll
                    for (int kk = 0; kk < 4; ++kk) au = mfma(ldf(lds + OFF_T1 + (32 * ti + l31) * SK + (16 * kk + 8 * hi) * 2), ldf(lds + OFF_VT + (32 * tc + l31) * SK + (16 * kk + 8 * hi) * 2), au);
                    {
                        f32x16 aw;
#pragma unroll
                        for (int r = 0; r < 16; ++r) aw[r] = 0.f;
#pragma unroll
                        for (int kk = 0; kk < 4; ++kk) aw = mfma(ldf(lds + OFF_KT + (32 * td + l31) * SK + (16 * kk + 8 * hi) * 2), ldf(lds + OFF_T2 + (32 * ti + l31) * SK + (16 * kk + 8 * hi) * 2), aw);
                        const int i = 32 * ti + l31;
#pragma unroll
                        for (int g4 = 0; g4 < 4; ++g4) { const int d0 = 32 * td + 8 * g4 + 4 * hi;
                            *(LAS u32x2*)(lds + OFF_A + i * SQ + d0 * 2) = (u32x2){cvtpk2(-aw[4 * g4], -aw[4 * g4 + 1]), cvtpk2(-aw[4 * g4 + 2], -aw[4 * g4 + 3])}; }
                    }
                    __syncthreads();
#pragma unroll
                    for (int kk = 0; kk < 8; ++kk) au = mfma(ldf(lds + OFF_A + (32 * ti + l31) * SQ + (16 * kk + 8 * hi) * 2), ldf(lds + OFF_ST + (32 * tc + l31) * SQ + (16 * kk + 8 * hi) * 2), au);
                    {
                        const int c = 32 * tc + l31;
#pragma unroll
                        for (int g4 = 0; g4 < 4; ++g4) { const int i0 = 32 * ti + 8 * g4 + 4 * hi;
                            const f32x4 e2 = *(const LAS f32x4*)(sm_e2 + i0);
                            *(LAS u32x2*)(lds + OFF_VT + c * SK + i0 * 2) = (u32x2){cvtpk2(au[4 * g4], au[4 * g4 + 1]), cvtpk2(au[4 * g4 + 2], au[4 * g4 + 3])};
                            *(LAS u32x2*)(lds + OFF_K + c * SK + i0 * 2) = (u32x2){cvtpk2(au[4 * g4] * e2[0], au[4 * g4 + 1] * e2[1]), cvtpk2(au[4 * g4 + 2] * e2[2], au[4 * g4 + 3] * e2[3])}; }
                    }
                    __syncthreads();
                    f32x16 a2;
#pragma unroll
                    for (int r = 0; r < 16; ++r) a2[r] = 0.f;
#pragma unroll
                    for (int kk = 0; kk < 4; ++kk) a2 = mfma(ldf(lds + OFF_QK + (32 * ti + l31) * SK + (16 * kk + 8 * hi) * 2), ldf(lds + OFF_VT + (32 * tc + l31) * SK + (16 * kk + 8 * hi) * 2), a2);
#pragma unroll
                    for (int g4 = 0; g4 < 4; ++g4) { const f32x4 eg = *(const LAS f32x4*)(sm_eg + 32 * ti + 8 * g4 + 4 * hi);
#pragma unroll
                        for (int e = 0; e < 4; ++e) a2[4 * g4 + e] += a1[4 * g4 + e] * eg[e]; }
                    {
                        const float egl = sm_egl[0];
#pragma unroll
                        for (int r = 0; r < 16; ++r) { S0[r] *= egl; S1[r] *= egl; }
#pragma unroll
                        for (int kk = 0; kk < 4; ++kk) { const bf16x8 a = ldf(lds + OFF_KT + (32 * td + l31) * SK + (16 * kk + 8 * hi) * 2);
                            S0 = mfma(a, ldf(lds + OFF_K + (32 * (2 * ti) + l31) * SK + (16 * kk + 8 * hi) * 2), S0);
                            S1 = mfma(a, ldf(lds + OFF_K + (32 * (2 * ti + 1) + l31) * SK + (16 * kk + 8 * hi) * 2), S1); }
                    }
                    __syncthreads();
#pragma unroll
                    for (int g4 = 0; g4 < 4; ++g4) { const int d0 = 32 * td + 8 * g4 + 4 * hi;
                        *(LAS u32x2*)(lds + OFF_ST + (32 * (2 * ti) + l31) * SQ + d0 * 2) = (u32x2){cvtpk2(S0[4 * g4], S0[4 * g4 + 1]), cvtpk2(S0[4 * g4 + 2], S0[4 * g4 + 3])};
                        *(LAS u32x2*)(lds + OFF_ST + (32 * (2 * ti + 1) + l31) * SQ + d0 * 2) = (u32x2){cvtpk2(S1[4 * g4], S1[4 * g4 + 1]), cvtpk2(S1[4 * g4 + 2], S1[4 * g4 + 3])}; }
                    if (dir == 0) {
                        bf16_t* go = O + (size_t)(rowbase + c0 + 32 * ti) * 4096 + h * 128 + 32 * tc + l31;
#pragma unroll
                        for (int r = 0; r < 16; ++r) go[(size_t)crow(r, hi) * 4096] = bf1(a2[r]);
                    } else {
#pragma unroll
                        for (int r = 0; r < 16; ++r) *(LAS unsigned short*)(lds + OFF_A + (32 * ti + crow(r, hi)) * SQ + (32 * tc + l31) * 2) = bf1(a2[r]);
                        __syncthreads();
                    }
                    if (dir) {
                        const int i = tid >> 3, cs = (tid & 7) * 16;
                        const int t = dir ? c0 + 63 - i : c0 + i;
                        bf16_t* gp = O + (size_t)(rowbase + t) * 4096 + h * 128 + cs;
                        const u32x4 s0 = *(const LAS u32x4*)(lds + OFF_A + i * SQ + cs * 2), s1 = *(const LAS u32x4*)(lds + OFF_A + i * SQ + cs * 2 + 16);
                        if (dir == 0) { *(u32x4*)gp = s0; *(u32x4*)(gp + 8) = s1; }
                        else {
                            const u32x4 p0 = *(const u32x4*)gp, p1 = *(const u32x4*)(gp + 8);
                            float v[16];
                            v[0] = bflo(s0.x) + bflo(p0.x); v[1] = bfhi(s0.x) + bfhi(p0.x); v[2] = bflo(s0.y) + bflo(p0.y); v[3] = bfhi(s0.y) + bfhi(p0.y);
                            v[4] = bflo(s0.z) + bflo(p0.z); v[5] = bfhi(s0.z) + bfhi(p0.z); v[6] = bflo(s0.w) + bflo(p0.w); v[7] = bfhi(s0.w) + bfhi(p0.w);
                            v[8] = bflo(s1.x) + bflo(p1.x); v[9] = bfhi(s1.x) + bfhi(p1.x); v[10] = bflo(s1.y) + bflo(p1.y); v[11] = bfhi(s1.y) + bfhi(p1.y);
                            v[12] = bflo(s1.z) + bflo(p1.z); v[13] = bfhi(s1.z) + bfhi(p1.z); v[14] = bflo(s1.w) + bflo(p1.w); v[15] = bfhi(s1.w) + bfhi(p1.w);
                            float ss = 0.f;
#pragma unroll
                            for (int e = 0; e < 16; ++e) ss += v[e] * v[e];
                            ss += swzx<1>(ss); ss += swzx<2>(ss); ss += swzx<4>(ss);
                            const float rstd = rsqrtf(ss * (1.f / 128.f) + EPS);
#pragma unroll
                            for (int e = 0; e < 16; ++e) v[e] *= rstd * norm_g[cs + e];
                            *(u32x4*)gp = (u32x4){cvtpk2(v[0], v[1]), cvtpk2(v[2], v[3]), cvtpk2(v[4], v[5]), cvtpk2(v[6], v[7])};
                            *(u32x4*)(gp + 8) = (u32x4){cvtpk2(v[8], v[9]), cvtpk2(v[10], v[11]), cvtpk2(v[12], v[13]), cvtpk2(v[14], v[15])};
                        }
                    }
                }
            }
        }
        __syncthreads();
    }
}
}
#define XB_TMO      128
#define XB_XCNT(j)  (256  + 64 * (j))
#define XB_XSUB(j)  (1280 + 64 * (j))
#define XB_XGEN(j)  (2304 + 64 * (j))
#define XB_TOP      3328
#define XB_TOPGEN   3392
#define XCD_BAR_WORDS 3456
#define XB_SPIN_CAP (1u << 18)

__device__ __forceinline__ unsigned xb_ld(unsigned* p)              { return __hip_atomic_load(p, __ATOMIC_RELAXED, __HIP_MEMORY_SCOPE_AGENT); }
__device__ __forceinline__ unsigned xb_add(unsigned* p, unsigned v) { return __hip_atomic_fetch_add(p, v, __ATOMIC_RELAXED, __HIP_MEMORY_SCOPE_AGENT); }
__device__ __forceinline__ unsigned xb_xcc_id() { return (unsigned)__builtin_amdgcn_s_getreg((3 << 11) | 20) & 0xFu; }
#define XB_SPIN(cond, bar) do { unsigned _sp = 0; while (cond) { __builtin_amdgcn_s_sleep(1); \
    if ((++_sp & 255u) == 0u) { if (xb_ld(&(bar)[XB_TMO])) break; if (_sp > XB_SPIN_CAP) { atomicAdd(&(bar)[XB_TMO], 1u); break; } } } } while (0)

struct XcdBarrier {
    unsigned* bar; unsigned x;
    volatile LAS unsigned* st;
};

__device__ __forceinline__ XcdBarrier xcd_barrier_post(unsigned* bar, volatile LAS unsigned* st) {
    XcdBarrier b; b.bar = bar; b.x = xb_xcc_id(); b.st = st;
    if (threadIdx.x == 0) (void)xb_add(&bar[XB_XCNT(b.x)], 1u);
    return b;
}
__device__ __forceinline__ void xcd_barrier_complete(unsigned* bar, unsigned x, unsigned& nloc, unsigned& nx) {
    const unsigned G = gridDim.x * gridDim.y * gridDim.z;
    unsigned sum, cnt, mine, sp = 0u;
    for (;;) {
        sum = 0u; cnt = 0u; mine = 0u;
#pragma unroll
        for (unsigned j = 0; j < 16; ++j) { const unsigned c = xb_ld(&bar[XB_XCNT(j)]); sum += c; cnt += (c > 0u) ? 1u : 0u; mine = (j == x) ? c : mine; }
        if (sum == G) break;
        __builtin_amdgcn_s_sleep(1);
        if ((++sp & 255u) == 0u) { if (xb_ld(&bar[XB_TMO])) break; if (sp > XB_SPIN_CAP) { atomicAdd(&bar[XB_TMO], 1u); break; } }
    }
    nloc = mine > 0u ? mine : 1u; nx = cnt > 0u ? cnt : 1u;
}

__device__ __forceinline__ void xcd_barrier(const XcdBarrier& b) {
    asm volatile("s_waitcnt vmcnt(0)" ::: "memory");
    __syncthreads();
    if (threadIdx.x == 0) {
        unsigned* bar = b.bar;
        __builtin_amdgcn_s_waitcnt(0);
        unsigned nloc = b.st[0], nx = b.st[1];
        if (nloc == 0u) { xcd_barrier_complete(bar, b.x, nloc, nx); b.st[0] = nloc; b.st[1] = nx; }
        const unsigned old = xb_add(&bar[XB_XSUB(b.x)], 1u);
        const unsigned gen = old / nloc;
        if (old + 1u == (gen + 1u) * nloc) {
            __builtin_amdgcn_fence(__ATOMIC_RELEASE, "agent");
            asm volatile("s_waitcnt vmcnt(0)" ::: "memory");
            const unsigned og = xb_add(&bar[XB_TOP], 1u);
            const unsigned tg = og / nx;
            if (og + 1u == (tg + 1u) * nx) xb_add(&bar[XB_TOPGEN], 1u);
            else XB_SPIN(xb_ld(&bar[XB_TOPGEN]) == tg, bar);
            __builtin_amdgcn_fence(__ATOMIC_ACQUIRE, "agent");
            xb_add(&bar[XB_XGEN(b.x)], 1u);
            asm volatile("s_waitcnt vmcnt(0)" ::: "memory");
        } else {
            XB_SPIN(xb_ld(&bar[XB_XGEN(b.x)]) == gen, bar);
            __builtin_amdgcn_fence(__ATOMIC_ACQUIRE, "agent");
            asm volatile("s_waitcnt vmcnt(0)" ::: "memory");
        }
    }
    __syncthreads();
}

#ifndef EN_MOD
#define EN_MOD 1
#endif
#ifndef EN_GEMM
#define EN_GEMM 1
#endif
#ifndef EN_GDN
#define EN_GDN 1
#endif
#ifndef EN_ATT
#define EN_ATT 1
#endif
#ifndef EN_G1
#define EN_G1 1
#endif
#ifndef EN_G2
#define EN_G2 1
#endif
#ifndef EN_G3
#define EN_G3 1
#endif
#ifndef EN_G4
#define EN_G4 1
#endif
#ifndef EN_G5
#define EN_G5 1
#endif
#ifndef EN_G6
#define EN_G6 1
#endif
#define GSYNC() xcd_barrier(xbar)
#define GSYNC_CG() do { asm volatile("s_waitcnt vmcnt(0) lgkmcnt(0)" ::: "memory"); grid.sync(); __builtin_amdgcn_fence(__ATOMIC_ACQUIRE, "agent"); asm volatile("s_waitcnt vmcnt(0)" ::: "memory"); __syncthreads(); } while (0)
#ifndef DBG_MEMSET
#define DBG_MEMSET 0
#endif
#ifndef GDN_REPS
#define GDN_REPS 1
#endif
#ifndef SYNC_REPS
#define SYNC_REPS 1
#endif
#ifndef FFN1_REPS
#define FFN1_REPS 1
#endif
#ifndef ATT_REPS
#define ATT_REPS 1
#endif
#ifndef PR_REPS
#define PR_REPS 1
#endif
#ifndef PROBE_PREP
#define PROBE_PREP 0
#endif
#ifndef G1_REPS
#define G1_REPS 1
#endif
#ifndef PROBE_FFN2
#define PROBE_FFN2 0
#endif
#ifndef GEMM_ALIGN
#define GEMM_ALIGN true
#endif
#ifndef GEMM_SP2
#define GEMM_SP2 true
#endif
struct Args { const float* in[20]; float* out; unsigned char* ws; };

__global__ void __launch_bounds__(NTHR, 2) fwd_megakernel(Args args) {
    extern __shared__ __attribute__((aligned(16))) unsigned char lds_raw[];
    cg::grid_group grid = cg::this_grid();
    LAS unsigned char* lds = (LAS unsigned char*)lds_raw;
    const int G = gridDim.x, bid = blockIdx.x;
    if (threadIdx.x < 2) ((volatile LAS unsigned*)(lds + LDS_XB))[threadIdx.x] = 0u;
    __syncthreads();
    XcdBarrier xbar = xcd_barrier_post((unsigned*)(WS() + WS_BAR), (volatile LAS unsigned*)(lds + LDS_XB));
#if EN_MOD
    phase_mod(IN(1), IN(3), IN(4), IN(5), P_MOD, lds, G, bid);
#endif
    __syncthreads();
    phase_convert(0, P_Wb, lds, G, bid, 31, 0);
    GSYNC_CG();

    for (int L = 0; L < 4; ++L) {
        const bool is_gdn = !(L & 1), last = (L == 3);
        const int j = L >> 1;
        const int Mrows = last ? NLAT : MROWS;
        if (L == 0) phase_prep(IN(0), IN(2), P_xlat, P_xctx, true, nullptr, nullptr, P_BIG2, MODL, MODL + DM, MROWS, G, bid);
        else {
            phase_prep(P_xlat, P_xctx, P_xlat, P_xctx, true, IN(6) + (size_t)((L - 1) * 2 + 1) * DM, IN(7) + (size_t)((L - 1) * 2 + 1) * DM, P_BIG2, MODL, MODL + DM, MROWS, G, bid);
            phase_convert(L, P_Wb, lds, G, bid, 16, 0);
        }
        GSYNC();
        const bf16_t* mixA; int mixK, mixLda;
        if (is_gdn) {
            {
                pg8::Gemm g{P_BIG2, P_Wb + W_A, MROWS, GIN1, 1024, 1024}; pg8::StaticOrder S; S.init(MROWS, GIN1, G, bid);
                EpiGdnIn E{P_BIG1, P_GB, IN(12) + j * 32, IN(13) + j * 32};
                for (int gr_ = 0; gr_ < G1_REPS; ++gr_) pg8::gemm_phase<EpiGdnIn, pg8::StaticOrder, GEMM_ALIGN, GEMM_SP2>(lds, g, S, E);
            }
            GSYNC();
            for (int cr_ = 0; cr_ < PR_REPS; ++cr_) gdn::conv_phase(P_BIG1, IN(11) + (size_t)j * 5 * 4096, P_BIG2, 0, G, bid);
            GSYNC();
            for (int cr_ = 0; cr_ < PR_REPS; ++cr_) gdn::conv_phase(P_BIG1, IN(11) + (size_t)j * 5 * 4096, P_BIG1, 1, G, bid);
            GSYNC();
            for (int rep_ = 0; rep_ < GDN_REPS; ++rep_) gdn::core(P_BIG2, P_BIG1, P_GB, IN(14) + j * 128, P_BIG1 + 2048, lds, G, bid);
            GSYNC();
            for (int cr_ = 0; cr_ < PR_REPS; ++cr_) phase_prep(P_xlat, P_xctx, P_xlat, P_xctx, false, nullptr, nullptr, P_BIG2, MODL, MODL + DM, MROWS, G, bid);
            GSYNC();
            {
                pg8::Gemm g{P_BIG2, P_Wb + W_Z, MROWS, 2048, 1024, 1024}; pg8::StaticOrder S; S.init(MROWS, 2048, G, bid);
                EpiGateZ E{P_BIG1 + 2048};
                if (EN_GEMM && EN_G2) pg8::gemm_phase<EpiGateZ, pg8::StaticOrder, GEMM_ALIGN, GEMM_SP2>(lds, g, S, E);
            }
            GSYNC();
            mixA = P_BIG1 + 2048; mixK = 2048; mixLda = 4096;
        } else {
            {
                pg8::Gemm g{P_BIG2, P_Wb + W_A, MROWS, 1536, 1024, 1024}; pg8::StaticOrder S; S.init(MROWS, 1536, G, bid);
                EpiPlainBf16 E{P_QKV, 1536};
                if (EN_GEMM && EN_G3) pg8::gemm_phase<EpiPlainBf16, pg8::StaticOrder, GEMM_ALIGN, GEMM_SP2>(lds, g, S, E);
            }
            GSYNC();
            phase_qkvpost(P_QKV, P_KB, P_VB, IN(17) + j * 128, IN(18) + j * 128, G, bid);
            GSYNC();
            {
                const int total = 1024 + (last ? 0 : 128);
                for (int arep_ = 0; arep_ < ATT_REPS; ++arep_)
                for (int it = bid; it < total; it += G) {
                    const att::bf16 *Qp, *Kp, *Vp; unsigned short* Op; int seq;
                    if (it < 1024) {
                        const int rnd = it >> 8, b256 = it & 255, grp = rnd * 8 + (b256 & 7), within = b256 >> 3;
                        const int b = grp >> 1, kvh = grp & 1, gq = within >> 3, qb = within & 7, h = kvh * 4 + gq;
                        Qp = (const att::bf16*)(P_QKV + (size_t)(b * SEQ + qb * 256) * 1536 + h * 128);
                        Kp = (const att::bf16*)(P_KB + (size_t)(b * 2 + kvh) * KVLEN * 128); Vp = (const att::bf16*)(P_VB + (size_t)(b * 2 + kvh) * KVLEN * 128);
                        Op = P_AO + (size_t)(b * SEQ + qb * 256) * 1024 + h * 128; seq = KVLEN;
                    } else {
                        const int q = it - 1024, b = q >> 3, h = q & 7, kvh = h >> 2;
                        Qp = (const att::bf16*)(P_QKV + (size_t)(NLAT + b * CTXL) * 1536 + h * 128);
                        Kp = (const att::bf16*)(P_KB + (size_t)(b * 2 + kvh) * KVLEN * 128); Vp = (const att::bf16*)(P_VB + (size_t)(b * 2 + kvh) * KVLEN * 128);
                        Op = P_AO + (size_t)(NLAT + b * CTXL) * 1024 + h * 128; seq = CTXL;
                    }
                    if (EN_ATT) att::attn_dense_body<att::bf16, 1536, 128, 1024>(Qp, Kp, Vp, Op, seq, (char*)lds_raw);
                    __syncthreads();
                }
            }
            GSYNC();
            mixA = P_AO; mixK = 1024; mixLda = 1024;
        }
        {
            pg8::Gemm g{mixA, P_Wb + W_O, Mrows, 1024, mixK, mixLda}; pg8::StaticOrder S; S.init(Mrows, 1024, G, bid);
            EpiResid E{P_xlat, P_xctx, MODL + 2 * DM, ALPHA, 1.f};
            if (EN_GEMM && EN_G4) pg8::gemm_phase<EpiResid, pg8::StaticOrder, GEMM_ALIGN, GEMM_SP2>(lds, g, S, E);
        }
        GSYNC();
#if PROBE_PREP
        phase_prep(P_xlat, P_xctx, P_xlat, P_xctx, false, IN(6) + (size_t)(L * 2) * DM, IN(7) + (size_t)(L * 2) * DM, P_BIG1, MODL + 3 * DM, MODL + 4 * DM, Mrows, G, bid);
#endif
        phase_prep(P_xlat, P_xctx, P_xlat, P_xctx, true, IN(6) + (size_t)(L * 2) * DM, IN(7) + (size_t)(L * 2) * DM, P_BIG2, MODL + 3 * DM, MODL + 4 * DM, Mrows, G, bid);
        GSYNC();
        {
            pg8::Gemm g{P_BIG2, P_Wb + W_F1, Mrows, 5632, 1024, 1024}; pg8::StaticOrder S; S.init(Mrows, 5632, G, bid);
            EpiSwiglu E{P_BIG1};
            for (int rp_ = 0; rp_ < FFN1_REPS; ++rp_) pg8::gemm_phase<EpiSwiglu, pg8::StaticOrder, GEMM_ALIGN, GEMM_SP2>(lds, g, S, E);
        }
        GSYNC();
        {
            pg8::Gemm g{P_BIG1, P_Wb + W_F2, Mrows, 1024, DFF, DFF}; pg8::StaticOrder S; S.init(Mrows, 1024, G, bid);
#if PROBE_FFN2
            { EpiResid E0{P_xlat, P_xctx, MODL + 5 * DM, 1.f, 0.f}; pg8::gemm_phase<EpiResid, pg8::StaticOrder, GEMM_ALIGN, GEMM_SP2>(lds, g, S, E0); }
#endif
            EpiResid E{P_xlat, P_xctx, MODL + 5 * DM, ALPHA, 1.f};
            if (EN_GEMM && EN_G6) pg8::gemm_phase<EpiResid, pg8::StaticOrder, GEMM_ALIGN, GEMM_SP2>(lds, g, S, E);
            if (L < 3) { __syncthreads(); phase_convert(L + 1, P_Wb, lds, G, bid, 15, (G == 256 && Mrows == MROWS) ? 64 : 0); }
        }
        GSYNC();
    }
    phase_prep(P_xlat, P_xctx, P_xlat, P_xctx, true, IN(6) + (size_t)7 * DM, IN(7) + (size_t)7 * DM, nullptr, nullptr, nullptr, NLAT, G, bid);
}

extern "C" void kernel_launch(void* const* d_in, const int* in_sizes, int n_in, void* d_out, int out_size, void* d_ws, size_t ws_size, hipStream_t stream) {
    static int grid = 0;
    if (grid == 0) {
        if (n_in != 20 || out_size != NLAT * DM || ws_size < WS_END) { fprintf(stderr, "kernel_launch: unexpected shapes: n_in %d out %d ws %zu (need %zu)\n", n_in, out_size, ws_size, (size_t)WS_END); grid = -1; return; }
        int dev = 0, cus = 0, per_cu = 0;
        hipGetDevice(&dev); hipDeviceGetAttribute(&cus, hipDeviceAttributeMultiprocessorCount, dev);
        if (hipFuncSetAttribute((const void*)fwd_megakernel, hipFuncAttributeMaxDynamicSharedMemorySize, LDS_BYTES) != hipSuccess) { fprintf(stderr, "kernel_launch: hipFuncSetAttribute failed\n"); grid = -1; return; }
        if (hipOccupancyMaxActiveBlocksPerMultiprocessor(&per_cu, (const void*)fwd_megakernel, NTHR, LDS_BYTES) != hipSuccess || per_cu < 1) { fprintf(stderr, "kernel_launch: occupancy query says %d\n", per_cu); per_cu = 1; }
        (void)hipGetLastError();
        grid = cus;
    }
    if (grid < 0) return;
    Args a{};
    for (int i = 0; i < 20; ++i) a.in[i] = (const float*)d_in[i];
    a.out = (float*)d_out; a.ws = (unsigned char*)d_ws;
#if DBG_MEMSET
    (void)hipMemsetAsync(d_ws, 0, WS_END, stream); (void)hipMemsetAsync(d_out, 0, (size_t)out_size * 4, stream);
#endif
    (void)hipMemsetAsync((char*)d_ws + WS_BAR, 0, WS_BAR_BYTES, stream);
    void* kargs[] = {&a};
    hipError_t e = hipLaunchCooperativeKernel((const void*)fwd_megakernel, dim3(grid), dim3(NTHR), kargs, LDS_BYTES, stream);
    if (e != hipSuccess) fprintf(stderr, "kernel_launch: cooperative launch failed: %s (grid %d)\n", hipGetErrorString(e), grid);
}
```

```cpp
#include <hip/hip_runtime.h>
#include <hip/hip_bf16.h>
#include <hip/hip_cooperative_groups.h>
#include <cstdio>
#include <cstdint>
#include <cmath>
namespace cg = cooperative_groups;
__device__ __forceinline__ int opaque_tid() { int t = threadIdx.x; asm volatile("" : "+v"(t)); return t; }
namespace pg8 {
#define PG8_LAS __attribute__((address_space(3)))
typedef unsigned short bf16_t;
typedef short bf16x8 __attribute__((ext_vector_type(8)));
typedef float f32x4 __attribute__((ext_vector_type(4)));
typedef unsigned u32x4 __attribute__((ext_vector_type(4)));
constexpr int BM = 256, BK = 64, HALF = 128, HTB = HALF * BK * 2  , STAGE_BYTES = 8 * HTB, NXCD = 8, WGM = 4;

__host__ __device__ __forceinline__ int lds_byte(int r, int c) { const int st = (r >> 4) * 2 + (c >> 5), rr = r & 15, cc = c & 31, ob = rr * 64 + cc * 2; return st * 1024 + (ob ^ (((ob >> 9) & 1) << 5)); }
__host__ __device__ __forceinline__ void stage_rc(int b, int& R, int& C) { const int st = b / 1024, sb = b % 1024, swz = sb ^ (((sb >> 9) & 1) << 5); R = (st >> 1) * 16 + swz / 64; C = (st & 1) * 32 + (swz % 64) / 2; }
__host__ __device__ __forceinline__ int perm32(int rho) { const int n = rho >> 4, i = rho & 15; return 8 * (i >> 2) + 4 * n + (i & 3); }

struct Unit { int pm, pn; };
struct Gemm { const bf16_t* A; const bf16_t* Bt; int M, N, K, lda; };

struct StaticOrder {
    int nM, nN, nwg, G, c;
    __host__ __device__ void init(int M, int N, int G_, int c_) { nM = M / BM; nN = N / BM; nwg = nM * nN; G = G_; c = c_; }
    __host__ __device__ bool next(int i, Unit& u) const {
        const long L = (long)i * G + c; if (L >= nwg) return false;
        int wgid = (int)L; { const int q = nwg / NXCD, r = nwg % NXCD, xcd = wgid % NXCD, off = wgid / NXCD; wgid = (xcd < r ? xcd * (q + 1) : r * (q + 1) + (xcd - r) * q) + off; }
        const int nig = WGM * nN, gid = wgid / nig, fm = gid * WGM, gsz = (nM - fm) < WGM ? (nM - fm) : WGM;
        u.pm = fm + ((wgid % nig) % gsz); u.pn = (wgid % nig) / gsz; return true;
    }
    __device__ __forceinline__ void a_ready(const Unit&) const {}
    __device__ __forceinline__ void done(const Unit&) const {}
};

__device__ __forceinline__ unsigned cvt_pk_bf16(float lo, float hi) { unsigned r; asm volatile("v_cvt_pk_bf16_f32 %0, %1, %2" : "=v"(r) : "v"(lo), "v"(hi)); return r; }
typedef float f32x2 __attribute__((ext_vector_type(2)));
__device__ __forceinline__ f32x2 gelu_pk(f32x2 v) {
    const f32x2 av = __builtin_elementwise_abs(v), d = av * 0.2316418882f + 1.0f;
    f32x2 t; t.x = __builtin_amdgcn_rcpf(d.x); t.y = __builtin_amdgcn_rcpf(d.y);
    f32x2 q = t * 0.5307027145f + (-0.7265760135f); q = q * t + 0.7107068705f; q = q * t + (-0.142248368f); q = q * t + 0.127414796f; q = q * t;
    const f32x2 s = (v * v) * (-0.72134752044f);
    f32x2 e; e.x = __builtin_amdgcn_exp2f(s.x); e.y = __builtin_amdgcn_exp2f(s.y);
    const f32x2 m = v * (q * e), r = v - m;
    f32x2 o; o.x = v.x < 0.f ? m.x : r.x; o.y = v.y < 0.f ? m.y : r.y; return o;
}

template <int ACT  > struct EpiBf16 {
    static constexpr bool PERM = true, AFTER_DRAIN = false; static_assert(ACT == 0 || ACT == 1, "EpiBf16: ACT is 0 (none) or 1 (gelu_pk)");
    bf16_t* O; int ldc; const float* bias; int split_cols; size_t split_stride; float scale0;
    __device__ __forceinline__ void operator()(const f32x4 (&acc)[2][2][4][2], const Unit& u, int wr, int wc, int fr, int fq) const {
        const int row0 = u.pm * BM + wr * 64 + fr; int colt = u.pn * BM; bf16_t* base = O;
        float sc = 1.f; if (split_cols) { const int t = colt / split_cols; base += (size_t)t * split_stride; colt -= t * split_cols; if (t == 0) sc = scale0; }
        const int col0 = colt + wc * 32 + 8 * fq, bcol0 = u.pn * BM + wc * 32 + 8 * fq;
        f32x4 bv[2][2];
#pragma unroll
        for (int bj = 0; bj < 2; ++bj)
#pragma unroll
            for (int n = 0; n < 2; ++n) bv[bj][n] = bias ? *(const f32x4*)(bias + bcol0 + bj * HALF + 4 * n) : (f32x4){0.f, 0.f, 0.f, 0.f};
#pragma unroll
        for (int ai = 0; ai < 2; ++ai)
#pragma unroll
            for (int m = 0; m < 4; ++m) { bf16_t* rowp = base + (size_t)(row0 + ai * HALF + m * 16) * ldc + col0;
#pragma unroll
                for (int bj = 0; bj < 2; ++bj) { f32x4 v0 = acc[ai][bj][m][0] + bv[bj][0], v1 = acc[ai][bj][m][1] + bv[bj][1];
                    if (ACT == 1) { f32x2 a = gelu_pk((f32x2){v0[0], v0[1]}), b = gelu_pk((f32x2){v0[2], v0[3]}), c = gelu_pk((f32x2){v1[0], v1[1]}), d = gelu_pk((f32x2){v1[2], v1[3]});
                        v0 = (f32x4){a.x, a.y, b.x, b.y}; v1 = (f32x4){c.x, c.y, d.x, d.y}; }
                    v0 = v0 * sc; v1 = v1 * sc; u32x4 w; w.x = cvt_pk_bf16(v0[0], v0[1]); w.y = cvt_pk_bf16(v0[2], v0[3]); w.z = cvt_pk_bf16(v1[0], v1[1]); w.w = cvt_pk_bf16(v1[2], v1[3]);
                    *(u32x4*)(rowp + bj * HALF) = w; } }
    }
};

struct PanelStats {
    unsigned* xbuf;
    unsigned* cnt;
    unsigned* tmo;
    int ntn; float eps;
    unsigned code;
    __device__ __forceinline__ bool run(const f32x4 (&v)[2][2][4][2], const Unit& u, int wr, int wc, int fr, int fq, PG8_LAS unsigned char* lds, int wid, int lane) const {
        typedef float f32x2v __attribute__((ext_vector_type(2)));
        PG8_LAS f32x2v* P = (PG8_LAS f32x2v*)lds;
        PG8_LAS f32x2v* S = (PG8_LAS f32x2v*)(lds + 8192);
        PG8_LAS unsigned* flag = (PG8_LAS unsigned*)(lds + 8192 + 2048);
#pragma unroll
        for (int ai = 0; ai < 2; ++ai)
#pragma unroll
            for (int m = 0; m < 4; ++m) {
                float s = 0.f;
#pragma unroll
                for (int bj = 0; bj < 2; ++bj)
#pragma unroll
                    for (int n = 0; n < 2; ++n) { const f32x4 x = v[ai][bj][m][n]; s += (x[0] + x[1]) + (x[2] + x[3]); }
                s += __shfl_xor(s, 16); s += __shfl_xor(s, 32);
                const float mw = s * (1.0f / 64.0f); float q = 0.f;
#pragma unroll
                for (int bj = 0; bj < 2; ++bj)
#pragma unroll
                    for (int n = 0; n < 2; ++n) { const f32x4 d = v[ai][bj][m][n] - mw; q += (d[0] * d[0] + d[1] * d[1]) + (d[2] * d[2] + d[3] * d[3]); }
                q += __shfl_xor(q, 16); q += __shfl_xor(q, 32);
                if (fq == 0) P[(ai * HALF + wr * 64 + m * 16 + fr) * 4 + wc] = (f32x2v){mw, q};
            }
        asm volatile("s_waitcnt lgkmcnt(0)" ::: "memory"); __builtin_amdgcn_s_barrier(); asm volatile("" ::: "memory");
#if defined(BROKEN_EXCHANGE_NO_WAIT)
#warning BROKEN CONTROL BUILD: the row-statistics exchange does not wait; results are wrong by design
        if (blockIdx.x >= 64) { const long long t0_ = clock64(); while (clock64() - t0_ < 60000) __builtin_amdgcn_s_sleep(8); }
#endif
        const int row = wid * 32 + (lane & 31);
        if (lane < 32) {
            const f32x2v a = P[row * 4 + 0], b = P[row * 4 + 1], c = P[row * 4 + 2], d = P[row * 4 + 3];
            const float mt = (a.x + b.x + c.x + d.x) * 0.25f;
            const float da = a.x - mt, db = b.x - mt, dc = c.x - mt, dd = d.x - mt;
            const float m2 = (a.y + b.y) + (c.y + d.y) + 64.0f * ((da * da + db * db) + (dc * dc + dd * dd));
            unsigned long long* slot = (unsigned long long*)xbuf + ((size_t)(u.pm * BM + row) * 4 + u.pn);
            __hip_atomic_store(slot, ((unsigned long long)__float_as_uint(m2) << 32) | __float_as_uint(mt), __ATOMIC_RELAXED, __HIP_MEMORY_SCOPE_AGENT);
        }
        asm volatile("s_waitcnt vmcnt(0)" ::: "memory");
        if (lane == 0) __hip_atomic_fetch_add(cnt + 64 * u.pm, 1u, __ATOMIC_RELAXED, __HIP_MEMORY_SCOPE_AGENT);
        if (wid == 0) {
            bool dead = false; const unsigned long long t0 = __builtin_amdgcn_s_memrealtime(); const unsigned want = 8u * (unsigned)ntn;
            for (;;) {
#if defined(BROKEN_EXCHANGE_NO_WAIT)
                break;
#endif
                if ((unsigned)__builtin_amdgcn_readfirstlane(__hip_atomic_load(cnt + 64 * u.pm, __ATOMIC_RELAXED, __HIP_MEMORY_SCOPE_AGENT)) >= want) break;
                if (__builtin_amdgcn_s_memrealtime() - t0 > 2000000ull) {
                    if (lane == 0) { unsigned expect = 0u; __hip_atomic_compare_exchange_strong(tmo + 1, &expect, code | (unsigned)(u.pm & 0xff), __ATOMIC_RELAXED, __ATOMIC_RELAXED, __HIP_MEMORY_SCOPE_AGENT);
                                     __hip_atomic_store(tmo, 1u, __ATOMIC_RELAXED, __HIP_MEMORY_SCOPE_AGENT); }
                    dead = true; break; }
                __builtin_amdgcn_s_sleep(2);
            }
            __builtin_amdgcn_fence(__ATOMIC_ACQUIRE, "agent");
            if (lane == 0) flag[0] = dead ? 1u : 0u;
        }
        asm volatile("s_waitcnt vmcnt(0) lgkmcnt(0)" ::: "memory"); __builtin_amdgcn_s_barrier(); asm volatile("" ::: "memory");
        const bool bad = flag[0] != 0u;
        if (lane < 32) {
            const unsigned long long* slot = (const unsigned long long*)xbuf + (size_t)(u.pm * BM + row) * 4; float mt[4], m2[4]; float ms = 0.f;
#pragma unroll
            for (int t = 0; t < 4; ++t) { if (t < ntn) { const unsigned long long w = __hip_atomic_load(slot + t, __ATOMIC_RELAXED, __HIP_MEMORY_SCOPE_AGENT); mt[t] = __uint_as_float((unsigned)w); m2[t] = __uint_as_float((unsigned)(w >> 32)); } else { mt[t] = 0.f; m2[t] = 0.f; } ms += mt[t]; }
            const float mean = ms / (float)ntn; float q = 0.f;
#pragma unroll
            for (int t = 0; t < 4; ++t) if (t < ntn) { const float dm = mt[t] - mean; q += m2[t] + 256.0f * dm * dm; }
            S[row] = (f32x2v){mean, 1.0f / sqrtf(q / (256.0f * (float)ntn) + eps)};
        }
        asm volatile("s_waitcnt lgkmcnt(0)" ::: "memory"); __builtin_amdgcn_s_barrier(); asm volatile("" ::: "memory");
        return bad;
    }
};
struct EpiLnRes {
    static constexpr bool PERM = false, AFTER_DRAIN = true;
    const float* base; float* out; int ldc; const float* bias; PanelStats st; unsigned poison;
    __device__ __forceinline__ void fused(f32x4 (&acc)[2][2][4][2], const Unit& u, int wr, int wc, int fr, int fq, PG8_LAS unsigned char* lds, int wid, int lane) const {
        typedef float f32x2v __attribute__((ext_vector_type(2)));
        const PG8_LAS f32x2v* S = (const PG8_LAS f32x2v*)(lds + 8192);
        const int col0 = u.pn * BM + wc * 32 + 4 * fq;
#pragma unroll
        for (int bj = 0; bj < 2; ++bj)
#pragma unroll
            for (int n = 0; n < 2; ++n) { const f32x4 bv = bias ? *(const f32x4*)(bias + col0 + bj * HALF + n * 16) : (f32x4){0.f, 0.f, 0.f, 0.f};
#pragma unroll
                for (int ai = 0; ai < 2; ++ai)
#pragma unroll
                    for (int m = 0; m < 4; ++m) acc[ai][bj][m][n] += bv; }
        f32x4 pre[4][2][2];
#pragma unroll
        for (int m = 0; m < 4; ++m) { const size_t off = (size_t)(u.pm * BM + wr * 64 + m * 16 + fr) * ldc + col0;
#pragma unroll
            for (int bj = 0; bj < 2; ++bj)
#pragma unroll
                for (int n = 0; n < 2; ++n) pre[m][bj][n] = *(const f32x4*)(base + off + bj * HALF + n * 16); }
        const bool bad = st.run(acc, u, wr, wc, fr, fq, lds, wid, lane) || poison != 0u;
        const float qnan = __builtin_nanf("");
#pragma unroll
        for (int ai = 0; ai < 2; ++ai)
#pragma unroll
            for (int m = 0; m < 4; ++m) { const int r = ai * HALF + wr * 64 + m * 16 + fr; const f32x2v sr = S[r]; const size_t off = (size_t)(u.pm * BM + r) * ldc + col0;
#pragma unroll
                for (int bj = 0; bj < 2; ++bj)
#pragma unroll
                    for (int n = 0; n < 2; ++n) { const f32x4 bs = ai == 0 ? pre[m][bj][n] : *(const f32x4*)(base + off + bj * HALF + n * 16); f32x4 o = bs + (acc[ai][bj][m][n] - sr.x) * sr.y;
                        if (bad) o = (f32x4){qnan, qnan, qnan, qnan}; *(f32x4*)(out + off + bj * HALF + n * 16) = o; }
                if (m & 1) asm volatile("" ::: "memory"); }
    }
};
struct EpiLnResLn {
    static constexpr bool PERM = false, AFTER_DRAIN = true;
    const float* base; float* out; bf16_t* xn; int ldc; const float* bias; PanelStats st1, st2; unsigned poison;
    __device__ __forceinline__ void fused(f32x4 (&acc)[2][2][4][2], const Unit& u, int wr, int wc, int fr, int fq, PG8_LAS unsigned char* lds, int wid, int lane) const {
        typedef float f32x2v __attribute__((ext_vector_type(2))); typedef unsigned u32x2v __attribute__((ext_vector_type(2)));
        const PG8_LAS f32x2v* S = (const PG8_LAS f32x2v*)(lds + 8192);
        const int col0 = u.pn * BM + wc * 32 + 4 * fq;
#pragma unroll
        for (int bj = 0; bj < 2; ++bj)
#pragma unroll
            for (int n = 0; n < 2; ++n) { const f32x4 bv = bias ? *(const f32x4*)(bias + col0 + bj * HALF + n * 16) : (f32x4){0.f, 0.f, 0.f, 0.f};
#pragma unroll
                for (int ai = 0; ai < 2; ++ai)
#pragma unroll
                    for (int m = 0; m < 4; ++m) acc[ai][bj][m][n] += bv; }
        bool bad = st1.run(acc, u, wr, wc, fr, fq, lds, wid, lane) || poison != 0u;
        const float qnan = __builtin_nanf("");
#pragma unroll
        for (int ai = 0; ai < 2; ++ai)
#pragma unroll
            for (int m = 0; m < 4; ++m) { const int r = ai * HALF + wr * 64 + m * 16 + fr; const f32x2v sr = S[r]; const size_t off = (size_t)(u.pm * BM + r) * ldc + col0;
#pragma unroll
                for (int bj = 0; bj < 2; ++bj)
#pragma unroll
                    for (int n = 0; n < 2; ++n) { const f32x4 bs = *(const f32x4*)(base + off + bj * HALF + n * 16); acc[ai][bj][m][n] = bs + (acc[ai][bj][m][n] - sr.x) * sr.y; }
                asm volatile("" : "+v"(acc[ai][0][m][0]), "+v"(acc[ai][0][m][1]), "+v"(acc[ai][1][m][0]), "+v"(acc[ai][1][m][1]));
                if (m & 1) asm volatile("" ::: "memory"); }
        const bool bad1 = bad;
        bad = st2.run(acc, u, wr, wc, fr, fq, lds, wid, lane) || bad;
#pragma unroll
        for (int ai = 0; ai < 2; ++ai)
#pragma unroll
            for (int m = 0; m < 4; ++m) { const int r = ai * HALF + wr * 64 + m * 16 + fr; const f32x2v sr = S[r]; const size_t off = (size_t)(u.pm * BM + r) * ldc + col0;
#pragma unroll
                for (int bj = 0; bj < 2; ++bj)
#pragma unroll
                    for (int n = 0; n < 2; ++n) { const f32x4 x1 = acc[ai][bj][m][n]; *(f32x4*)(out + off + bj * HALF + n * 16) = bad1 ? (f32x4){qnan, qnan, qnan, qnan} : x1;
                        const f32x4 o = (x1 - sr.x) * sr.y; u32x2v w; w.x = cvt_pk_bf16(o[0], o[1]); w.y = cvt_pk_bf16(o[2], o[3]);
                        if (bad) { w.x = 0x7fc07fc0u; w.y = 0x7fc07fc0u; } *(u32x2v*)(xn + off + bj * HALF + n * 16) = w; }
                asm volatile("" ::: "memory"); }
    }
};

template <class Epi, class Sched, bool ALIGN_EPI = false, bool SP2 = false>
__device__ __forceinline__ void gemm_phase(PG8_LAS unsigned char* lds, const Gemm g, const Sched& S, const Epi& E) {
    const int tid = opaque_tid(), wid = __builtin_amdgcn_readfirstlane(tid >> 6), lane = tid & 63, wr = wid >> 2, wc = wid & 3, fr = lane & 15, fq = lane >> 4;
    const int K = g.K, nt = K / BK;
    unsigned voffA[2], voffB[2];
#pragma unroll
    for (int i = 0; i < 2; ++i) { int R, C; stage_rc(tid * 16 + i * 8192, R, C); const int Rb = Epi::PERM ? ((R & ~31) + perm32(R & 31)) : R;
        voffA[i] = (unsigned)(R * g.lda + C) * 2u; voffB[i] = (unsigned)(Rb * K + C) * 2u; }
    const size_t kstep = (size_t)(BK * 2);
    const size_t hstep = (size_t)HALF * K * 2;
    const size_t tstep = 2 * hstep;
    const size_t hstepA = (size_t)HALF * g.lda * 2, tstepA = 2 * hstepA;
    const unsigned ldsw = (unsigned)wid * 1024u;
    const int aoff = lds_byte(wr * 64 + fr, fq * 8), boff = lds_byte(wc * 32 + fr, fq * 8);
#define PG8_SA(b, h) (((b) * 2 + (h)) * HTB)
#define PG8_SB(b, h) ((4 + (b) * 2 + (h)) * HTB)
#define PG8_STAGE(bufoff, gbase, voff) do { _Pragma("unroll") for (int _i = 0; _i < 2; ++_i) \
        __builtin_amdgcn_global_load_lds((const unsigned*)((const char*)(gbase) + (voff)[_i]), (PG8_LAS unsigned*)(lds + (bufoff) + ldsw + _i * 8192), 16, 0, 0); } while (0)
#define PG8_LDA(dst, b, h) do { _Pragma("unroll") for (int m = 0; m < 4; ++m) _Pragma("unroll") for (int k = 0; k < 2; ++k) dst[m][k] = *(const PG8_LAS bf16x8*)(lds + PG8_SA(b, h) + aoff + m * 2048 + k * 1024); } while (0)
#define PG8_LDB(dst, b, h) do { _Pragma("unroll") for (int n = 0; n < 2; ++n) _Pragma("unroll") for (int k = 0; k < 2; ++k) dst[n][k] = *(const PG8_LAS bf16x8*)(lds + PG8_SB(b, h) + boff + n * 2048 + k * 1024); } while (0)
#define PG8_MMA(ai, bj, At, Bt) do { __builtin_amdgcn_s_setprio(1); _Pragma("unroll") for (int m = 0; m < 4; ++m) _Pragma("unroll") for (int n = 0; n < 2; ++n) _Pragma("unroll") for (int k = 0; k < 2; ++k) \
        acc[ai][bj][m][n] = __builtin_amdgcn_mfma_f32_16x16x32_bf16(Bt[n][k], At[m][k], acc[ai][bj][m][n], 0, 0, 0); __builtin_amdgcn_s_setprio(0); } while (0)
#define PG8_WAIT_V(n) asm volatile("s_waitcnt vmcnt(" #n ")" ::: "memory")
#define PG8_WAIT_L(n) asm volatile("s_waitcnt lgkmcnt(" #n ")" ::: "memory")
#define PG8_BAR __builtin_amdgcn_s_barrier()
#define PG8_SCHED __builtin_amdgcn_sched_barrier(0)
    Unit cur, nxt; int ui = 0;
    if (!S.next(0, cur)) return;
    f32x4 acc[2][2][4][2];
#pragma unroll
    for (int a = 0; a < 2; ++a)
#pragma unroll
        for (int b = 0; b < 2; ++b)
#pragma unroll
            for (int m = 0; m < 4; ++m)
#pragma unroll
                for (int n = 0; n < 2; ++n) acc[a][b][m][n] = (f32x4){0.f, 0.f, 0.f, 0.f};
    bf16x8 At[4][2], B0[2][2], B1[2][2];
    const char* cA = (const char*)g.A + (size_t)cur.pm * tstepA; const char* cB = (const char*)g.Bt + (size_t)cur.pn * tstep;
    S.a_ready(cur);
    if constexpr (SP2) {
        PG8_STAGE(PG8_SB(0, 0), cB, voffB); PG8_STAGE(PG8_SB(0, 1), cB + hstep, voffB); PG8_STAGE(PG8_SA(0, 0), cA, voffA); PG8_STAGE(PG8_SA(0, 1), cA + hstepA, voffA);
        if (wr == 1) PG8_BAR;
        PG8_WAIT_V(2); PG8_BAR;
        PG8_STAGE(PG8_SB(1, 0), cB + kstep, voffB); PG8_STAGE(PG8_SA(1, 0), cA + kstep, voffA); PG8_STAGE(PG8_SB(1, 1), cB + hstep + kstep, voffB);
        PG8_WAIT_V(6); PG8_BAR;
    } else {
        PG8_STAGE(PG8_SB(0, 0), cB, voffB); PG8_STAGE(PG8_SA(0, 0), cA, voffA); PG8_STAGE(PG8_SB(0, 1), cB + hstep, voffB); PG8_STAGE(PG8_SA(0, 1), cA + hstepA, voffA);
        if (wr == 1) PG8_BAR;
        PG8_WAIT_V(4); PG8_BAR;
        PG8_STAGE(PG8_SB(1, 0), cB + kstep, voffB); PG8_STAGE(PG8_SA(1, 0), cA + kstep, voffA); PG8_STAGE(PG8_SB(1, 1), cB + hstep + kstep, voffB);
        PG8_WAIT_V(6); PG8_BAR;
    }
    for (;;) {
        const bool has_next = S.next(ui + 1, nxt);
        const char* nA = has_next ? (const char*)g.A + (size_t)nxt.pm * tstepA : cA; const char* nB = has_next ? (const char*)g.Bt + (size_t)nxt.pn * tstep : cB;
        for (int t = 0; t < nt; t += 2) {
            const bool last = (t == nt - 2);
            const char* a1 = cA + (size_t)(t + 1) * kstep;
            const char* a2 = last ? nA : cA + (size_t)(t + 2) * kstep; const char* b2 = last ? nB : cB + (size_t)(t + 2) * kstep;
            const char* a3 = a2 + kstep; const char* b3 = b2 + kstep;
            if (last && has_next) S.a_ready(nxt);
            if constexpr (SP2) {
            PG8_LDB(B0, 0, 0); PG8_LDB(B1, 0, 1); PG8_SCHED; PG8_LDA(At, 0, 0); PG8_STAGE(PG8_SA(1, 1), a1 + hstepA, voffA);
            PG8_WAIT_V(8); PG8_WAIT_L(0); PG8_BAR; PG8_MMA(0, 0, At, B0); PG8_MMA(0, 1, At, B1); PG8_BAR; PG8_SCHED;
            PG8_LDA(At, 0, 1); PG8_STAGE(PG8_SB(0, 0), b2, voffB); PG8_STAGE(PG8_SB(0, 1), b2 + hstep, voffB); PG8_STAGE(PG8_SA(0, 0), a2, voffA);
            PG8_WAIT_V(8); PG8_WAIT_L(0); PG8_BAR; PG8_MMA(1, 0, At, B0); PG8_MMA(1, 1, At, B1); PG8_BAR; PG8_SCHED;
            PG8_LDB(B0, 1, 0); PG8_LDB(B1, 1, 1); PG8_SCHED; PG8_LDA(At, 1, 0); PG8_STAGE(PG8_SA(0, 1), a2 + hstepA, voffA);
            PG8_WAIT_V(8); PG8_WAIT_L(0); PG8_BAR; PG8_MMA(0, 0, At, B0); PG8_MMA(0, 1, At, B1); PG8_BAR; PG8_SCHED;
            PG8_LDA(At, 1, 1); PG8_STAGE(PG8_SB(1, 0), b3, voffB); PG8_STAGE(PG8_SB(1, 1), b3 + hstep, voffB); PG8_STAGE(PG8_SA(1, 0), a3, voffA);
            PG8_WAIT_V(8); PG8_WAIT_L(0); PG8_BAR; PG8_MMA(1, 0, At, B0); PG8_MMA(1, 1, At, B1); PG8_BAR; PG8_SCHED;
            } else {
            PG8_LDB(B0, 0, 0); PG8_SCHED; PG8_LDA(At, 0, 0); PG8_STAGE(PG8_SA(1, 1), a1 + hstepA, voffA);
            PG8_WAIT_L(8); PG8_BAR; PG8_WAIT_L(0); PG8_MMA(0, 0, At, B0); PG8_BAR; PG8_SCHED;
            PG8_LDB(B1, 0, 1); PG8_STAGE(PG8_SB(0, 0), b2, voffB);
            PG8_BAR; PG8_WAIT_L(0); PG8_MMA(0, 1, At, B1); PG8_BAR;
            PG8_LDA(At, 0, 1); PG8_STAGE(PG8_SA(0, 0), a2, voffA);
            PG8_BAR; PG8_WAIT_L(0); PG8_MMA(1, 0, At, B0); PG8_BAR; PG8_SCHED;
            PG8_STAGE(PG8_SB(0, 1), b2 + hstep, voffB);
            PG8_WAIT_V(6); PG8_BAR; PG8_MMA(1, 1, At, B1); PG8_BAR;
            PG8_LDB(B0, 1, 0); PG8_SCHED; PG8_LDA(At, 1, 0); PG8_STAGE(PG8_SA(0, 1), a2 + hstepA, voffA);
            PG8_WAIT_L(8); PG8_BAR; PG8_WAIT_L(0); PG8_MMA(0, 0, At, B0); PG8_BAR; PG8_SCHED;
            PG8_LDB(B1, 1, 1); PG8_STAGE(PG8_SB(1, 0), b3, voffB);
            PG8_BAR; PG8_WAIT_L(0); PG8_MMA(0, 1, At, B1); PG8_BAR;
            PG8_LDA(At, 1, 1); PG8_STAGE(PG8_SA(1, 0), a3, voffA);
            PG8_BAR; PG8_WAIT_L(0); PG8_MMA(1, 0, At, B0); PG8_BAR; PG8_SCHED;
            PG8_STAGE(PG8_SB(1, 1), b3 + hstep, voffB);
            PG8_WAIT_V(6); PG8_BAR; PG8_MMA(1, 1, At, B1); PG8_BAR;
            }
        }
        if constexpr (ALIGN_EPI) { if (wr == 0) PG8_BAR; }
        if constexpr (!Epi::AFTER_DRAIN) { E(acc, cur, wr, wc, fr, fq); S.done(cur); }
        if (!has_next) break;
#pragma unroll
        for (int a = 0; a < 2; ++a)
#pragma unroll
            for (int b = 0; b < 2; ++b)
#pragma unroll
                for (int m = 0; m < 4; ++m)
#pragma unroll
                    for (int n = 0; n < 2; ++n) acc[a][b][m][n] = (f32x4){0.f, 0.f, 0.f, 0.f};
        cur = nxt; cA = nA; cB = nB; ++ui;
        if constexpr (ALIGN_EPI) { if (wr == 1) PG8_BAR; }
    }
    PG8_WAIT_V(0);
    if constexpr (!ALIGN_EPI) { if (wr == 0) PG8_BAR; }
    PG8_BAR;
    if constexpr (Epi::AFTER_DRAIN) { E.fused(acc, cur, wr, wc, fr, fq, lds, wid, lane); S.done(cur); }
#undef PG8_SA
#undef PG8_SB
#undef PG8_STAGE
#undef PG8_LDA
#undef PG8_LDB
#undef PG8_MMA
#undef PG8_WAIT_V
#undef PG8_WAIT_L
#undef PG8_BAR
#undef PG8_SCHED
}
}

namespace att {
using bf16 = __hip_bfloat16;
constexpr int D = 128, NW = 8, QBLK = 32, KVBLK = 64;
constexpr float SCALE = 0.088388347648318440f;
constexpr float THR = 8.f;
constexpr int SDEPTH = 2;
constexpr size_t SHM_V = KVBLK * D * 2, SHM_K = KVBLK * D * 2, SHM_ATTN = 2 * SHM_V + 2 * SHM_K + NW * 64 * 4;
using bf16x8 = __attribute__((ext_vector_type(8))) short;
using s16x4  = __attribute__((ext_vector_type(4))) short;
using f32x16 = __attribute__((ext_vector_type(16))) float;
using f32x8  = __attribute__((ext_vector_type(8))) float;
using u32x4  = __attribute__((ext_vector_type(4))) unsigned;
#define KSWZ(row, colB) ((row) * 256 + ((colB) ^ (((row) & 7) << 4)))
#define SBAR() __builtin_amdgcn_sched_barrier(0)
__device__ __forceinline__ int crow(int r, int hi) { return (r & 3) + 8 * (r >> 2) + 4 * hi; }
__device__ __forceinline__ unsigned cvtpk(float lo, float hi) {
  unsigned r; asm volatile("v_cvt_pk_bf16_f32 %0, %1, %2" : "=v"(r) : "v"(lo), "v"(hi)); return r;
}
template <typename TIn> struct Stage;
template <> struct Stage<bf16>  { using T = bf16x8;
  __device__ static __forceinline__ T ld8(const bf16* p) { return *reinterpret_cast<const bf16x8*>(p); }
  __device__ static __forceinline__ bf16x8 tobf(T x) { return x; } };
template <> struct Stage<float> { using T = f32x8;
  __device__ static __forceinline__ T ld8(const float* p) { return *reinterpret_cast<const f32x8*>(p); }
  __device__ static __forceinline__ bf16x8 tobf(T x) {
    u32x4 w = {cvtpk(x[0], x[1]), cvtpk(x[2], x[3]), cvtpk(x[4], x[5]), cvtpk(x[6], x[7])}; return *reinterpret_cast<bf16x8*>(&w); } };

__device__ __forceinline__ void partialSM(f32x16& p0, f32x16& p1, float& m_reg, float& mn, float& alpha) {
  constexpr float C = SCALE * 1.4426950408889634f;
  float pmax = p0[0]; for (int r = 1; r < 16; ++r) pmax = fmaxf(pmax, p0[r]); for (int r = 0; r < 16; ++r) pmax = fmaxf(pmax, p1[r]);
  { auto rr = __builtin_amdgcn_permlane32_swap(__float_as_uint(pmax), __float_as_uint(pmax), false, false);
    pmax = fmaxf(__uint_as_float(rr[0]), __uint_as_float(rr[1])); }
  if (__builtin_expect(__all(pmax - m_reg <= THR / SCALE), 1)) { mn = m_reg; alpha = 1.f; }
  else { mn = fmaxf(m_reg, pmax); alpha = __builtin_amdgcn_exp2f((m_reg - mn) * C); m_reg = mn; }
  float mnC = -mn * C;
  for (int r = 0; r < 16; ++r) p0[r] = fmaf(p0[r], C, mnC); for (int r = 0; r < 16; ++r) p1[r] = fmaf(p1[r], C, mnC);
  for (int r = 0; r < 16; ++r) p0[r] = __builtin_amdgcn_exp2f(p0[r]);
}
__device__ __forceinline__ void finishSM(f32x16& p0, f32x16& p1, float alpha, float& l_reg, bf16x8& pa0, bf16x8& pa1, bf16x8& pa2, bf16x8& pa3) {
  for (int r = 0; r < 16; ++r) p1[r] = __builtin_amdgcn_exp2f(p1[r]);
  float ps = 0; for (int r = 0; r < 16; ++r) ps += p0[r]; for (int r = 0; r < 16; ++r) ps += p1[r];
  { auto rr = __builtin_amdgcn_permlane32_swap(__float_as_uint(ps), __float_as_uint(ps), false, false);
    ps = __uint_as_float(rr[0]) + __uint_as_float(rr[1]); }
  l_reg = l_reg * alpha + ps;
#define PK4(P, BASE, OUT) do { unsigned a0 = cvtpk(P[BASE + 0], P[BASE + 1]), a1 = cvtpk(P[BASE + 2], P[BASE + 3]);   \
    unsigned b0 = cvtpk(P[BASE + 4], P[BASE + 5]), b1 = cvtpk(P[BASE + 6], P[BASE + 7]);                              \
    auto r0 = __builtin_amdgcn_permlane32_swap(a0, b0, false, false); auto r1 = __builtin_amdgcn_permlane32_swap(a1, b1, false, false); \
    u32x4 w = {r0[0], r1[0], r0[1], r1[1]}; OUT = *reinterpret_cast<bf16x8*>(&w); } while (0)
  PK4(p0, 0, pa0); PK4(p0, 8, pa1); PK4(p1, 0, pa2); PK4(p1, 8, pa3);
#undef PK4
}
__device__ __forceinline__ void qkt(f32x16& p0, f32x16& p1, const bf16* Ks, const bf16x8* qr, int r32, int hi) {
  p0 = f32x16{}; p1 = f32x16{};
  for (int d0 = 0; d0 < 8; ++d0) { int cb = (d0 * 16 + hi * 8) * 2;
    bf16x8 b0 = *reinterpret_cast<const bf16x8*>((const char*)Ks + KSWZ(r32, cb));
    bf16x8 b1 = *reinterpret_cast<const bf16x8*>((const char*)Ks + KSWZ(32 + r32, cb));
    p0 = __builtin_amdgcn_mfma_f32_32x32x16_bf16(b0, qr[d0], p0, 0, 0, 0);
    p1 = __builtin_amdgcn_mfma_f32_32x32x16_bf16(b1, qr[d0], p1, 0, 0, 0); }
}
__device__ __forceinline__ int v_st(int k, int c) { const int kk = (k & ~0xC) | ((k & 4) << 1) | ((k & 8) >> 1); return ((kk >> 3) * 4 + (c >> 5)) * 512 + ((kk & 7) * 32 + (c & 31)) * 2; }
__device__ __forceinline__ int v_rd_base(int lane) { return ((lane & 3) << 3) | (((lane >> 2) & 3) << 6) | (((lane >> 4) & 1) << 5) | (((lane >> 5) & 1) << 8); }
constexpr int v_rd_off(int d0, int ks, int half) { return d0 * 512 + ks * 4096 + half * 2048; }
template <int OFF> __device__ __forceinline__ s16x4 tr_read(int vb) {
  s16x4 r; asm volatile("ds_read_b64_tr_b16 %0, %1 offset:%2" : "=&v"(r) : "v"(vb), "i"(OFF) : "memory"); return r;
}
template <int D0> __device__ __forceinline__ void pv_one(f32x16& od, int vb, bf16x8 pa0, bf16x8 pa1, bf16x8 pa2, bf16x8 pa3) {
  const s16x4 l0 = tr_read<v_rd_off(D0, 0, 0)>(vb), h0 = tr_read<v_rd_off(D0, 0, 1)>(vb), l1 = tr_read<v_rd_off(D0, 1, 0)>(vb), h1 = tr_read<v_rd_off(D0, 1, 1)>(vb);
  const s16x4 l2 = tr_read<v_rd_off(D0, 2, 0)>(vb), h2 = tr_read<v_rd_off(D0, 2, 1)>(vb), l3 = tr_read<v_rd_off(D0, 3, 0)>(vb), h3 = tr_read<v_rd_off(D0, 3, 1)>(vb);
  asm volatile("s_waitcnt lgkmcnt(0)" ::: "memory"); SBAR();
#define PK(L, H) (bf16x8){L[0], L[1], L[2], L[3], H[0], H[1], H[2], H[3]}
  od = __builtin_amdgcn_mfma_f32_32x32x16_bf16(pa0, PK(l0, h0), od, 0, 0, 0);
  od = __builtin_amdgcn_mfma_f32_32x32x16_bf16(pa1, PK(l1, h1), od, 0, 0, 0);
  od = __builtin_amdgcn_mfma_f32_32x32x16_bf16(pa2, PK(l2, h2), od, 0, 0, 0);
  od = __builtin_amdgcn_mfma_f32_32x32x16_bf16(pa3, PK(l3, h3), od, 0, 0, 0);
#undef PK
}
__device__ __forceinline__ void pv_d0(f32x16* o, int vb, bf16x8 pa0, bf16x8 pa1, bf16x8 pa2, bf16x8 pa3) {
  pv_one<0>(o[0], vb, pa0, pa1, pa2, pa3); pv_one<1>(o[1], vb, pa0, pa1, pa2, pa3); pv_one<2>(o[2], vb, pa0, pa1, pa2, pa3); pv_one<3>(o[3], vb, pa0, pa1, pa2, pa3);
}

template <typename TQ, int LDQ, int LDK, int LDO>
__device__ __forceinline__ void attn_dense_body(const TQ* __restrict__ Qb, const bf16* __restrict__ Kh, const bf16* __restrict__ Vh,
                                                unsigned short* __restrict__ Ob, int seq, char* lds) {
  using St = Stage<bf16>; using SQ = Stage<TQ>;
  const int tid = opaque_tid(), wid = tid >> 6, lane = tid & 63, r32 = lane & 31, hi = lane >> 5;
  bf16* V_lds = (bf16*)lds; bf16* K_lds = (bf16*)(lds + 2 * SHM_V);
  float* ws = (float*)(lds + 2 * SHM_V + 2 * SHM_K) + wid * 64; float* li_l = ws; float* al_l = ws + 32;
  float m_reg = -1e30f, l_reg = 0; f32x16 o[4] = {}; bf16x8 qr[8];
  const TQ* Qw = Qb + (long)(wid * QBLK + r32) * LDQ + hi * 8;
#pragma unroll
  for (int d0 = 0; d0 < 8; ++d0) qr[d0] = SQ::tobf(SQ::ld8(Qw + d0 * 16));
  const int sr = tid >> 4, sc = (tid & 15) * 8, vst0 = v_st(sr, sc), vst1 = v_st(32 + sr, sc);
  const int vb0 = (int)(uintptr_t)V_lds + v_rd_base(lane);
  struct { typename St::T vs0, vs1, ks0, ks1; } sr_[SDEPTH];
#define SLOAD(i, k0) do { sr_[i].vs0 = St::ld8(&Vh[(long)((k0) + sr) * LDK + sc]); sr_[i].vs1 = St::ld8(&Vh[(long)((k0) + 32 + sr) * LDK + sc]); \
    sr_[i].ks0 = St::ld8(&Kh[(long)((k0) + sr) * LDK + sc]); sr_[i].ks1 = St::ld8(&Kh[(long)((k0) + 32 + sr) * LDK + sc]); } while (0)
#define SWRITE(b, i) do { *(bf16x8*)((char*)V_lds + (b) * SHM_V + vst0) = St::tobf(sr_[i].vs0);          \
    *(bf16x8*)((char*)V_lds + (b) * SHM_V + vst1) = St::tobf(sr_[i].vs1); int kc = sc * 2;               \
    *(bf16x8*)((char*)K_lds + (b) * SHM_K + KSWZ(sr, kc)) = St::tobf(sr_[i].ks0);                       \
    *(bf16x8*)((char*)K_lds + (b) * SHM_K + KSWZ(32 + sr, kc)) = St::tobf(sr_[i].ks1); } while (0)
#define SWAIT() do { if constexpr (SDEPTH == 2) asm volatile("s_waitcnt vmcnt(4)" ::: "memory"); else asm volatile("s_waitcnt vmcnt(0)" ::: "memory"); } while (0)
#define RESC(a) do { if (__any((a) < 1.f)) { if (hi == 0) al_l[r32] = (a); asm volatile("s_waitcnt lgkmcnt(0)" ::: "memory"); \
    for (int d = 0; d < 4; ++d) for (int r = 0; r < 16; ++r) o[d][r] *= al_l[crow(r, hi)]; } } while (0)
  f32x16 pA0, pA1, pB0, pB1; float mnA, mnB, alA, alB; bf16x8 pa0, pa1, pa2, pa3; const int NT = seq / KVBLK;
  constexpr int SE = 0, SO = SDEPTH - 1;
  SLOAD(SE, 0); asm volatile("s_waitcnt vmcnt(0)" ::: "memory"); SWRITE(0, SE); __syncthreads();
  qkt(pA0, pA1, K_lds, qr, r32, hi); partialSM(pA0, pA1, m_reg, mnA, alA);
  SLOAD(SO, KVBLK); if constexpr (SDEPTH == 2) { if (2 < NT) SLOAD(SE, 2 * KVBLK); }
  SWAIT(); SWRITE(1, SO); __syncthreads();
  for (int j = 1; j + 1 < NT; j += 2) {
    SBAR(); qkt(pB0, pB1, (bf16*)((char*)K_lds + SHM_K), qr, r32, hi);
    finishSM(pA0, pA1, alA, l_reg, pa0, pa1, pa2, pa3); SBAR();
    SLOAD(SO, (j + SDEPTH) * KVBLK); SBAR();
    pv_d0(o, vb0, pa0, pa1, pa2, pa3); partialSM(pB0, pB1, m_reg, mnB, alB);
    __syncthreads(); SWAIT(); SWRITE(0, SE);
    RESC(alB); __syncthreads();
    SBAR(); qkt(pA0, pA1, K_lds, qr, r32, hi);
    finishSM(pB0, pB1, alB, l_reg, pa0, pa1, pa2, pa3); SBAR();
    if (SDEPTH == 1 || j + 3 < NT) SLOAD(SE, (j + 1 + SDEPTH) * KVBLK); SBAR();
    pv_d0(o, vb0 + (int)SHM_V, pa0, pa1, pa2, pa3); partialSM(pA0, pA1, m_reg, mnA, alA);
    __syncthreads(); SWAIT(); SWRITE(1, SO);
    RESC(alA); __syncthreads();
  }
  SBAR(); qkt(pB0, pB1, (bf16*)((char*)K_lds + SHM_K), qr, r32, hi);
  finishSM(pA0, pA1, alA, l_reg, pa0, pa1, pa2, pa3); SBAR();
  pv_d0(o, vb0, pa0, pa1, pa2, pa3); partialSM(pB0, pB1, m_reg, mnB, alB);
  __syncthreads(); RESC(alB);
  finishSM(pB0, pB1, alB, l_reg, pa0, pa1, pa2, pa3); SBAR();
  pv_d0(o, vb0 + (int)SHM_V, pa0, pa1, pa2, pa3);
  if (hi == 0) li_l[r32] = l_reg; asm volatile("s_waitcnt lgkmcnt(0)" ::: "memory");
  float rli[16];
#pragma unroll
  for (int r = 0; r < 16; ++r) rli[r] = __builtin_amdgcn_rcpf(li_l[crow(r, hi)]);
  unsigned short* Ow = Ob + (long)(wid * QBLK) * LDO;
#pragma unroll
  for (int r = 0; r < 16; ++r) { int orow = crow(r, hi);
    for (int d0 = 0; d0 < 4; ++d0) Ow[(long)orow * LDO + d0 * 32 + r32] = (unsigned short)(cvtpk(o[d0][r] * rli[r], 0.f) & 0xffffu); }
#undef SLOAD
#undef SWRITE
#undef SWAIT
#undef RESC
}

}

typedef const __attribute__((address_space(4))) unsigned char* kargp_t;
__device__ __forceinline__ unsigned char* karg_ptr(int byte_off) {
    kargp_t p = (kargp_t)__builtin_amdgcn_kernarg_segment_ptr(); asm volatile("" : "+s"(p));
    return *(unsigned char* const __attribute__((address_space(4)))*)(p + byte_off);
}
#define IN(k) ((const float*)karg_ptr(8 * (k)))
#define WS() (karg_ptr(168))
#define P_xlat ((float*)karg_ptr(160))
#define P_MOD ((float*)(WS() + WS_MOD))
#define P_xctx ((float*)(WS() + WS_XCTX))
#define P_GB ((float*)(WS() + WS_GB))
#define P_Wb ((bf16_t*)(WS() + WS_W))
#define P_BIG1 ((bf16_t*)(WS() + WS_BIG1))
#define P_BIG2 ((bf16_t*)(WS() + WS_BIG2))
#define MODL (P_MOD + (size_t)L * 17 * NMODC)
#define P_QKV ((bf16_t*)(WS() + WS_BIG1 + B1_QKV))
#define P_KB ((bf16_t*)(WS() + WS_BIG1 + B1_KB))
#define P_VB ((bf16_t*)(WS() + WS_BIG1 + B1_VB))
#define P_AO ((bf16_t*)(WS() + WS_BIG1 + B1_AO))

#define LAS __attribute__((address_space(3)))
typedef unsigned short bf16_t;
typedef short bf16x8 __attribute__((ext_vector_type(8)));
typedef float f32x4 __attribute__((ext_vector_type(4)));
typedef float f32x16 __attribute__((ext_vector_type(16)));
typedef unsigned u32x4 __attribute__((ext_vector_type(4)));
typedef unsigned u32x2 __attribute__((ext_vector_type(2)));

constexpr int DM = 1024, NB = 16, SEQ = 2048, CTXL = 256, NLAT = NB * SEQ, NCTX = NB * CTXL, MROWS = NLAT + NCTX;
constexpr int DFF = 2816, NMODC = 6 * DM, GIN1 = 4352, KVLEN = CTXL + SEQ;
constexpr float ALPHA = 1.6817928305074290f;
constexpr float EPS = 1e-6f;
constexpr int NTHR = 512, NWAVE = 8;

constexpr size_t WS_BAR  = 0, WS_BAR_BYTES = 16384;
constexpr size_t WS_MOD  = WS_BAR_BYTES;
constexpr size_t WS_XCTX = WS_MOD + (size_t)4 * 17 * NMODC * 4;
constexpr size_t WS_GB   = WS_XCTX + (size_t)NCTX * DM * 4;
constexpr size_t WS_W    = WS_GB + (size_t)MROWS * 64 * 4;
constexpr size_t W_A = 0, W_Z = W_A + (size_t)GIN1 * 1024, W_O = W_Z + (size_t)2048 * 1024, W_F1 = W_O + (size_t)2048 * 1024, W_F2 = W_F1 + (size_t)5632 * 1024, W_END = W_F2 + (size_t)1024 * DFF;
constexpr size_t WS_BIG1 = WS_W + W_END * 2;
constexpr size_t WS_BIG2 = WS_BIG1 + (size_t)MROWS * 4096 * 2;
constexpr size_t WS_END  = WS_BIG2 + (size_t)MROWS * 2048 * 2;
constexpr size_t B1_QKV = 0, B1_KB = (size_t)MROWS * 1536 * 2, B1_VB = B1_KB + (size_t)NB * 2 * KVLEN * 128 * 2, B1_AO = B1_VB + (size_t)NB * 2 * KVLEN * 128 * 2;

constexpr int LDS_BYTES = 161792, LDS_XB = 155008, LDS_S2 = 155648;

typedef float f32x2_t __attribute__((ext_vector_type(2))); typedef __bf16 bf16x2_t __attribute__((ext_vector_type(2)));
__device__ __forceinline__ unsigned cvtpk2(float lo, float hi) { f32x2_t v = {lo, hi}; bf16x2_t b = __builtin_convertvector(v, bf16x2_t); return __builtin_bit_cast(unsigned, b); }
__device__ __forceinline__ float bflo(unsigned u) { return __uint_as_float(u << 16); }
__device__ __forceinline__ float bfhi(unsigned u) { return __uint_as_float(u & 0xffff0000u); }
__device__ __forceinline__ float silu_f(float v) { return v * __builtin_amdgcn_rcpf(1.f + __builtin_amdgcn_exp2f(v * -1.4426950408889634f)); }
template <int X> __device__ __forceinline__ float swzx(float v) { return __uint_as_float((unsigned)__builtin_amdgcn_ds_swizzle((int)__float_as_uint(v), (X << 10) | 0x1f)); }
__device__ __forceinline__ float wave_sum(float v) {
    v += swzx<1>(v); v += swzx<2>(v); v += swzx<4>(v); v += swzx<8>(v); v += swzx<16>(v);
    auto rr = __builtin_amdgcn_permlane32_swap(__float_as_uint(v), __float_as_uint(v), false, false);
    return __uint_as_float(rr[0]) + __uint_as_float(rr[1]);
}
__device__ __forceinline__ int crow(int r, int hi) { return (r & 3) + 8 * (r >> 2) + 4 * hi; }

struct EpiPlainBf16 {
    static constexpr bool PERM = true, AFTER_DRAIN = false;
    bf16_t* O; int ldc;
    __device__ __forceinline__ void operator()(const pg8::f32x4 (&acc)[2][2][4][2], const pg8::Unit& u, int wr, int wc, int fr, int fq) const {
        const int row0 = u.pm * 256 + wr * 64 + fr, col0 = u.pn * 256 + wc * 32 + fq * 8;
#pragma unroll
        for (int ai = 0; ai < 2; ++ai)
#pragma unroll
            for (int m = 0; m < 4; ++m) { bf16_t* rp = O + (size_t)(row0 + ai * 128 + m * 16) * ldc + col0;
#pragma unroll
                for (int bj = 0; bj < 2; ++bj) { const pg8::f32x4 v0 = acc[ai][bj][m][0], v1 = acc[ai][bj][m][1];
                    *(u32x4*)(rp + bj * 128) = (u32x4){cvtpk2(v0[0], v0[1]), cvtpk2(v0[2], v0[3]), cvtpk2(v1[0], v1[1]), cvtpk2(v1[2], v1[3])}; } }
    }
};
struct EpiGdnIn {
    static constexpr bool PERM = true, AFTER_DRAIN = false;
    bf16_t* P; float* GB; const float* a_log; const float* dt_bias;
    __device__ __forceinline__ void operator()(const pg8::f32x4 (&acc)[2][2][4][2], const pg8::Unit& u, int wr, int wc, int fr, int fq) const {
        const int row0 = u.pm * 256 + wr * 64 + fr;
        if (u.pn < 16) {
            const int col0 = u.pn * 256 + wc * 32 + fq * 8;
#pragma unroll
            for (int ai = 0; ai < 2; ++ai)
#pragma unroll
                for (int m = 0; m < 4; ++m) { bf16_t* rp = P + (size_t)(row0 + ai * 128 + m * 16) * 4096 + col0;
#pragma unroll
                    for (int bj = 0; bj < 2; ++bj) { const pg8::f32x4 v0 = acc[ai][bj][m][0], v1 = acc[ai][bj][m][1];
                        *(u32x4*)(rp + bj * 128) = (u32x4){cvtpk2(v0[0], v0[1]), cvtpk2(v0[2], v0[3]), cvtpk2(v1[0], v1[1]), cvtpk2(v1[2], v1[3])}; } }
        } else if (wc < 2) {
#pragma unroll
            for (int n = 0; n < 2; ++n) {
                const int col = wc * 32 + fq * 8 + n * 4;
                float al[4], db[4];
#pragma unroll
                for (int e = 0; e < 4; ++e) { const int idx = (col + e) & 31; al[e] = __expf(a_log[idx]); db[e] = dt_bias[idx]; }
#pragma unroll
                for (int ai = 0; ai < 2; ++ai)
#pragma unroll
                    for (int m = 0; m < 4; ++m) { const pg8::f32x4 v = acc[ai][0][m][n]; f32x4 o;
#pragma unroll
                        for (int e = 0; e < 4; ++e) {
                            if (col < 32) o[e] = 1.f / (1.f + __expf(-v[e]));
                            else { const float xx = v[e] + db[e]; const float sp = xx > 20.f ? xx : log1pf(__expf(xx)); o[e] = -al[e] * sp; } }
                        *(f32x4*)(GB + (size_t)(row0 + ai * 128 + m * 16) * 64 + col) = o; }
            }
        }
    }
};
struct EpiGateZ {
    static constexpr bool PERM = true, AFTER_DRAIN = false;
    bf16_t* Y;
    __device__ __forceinline__ void operator()(const pg8::f32x4 (&acc)[2][2][4][2], const pg8::Unit& u, int wr, int wc, int fr, int fq) const {
        asm volatile("" : "+v"(fr));
        const int row0 = u.pm * 256 + wr * 64 + fr, col0 = u.pn * 256 + wc * 32 + fq * 8;
#pragma unroll
        for (int ai = 0; ai < 2; ++ai) {
            u32x4 on[4][2];
#pragma unroll
            for (int m = 0; m < 4; ++m)
#pragma unroll
                for (int bj = 0; bj < 2; ++bj) on[m][bj] = *(const u32x4*)(Y + (size_t)(row0 + ai * 128 + m * 16) * 4096 + col0 + bj * 128);
#pragma unroll
            for (int m = 0; m < 4; ++m)
#pragma unroll
                for (int bj = 0; bj < 2; ++bj) { const pg8::f32x4 v0 = acc[ai][bj][m][0], v1 = acc[ai][bj][m][1]; const u32x4 o = on[m][bj];
                    *(u32x4*)(Y + (size_t)(row0 + ai * 128 + m * 16) * 4096 + col0 + bj * 128) =
                        (u32x4){cvtpk2(bflo(o.x) * silu_f(v0[0]), bfhi(o.x) * silu_f(v0[1])), cvtpk2(bflo(o.y) * silu_f(v0[2]), bfhi(o.y) * silu_f(v0[3])),
                                cvtpk2(bflo(o.z) * silu_f(v1[0]), bfhi(o.z) * silu_f(v1[1])), cvtpk2(bflo(o.w) * silu_f(v1[2]), bfhi(o.w) * silu_f(v1[3]))}; }
        }
    }
};
struct EpiResid {
    static constexpr bool PERM = true, AFTER_DRAIN = false;
    float* xlat; float* xctx; const float* gate; float alpha, gs;
    __device__ __forceinline__ void operator()(const pg8::f32x4 (&acc)[2][2][4][2], const pg8::Unit& u, int wr, int wc, int fr, int fq) const {
        asm volatile("" : "+v"(fr));
        const int pm = u.pm;
        float* xb = pm < 128 ? xlat + (size_t)pm * 256 * DM : xctx + (size_t)(pm - 128) * 256 * DM;
        const float* gp = gate + (size_t)(pm < 128 ? (pm >> 3) : 16) * NMODC;
        const int col0 = u.pn * 256 + wc * 32 + fq * 8, r0 = wr * 64 + fr;
#pragma unroll
        for (int bj = 0; bj < 2; ++bj) { const int col = col0 + bj * 128; const f32x4 g0 = *(const f32x4*)(gp + col) * gs, g1 = *(const f32x4*)(gp + col + 4) * gs;
#pragma unroll
            for (int ai = 0; ai < 2; ++ai) {
                f32x4 x0[4], x1[4];
#pragma unroll
                for (int m = 0; m < 4; ++m) { const float* p = xb + (size_t)(r0 + ai * 128 + m * 16) * DM + col; x0[m] = *(const f32x4*)p; x1[m] = *(const f32x4*)(p + 4); }
#pragma unroll
                for (int m = 0; m < 4; ++m) { float* p = xb + (size_t)(r0 + ai * 128 + m * 16) * DM + col; const pg8::f32x4 a0 = acc[ai][bj][m][0], a1 = acc[ai][bj][m][1]; f32x4 y0, y1;
#pragma unroll
                    for (int e = 0; e < 4; ++e) { y0[e] = x0[m][e] * alpha + g0[e] * a0[e]; y1[e] = x1[m][e] * alpha + g1[e] * a1[e]; }
                    *(f32x4*)p = y0; *(f32x4*)(p + 4) = y1; }
            }
        }
    }
};
struct EpiSwiglu {
    static constexpr bool PERM = true, AFTER_DRAIN = false;
    bf16_t* ACT;
    __device__ __forceinline__ void operator()(const pg8::f32x4 (&acc)[2][2][4][2], const pg8::Unit& u, int wr, int wc, int fr, int fq) const {
        const int row0 = u.pm * 256 + wr * 64 + fr, col0 = u.pn * 128 + wc * 32 + fq * 8;
#pragma unroll
        for (int ai = 0; ai < 2; ++ai)
#pragma unroll
            for (int m = 0; m < 4; ++m) { const pg8::f32x4 g0 = acc[ai][0][m][0], g1 = acc[ai][0][m][1], u0 = acc[ai][1][m][0], u1 = acc[ai][1][m][1];
                *(u32x4*)(ACT + (size_t)(row0 + ai * 128 + m * 16) * DFF + col0) = (u32x4){cvtpk2(silu_f(g0[0]) * u0[0], silu_f(g0[1]) * u0[1]), cvtpk2(silu_f(g0[2]) * u0[2], silu_f(g0[3]) * u0[3]),
                                                                                        cvtpk2(silu_f(g1[0]) * u1[0], silu_f(g1[1]) * u1[1]), cvtpk2(silu_f(g1[2]) * u1[2], silu_f(g1[3]) * u1[3])}; }
    }
};

__device__ __forceinline__ void phase_mod(const float* c, const float* c_ctx, const float* w_mod, const float* b_mod, float* MOD, LAS unsigned char* lds, int G, int bid) {
    const int tid = opaque_tid(), wave = tid >> 6, lane = tid & 63;
    LAS float* sc = (LAS float*)lds;
    LAS float* red = (LAS float*)(lds + 81920);
    if (bid < 384) {
        for (int idx = tid; idx < 17 * 1024; idx += NTHR) { const int row = idx >> 10, k = idx & 1023; const float v = row < 16 ? c[row * 1024 + k] : c_ctx[k]; sc[k * 20 + row] = v / (1.f + expf(-v)); }
    }
    __syncthreads();
    for (int item = bid; item < 384; item += G) {
        const int layer = item / 96, cgp = item % 96;
        const float* w = w_mod + (size_t)layer * 1024 * NMODC + cgp * 64 + lane;
        float acc[17];
#pragma unroll
        for (int r = 0; r < 17; ++r) acc[r] = 0.f;
        const int k0 = wave * 128;
        for (int kb = k0; kb < k0 + 128; kb += 16) {
            float wv[16];
#pragma unroll
            for (int q = 0; q < 16; ++q) wv[q] = __builtin_nontemporal_load(&w[(size_t)(kb + q) * NMODC]);
#pragma unroll
            for (int q = 0; q < 16; ++q) {
#pragma unroll
                for (int r = 0; r < 17; ++r) acc[r] += sc[(kb + q) * 20 + r] * wv[q]; }
        }
#pragma unroll
        for (int r = 0; r < 17; ++r) red[(wave * 17 + r) * 64 + lane] = acc[r];
        __syncthreads();
        for (int idx = tid; idx < 17 * 64; idx += NTHR) { const int r = idx >> 6, l = idx & 63; float s = 0.f;
#pragma unroll
            for (int wv = 0; wv < 8; ++wv) s += red[(wv * 17 + r) * 64 + l];
            MOD[(size_t)(layer * 17 + r) * NMODC + cgp * 64 + l] = s + b_mod[layer * NMODC + cgp * 64 + l]; }
        __syncthreads();
    }
}

__device__ __forceinline__ int srcmap(int mode, int n, int off) {
    if (mode == 0) return n + off;
    if (mode == 1) return n < 4096 ? n : (n < 4160 ? n + 2048 : -1);
    return ((n >> 7) & 1) * DFF + ((n >> 8) << 7) + (n & 127);
}
__device__ __forceinline__ void transpose_item(const float* W, int Nsrc, bf16_t* WT, int K, int mode, int off, int nblk, LAS float* scr, int item, int lane) {
    const int kb = item / nblk, nb = item % nblk, k0 = 64 * kb, n0 = 32 * nb;
    const int sc = srcmap(mode, n0 + (lane & 31), off);
    float wv_[32];
#pragma unroll
    for (int i = 0; i < 32; ++i) { const int kk = 2 * i + (lane >> 5); wv_[i] = sc >= 0 ? __builtin_nontemporal_load(&W[(size_t)(k0 + kk) * Nsrc + sc]) : 0.f; }
#pragma unroll
    for (int i = 0; i < 32; ++i) { const int kk = 2 * i + (lane >> 5); scr[kk * 33 + (lane & 31)] = wv_[i]; }
    asm volatile("s_waitcnt lgkmcnt(0)" ::: "memory");
    const int c = lane & 7;
#pragma unroll
    for (int j = 0; j < 4; ++j) { const int n = (lane >> 3) + 8 * j; const LAS float* s = scr + (8 * c) * 33 + n;
        u32x4 o; o.x = cvtpk2(s[0 * 33], s[1 * 33]); o.y = cvtpk2(s[2 * 33], s[3 * 33]); o.z = cvtpk2(s[4 * 33], s[5 * 33]); o.w = cvtpk2(s[6 * 33], s[7 * 33]);
        *(u32x4*)(WT + (size_t)(n0 + n) * K + k0 + 8 * c) = o; }
    asm volatile("s_waitcnt lgkmcnt(0)" ::: "memory");
}
struct ConvJob { const float* W; bf16_t* WT; int Nsrc, K, mode, off, nblk, nitems; };
__device__ __forceinline__ void phase_convert(int L, bf16_t* Wb, LAS unsigned char* lds, int G, int bid, int jobmask, int b0) {
    if (bid < b0) return;
    const int tid_ = opaque_tid(), lane = tid_ & 63, wave = __builtin_amdgcn_readfirstlane(tid_ >> 6), gw = (bid - b0) * NWAVE + wave, NGW = (G - b0) * NWAVE;
    LAS float* scr = (LAS float*)(lds + wave * 8448);
    const int j = L >> 1;
    ConvJob jb[5]; int nj = 0;
    if (!(L & 1)) {
        jb[0] = ConvJob{IN(10) + (size_t)j * 1024 * 6208, Wb + W_A, 6208, 1024, 1, 0, GIN1 / 32, (GIN1 / 32) * 16};
        jb[1] = ConvJob{IN(10) + (size_t)j * 1024 * 6208, Wb + W_Z, 6208, 1024, 0, 4096, 64, 64 * 16};
        jb[2] = ConvJob{IN(15) + (size_t)j * 2048 * 1024, Wb + W_O, 1024, 2048, 0, 0, 32, 32 * 32};
        nj = 3;
    } else {
        jb[0] = ConvJob{IN(16) + (size_t)j * 1024 * 1536, Wb + W_A, 1536, 1024, 0, 0, 48, 48 * 16};
        jb[1] = ConvJob{IN(19) + (size_t)j * 1024 * 1024, Wb + W_O, 1024, 1024, 0, 0, 32, 32 * 16};
        jb[2] = ConvJob{IN(19), Wb + W_O, 1024, 1024, 0, 0, 32, 0};
        nj = 3;
    }
    jb[3] = ConvJob{IN(8) + (size_t)L * 1024 * 5632, Wb + W_F1, 5632, 1024, 2, 0, 176, 176 * 16};
    jb[4] = ConvJob{IN(9) + (size_t)L * DFF * 1024, Wb + W_F2, 1024, DFF, 0, 0, 32, 32 * 44};
    (void)nj;
#pragma unroll
    for (int q = 0; q < 5; ++q) if (!((jobmask >> q) & 1)) jb[q].nitems = 0;
    const int total = jb[0].nitems + jb[1].nitems + jb[2].nitems + jb[3].nitems + jb[4].nitems;
    for (int it = gw; it < total; it += NGW) {
        int r = it;
#pragma unroll
        for (int q = 0; q < 5; ++q) {
            if (r >= 0 && r < jb[q].nitems) { transpose_item(jb[q].W, jb[q].Nsrc, jb[q].WT, jb[q].K, jb[q].mode, jb[q].off, jb[q].nblk, scr, r, lane); r = -1; }
            else if (r >= 0) r -= jb[q].nitems;
        }
    }
}

__device__ __forceinline__ void phase_prep(const float* src_lat, const float* src_ctx, float* xlat, float* xctx, bool write_x, const float* lng, const float* lnb,
                                           bf16_t* H, const float* shift, const float* scale, int nrows, int G, int bid) {
    const int tid_ = opaque_tid(), lane = tid_ & 63, gw = bid * NWAVE + __builtin_amdgcn_readfirstlane(tid_ >> 6), NGW = G * NWAVE;
    const int R = (nrows + NGW - 1) / NGW, rbeg = gw * R, rend = (rbeg + R < nrows) ? rbeg + R : nrows;
    f32x4 vn[4], g[4], bb[4], sh[4], scv[4];
#pragma unroll
    for (int j = 0; j < 4; ++j) { g[j] = (f32x4){1.f, 1.f, 1.f, 1.f}; bb[j] = (f32x4){0.f, 0.f, 0.f, 0.f}; sh[j] = bb[j]; scv[j] = bb[j]; vn[j] = bb[j]; }
    if (lng) {
#pragma unroll
        for (int j = 0; j < 4; ++j) { g[j] = *(const f32x4*)(lng + 4 * lane + 256 * j); bb[j] = *(const f32x4*)(lnb + 4 * lane + 256 * j); }
    }
    if (rbeg < rend) { const float* sp = rbeg < NLAT ? src_lat + (size_t)rbeg * DM : src_ctx + (size_t)(rbeg - NLAT) * DM;
#pragma unroll
        for (int j = 0; j < 4; ++j) vn[j] = *(const f32x4*)(sp + 4 * lane + 256 * j); }
    int curmod = -1;
    for (int row = rbeg; row < rend; ++row) {
        const bool islat = row < NLAT;
        f32x4 v[4];
#pragma unroll
        for (int j = 0; j < 4; ++j) v[j] = vn[j];
        if (row + 1 < rend) { const int rn = row + 1; const float* sp = rn < NLAT ? src_lat + (size_t)rn * DM : src_ctx + (size_t)(rn - NLAT) * DM;
#pragma unroll
            for (int j = 0; j < 4; ++j) vn[j] = *(const f32x4*)(sp + 4 * lane + 256 * j); }
        const int modrow = islat ? (row >> 11) : 16;
        if (H && modrow != curmod) { curmod = modrow; const size_t mo = (size_t)modrow * NMODC;
#pragma unroll
            for (int j = 0; j < 4; ++j) { sh[j] = *(const f32x4*)(shift + mo + 4 * lane + 256 * j); scv[j] = *(const f32x4*)(scale + mo + 4 * lane + 256 * j); } }
        if (lng) {
            float s = 0.f;
#pragma unroll
            for (int j = 0; j < 4; ++j) s += (v[j][0] + v[j][1]) + (v[j][2] + v[j][3]);
            const float mean = wave_sum(s) * (1.f / DM); float s2 = 0.f;
#pragma unroll
            for (int j = 0; j < 4; ++j) { v[j] = v[j] - mean; s2 += (v[j][0] * v[j][0] + v[j][1] * v[j][1]) + (v[j][2] * v[j][2] + v[j][3] * v[j][3]); }
            const float rstd = rsqrtf(wave_sum(s2) * (1.f / DM) + EPS);
#pragma unroll
            for (int j = 0; j < 4; ++j) v[j] = v[j] * rstd * g[j] + bb[j];
        }
        if (write_x) { float* xp = islat ? xlat + (size_t)row * DM : xctx + (size_t)(row - NLAT) * DM;
#pragma unroll
            for (int j = 0; j < 4; ++j) *(f32x4*)(xp + 4 * lane + 256 * j) = v[j]; }
        if (H) {
#pragma unroll
            for (int j = 0; j < 4; ++j) { const f32x4 h = v[j] * (scv[j] + 1.f) + sh[j]; u32x2 w; w.x = cvtpk2(h[0], h[1]); w.y = cvtpk2(h[2], h[3]); *(u32x2*)(H + (size_t)row * DM + 4 * lane + 256 * j) = w; } }
    }
}

__device__ __forceinline__ void phase_qkvpost(bf16_t* QKV, bf16_t* KB, bf16_t* VB, const float* qn, const float* kn, int G, int bid) {
    const int tid_ = opaque_tid(), lane = tid_ & 63, gw = bid * NWAVE + __builtin_amdgcn_readfirstlane(tid_ >> 6), NGW = G * NWAVE;
    const float L2T = 13.287712379549449f / 32.f;
    const int d0 = 2 * lane;
    const float f0 = exp2f(-(float)(d0 & 31) * L2T), f1 = exp2f(-(float)((d0 + 1) & 31) * L2T);
    const float qw0 = qn[d0], qw1 = qn[d0 + 1], kw0 = kn[d0], kw1 = kn[d0 + 1];
    unsigned rawn[12];
    if (gw < MROWS) {
#pragma unroll
        for (int head = 0; head < 12; ++head) rawn[head] = *(const unsigned*)(QKV + (size_t)gw * 1536 + d0 + head * 128);
    }
    for (int row = gw; row < MROWS; row += NGW) {
        const bool islat = row < NLAT;
        int b, pos; float c0 = 1.f, s0 = 0.f, c1 = 1.f, s1 = 0.f;
        unsigned rawc[12];
#pragma unroll
        for (int head = 0; head < 12; ++head) rawc[head] = rawn[head];
        if (row + NGW < MROWS) {
#pragma unroll
            for (int head = 0; head < 12; ++head) rawn[head] = *(const unsigned*)(QKV + (size_t)(row + NGW) * 1536 + d0 + head * 128);
        }
        if (islat) { b = row >> 11; const int t = row & 2047; pos = CTXL + t; const float p = (lane < 32) ? (float)(t >> 6) : (float)(t & 63); sincosf(p * f0, &s0, &c0); sincosf(p * f1, &s1, &c1); }
        else { const int r2 = row - NLAT; b = r2 >> 8; pos = r2 & 255; }
        bf16_t* base = QKV + (size_t)row * 1536 + d0;
        unsigned outv[12];
#pragma unroll
        for (int head = 0; head < 12; ++head) {
            const unsigned raw = rawc[head];
            float x0 = bflo(raw), x1 = bfhi(raw);
            if (head < 10) {
                const float ss = wave_sum(x0 * x0 + x1 * x1);
                const float rstd = rsqrtf(ss * (1.f / 128.f) + EPS);
                x0 *= rstd * (head < 8 ? qw0 : kw0); x1 *= rstd * (head < 8 ? qw1 : kw1);
                if (islat) {
                    float p0 = swzx<16>(x0), p1 = swzx<16>(x1);
                    if (!(lane & 16)) { p0 = -p0; p1 = -p1; }
                    x0 = x0 * c0 + p0 * s0; x1 = x1 * c1 + p1 * s1;
                }
            }
            outv[head] = cvtpk2(x0, x1);
        }
#pragma unroll
        for (int head = 0; head < 12; ++head) {
            if (head < 8) *(unsigned*)(base + head * 128) = outv[head];
            else { const int kvh = (head - 8) & 1; bf16_t* dst = (head < 10 ? KB : VB) + ((size_t)(b * 2 + kvh) * KVLEN + pos) * 128 + d0; *(unsigned*)dst = outv[head]; }
        }
    }
}


#ifndef GDN_TRIVIAL
#define GDN_TRIVIAL 0
#endif
namespace gdn {
#ifndef GDN_SB
#define GDN_SB 0
#endif
#if GDN_SB
#define SB_() __builtin_amdgcn_sched_barrier(0)
#else
#define SB_() do {} while (0)
#endif
constexpr int SQ = 272;
constexpr int SK = 144;
constexpr int OFF_Q = 0, OFF_K = 17408  , OFF_KT = 35840, OFF_VT = 54272  , OFF_T1 = 72704, OFF_T2 = 81920,
              OFF_A = 91136  , OFF_QK = 108544, OFF_ST = 117760, OFF_SM = 152576, GDN_LDS = 154624;
static_assert(GDN_LDS <= LDS_BYTES, "lds");
__device__ __forceinline__ bf16x8 ldf(const LAS unsigned char* p) { return *(const LAS bf16x8*)p; }
__device__ __forceinline__ f32x16 mfma(bf16x8 a, bf16x8 b, f32x16 c) { return __builtin_amdgcn_mfma_f32_32x32x16_bf16(a, b, c, 0, 0, 0); }
__device__ __forceinline__ unsigned short bf1(float v) { return (unsigned short)(cvtpk2(v, 0.f) & 0xffffu); }

__device__ __forceinline__ void conv_phase(const bf16_t* P, const float* __restrict__ convw, bf16_t* OUT, int which, int G, int bid) {
    const int tid = opaque_tid();
    const int gtid = bid * NTHR + tid, nthr = G * NTHR;
    const int cgc = gtid & 255, col = (which ? 2048 : 0) + cgc * 8;
    float cw[5][8];
#pragma unroll
    for (int j = 0; j < 5; ++j) { const f32x4 a = *(const f32x4*)(convw + j * 4096 + col), c = *(const f32x4*)(convw + j * 4096 + col + 4);
        cw[j][0] = a[0]; cw[j][1] = a[1]; cw[j][2] = a[2]; cw[j][3] = a[3]; cw[j][4] = c[0]; cw[j][5] = c[1]; cw[j][6] = c[2]; cw[j][7] = c[3]; }
    const float qs = (!which && col < 1024) ? 0.08838834764831845f : 1.f;
#define GDN_CONV_LOAD(dst, uu) do { const int r0_ = ((uu) >> 8) * 8; const bool il_ = r0_ < NLAT; const int t0_ = il_ ? (r0_ & 2047) : ((r0_ - NLAT) & 255); const int T_ = il_ ? SEQ : CTXL; \
        _Pragma("unroll") for (int rr = 0; rr < 12; ++rr) { const int t = t0_ - 2 + rr; dst[rr] = (t >= 0 && t < T_) ? *(const u32x4*)(P + (size_t)(r0_ - 2 + rr) * 4096 + col) : (u32x4){0u, 0u, 0u, 0u}; } } while (0)
    u32x4 raw[12], nxt[12];
    if (gtid < (MROWS / 8) * 256) GDN_CONV_LOAD(nxt, gtid);
    for (int u = gtid; u < (MROWS / 8) * 256; u += nthr) {
        const int row0 = (u >> 8) * 8;
#pragma unroll
        for (int rr = 0; rr < 12; ++rr) raw[rr] = nxt[rr];
        if (u + nthr < (MROWS / 8) * 256) GDN_CONV_LOAD(nxt, u + nthr);
#pragma unroll
        for (int tt = 0; tt < 8; ++tt) {
            float y[8];
#pragma unroll
            for (int e = 0; e < 8; ++e) y[e] = 0.f;
#pragma unroll
            for (int j = 0; j < 5; ++j) { const u32x4 rw = raw[tt + j];
                y[0] += bflo(rw.x) * cw[j][0]; y[1] += bfhi(rw.x) * cw[j][1]; y[2] += bflo(rw.y) * cw[j][2]; y[3] += bfhi(rw.y) * cw[j][3];
                y[4] += bflo(rw.z) * cw[j][4]; y[5] += bfhi(rw.z) * cw[j][5]; y[6] += bflo(rw.w) * cw[j][6]; y[7] += bfhi(rw.w) * cw[j][7]; }
            float ss = 0.f;
#pragma unroll
            for (int e = 0; e < 8; ++e) { y[e] = silu_f(y[e]); ss += y[e] * y[e]; }
            if (!which) {
                ss += swzx<1>(ss); ss += swzx<2>(ss); ss += swzx<4>(ss); ss += swzx<8>(ss);
                const float sc = rsqrtf(ss + EPS) * qs;
#pragma unroll
                for (int e = 0; e < 8; ++e) y[e] *= sc;
            }
            const u32x4 o = (u32x4){cvtpk2(y[0], y[1]), cvtpk2(y[2], y[3]), cvtpk2(y[4], y[5]), cvtpk2(y[6], y[7])};
            if (which) *(u32x4*)(OUT + (size_t)(row0 + tt) * 4096 + cgc * 8) = o; else *(u32x4*)(OUT + (size_t)(row0 + tt) * 2048 + cgc * 8) = o;
        }
    }
}

__device__ __forceinline__ void core(const bf16_t* QK, const bf16_t* PV, const float* __restrict__ GB, const float* __restrict__ norm_g,
                                     bf16_t* O, LAS unsigned char* lds, int G, int bid) {
    const int tid0 = opaque_tid(), wave = __builtin_amdgcn_readfirstlane(tid0 >> 6);
    LAS float* sm_gcum = (LAS float*)(lds + OFF_SM);
    LAS float* sm_beta = sm_gcum + 64;
    LAS float* sm_eg = sm_gcum + 128;
    LAS float* sm_e2 = sm_gcum + 192;
    LAS float* sm_egl = sm_gcum + 256;
    LAS float* Af = (LAS float*)(lds + OFF_A);
    const int ten = wave >> 1;
    const int ti = wave >> 2, tc = wave & 3, td = wave & 3;
    for (int item = bid; item < 256; item += G) {
        const int b = item >> 4, h = item & 15, hk = h >> 1;
        for (int dir = 0; dir < 2; ++dir) {
            f32x16 S0, S1;
#pragma unroll
            for (int r = 0; r < 16; ++r) { S0[r] = 0.f; S1[r] = 0.f; }
            __syncthreads();
            for (int q = tid0; q < 34816 / 16; q += NTHR) *(LAS u32x4*)(lds + OFF_ST + q * 16) = (u32x4){0u, 0u, 0u, 0u};
            __syncthreads();
            u32x4 pf[8];
#define GDN_PREFETCH(qq) do { if (wave < 6) { const int sq_ = (qq) >= 4, n_ = sq_ ? (qq) - 4 : (qq), T_ = sq_ ? SEQ : CTXL, rb_ = sq_ ? b * SEQ : NLAT + b * CTXL; \
        const int cc_ = dir ? T_ - 64 * (n_ + 1) : 64 * n_; const int pt_ = opaque_tid() & 127; \
        const bf16_t* sp_ = (ten == 2 ? PV + h * 128 : QK + ten * 1024 + hk * 128) + (ten ? (pt_ >> 3) : (pt_ & 15)) * 8; const size_t st_ = ten == 2 ? 4096 : 2048; \
        _Pragma("unroll") for (int tt_ = 0; tt_ < 8; ++tt_) pf[tt_] = *(const u32x4*)(sp_ + (size_t)(rb_ + cc_ + 8 * (ten ? (pt_ & 7) : (pt_ >> 4)) + tt_) * st_); } } while (0)
#pragma unroll
            for (int tt = 0; tt < 8; ++tt) pf[tt] = (u32x4){0u, 0u, 0u, 0u};
            GDN_PREFETCH(0);
            {
                for (int qc = 0; qc < 36; ++qc) {
                    const int seqi = qc >= 4, n = seqi ? qc - 4 : qc;
                    const int T = seqi ? SEQ : CTXL; const int rowbase = seqi ? b * SEQ : NLAT + b * CTXL;
                    const int c0 = dir ? T - 64 * (n + 1) : 64 * n;
                    int tid = tid0; asm volatile("" : "+v"(tid));
                    const int lane = tid & 63, l31 = lane & 31, hi = lane >> 5, idx = tid & 127, seg = ten ? (idx & 7) : (idx >> 4), cgp = ten ? (idx >> 3) : (idx & 15);
                    if (wave < 6) {
                        unsigned pk[8][4];
#pragma unroll
                        for (int tt = 0; tt < 8; ++tt) { pk[tt][0] = pf[tt].x; pk[tt][1] = pf[tt].y; pk[tt][2] = pf[tt].z; pk[tt][3] = pf[tt].w; }
                        if (ten < 2) {
                            LAS unsigned char* dst = lds + (ten == 0 ? OFF_Q : OFF_K) + cgp * 16;
#pragma unroll
                            for (int tt = 0; tt < 8; ++tt) { const int i = dir ? 63 - (8 * seg + tt) : 8 * seg + tt; *(LAS u32x4*)(dst + i * SQ) = (u32x4){pk[tt][0], pk[tt][1], pk[tt][2], pk[tt][3]}; }
                        }
                        if (ten >= 1) {
                            LAS unsigned char* dst = lds + (ten == 1 ? OFF_KT : OFF_VT) + (dir ? 56 - 8 * seg : 8 * seg) * 2;
#pragma unroll
                            for (int e = 0; e < 8; ++e) {
                                unsigned v[8];
#pragma unroll
                                for (int s = 0; s < 8; ++s) { const unsigned a = dir ? pk[7 - s][e >> 1] : pk[s][e >> 1]; v[s] = (e & 1) ? (a >> 16) : (a & 0xffffu); }
                                *(LAS u32x4*)(dst + (cgp * 8 + e) * SK) = (u32x4){v[0] | (v[1] << 16), v[2] | (v[3] << 16), v[4] | (v[5] << 16), v[6] | (v[7] << 16)};
                            }
                        }
                    } else if (wave == 6) {
                        const int t = dir ? c0 + 63 - lane : c0 + lane;
                        const float* gb = GB + (size_t)(rowbase + t) * 64;
                        const float beta = gb[dir * 16 + h]; const float g = gb[32 + dir * 16 + h];
                        float cs = g;
#pragma unroll
                        for (int off = 1; off < 64; off <<= 1) { const float v = __uint_as_float((unsigned)__builtin_amdgcn_ds_bpermute(((lane - off) & 63) << 2, (int)__float_as_uint(cs))); if (lane >= off) cs += v; }
                        const float glast = __uint_as_float((unsigned)__builtin_amdgcn_readlane((int)__float_as_uint(cs), 63));
                        sm_gcum[lane] = cs; sm_beta[lane] = beta; sm_eg[lane] = __expf(cs); sm_e2[lane] = __expf(glast - cs);
                        if (lane == 0) sm_egl[0] = __expf(glast);
                    }
                    __syncthreads();
                    if (qc + 1 < 36) GDN_PREFETCH(qc + 1);
                    if (wave < 4) {
                        if (wave < 2) {
                            const int bb = wave ? 32 : 0;
                            f32x16 acc;
#pragma unroll
                            for (int r = 0; r < 16; ++r) acc[r] = 0.f;
#pragma unroll
                            for (int kk = 0; kk < 8; ++kk) acc = mfma(ldf(lds + OFF_K + (bb + l31) * SQ + (16 * kk + 8 * hi) * 2), ldf(lds + OFF_K + (bb + l31) * SQ + (16 * kk + 8 * hi) * 2), acc);
                            const int j = bb + l31; const float gj = sm_gcum[j];
                            LAS float* Ab = (LAS float*)(lds + OFF_A + (wave ? 4608 : 0));
#pragma unroll
                            for (int r = 0; r < 16; ++r) { const int i = bb + crow(r, hi); const float val = (i > j) ? sm_beta[i] * acc[r] * __expf(sm_gcum[i] - gj) : 0.f; Ab[crow(r, hi) * 36 + l31] = val; }
                        } else if (wave == 2) {
                            f32x16 acc;
#pragma unroll
                            for (int r = 0; r < 16; ++r) acc[r] = 0.f;
#pragma unroll
                            for (int kk = 0; kk < 8; ++kk) acc = mfma(ldf(lds + OFF_K + l31 * SQ + (16 * kk + 8 * hi) * 2), ldf(lds + OFF_K + (32 + l31) * SQ + (16 * kk + 8 * hi) * 2), acc);
                            const int i = 32 + l31; const float gi = sm_gcum[i], bi = sm_beta[i];
#pragma unroll
                            for (int g4 = 0; g4 < 4; ++g4) { const int j0 = 8 * g4 + 4 * hi; float v[4];
#pragma unroll
                                for (int e = 0; e < 4; ++e) v[e] = bi * acc[4 * g4 + e] * __expf(gi - sm_gcum[j0 + e]);
                                *(LAS u32x2*)(lds + LDS_S2 + l31 * 64 + j0 * 2) = (u32x2){cvtpk2(v[0], v[1]), cvtpk2(v[2], v[3])}; }
                        }
                    } else {
                        const int w4 = wave - 4, aj = w4 >> 1, ai = w4 & 1;
                        f32x16 acc;
#pragma unroll
                        for (int r = 0; r < 16; ++r) acc[r] = 0.f;
                        if (!(aj == 1 && ai == 0)) {
#pragma unroll
                            for (int kk = 0; kk < 8; ++kk) acc = mfma(ldf(lds + OFF_K + (32 * aj + l31) * SQ + (16 * kk + 8 * hi) * 2), ldf(lds + OFF_Q + (32 * ai + l31) * SQ + (16 * kk + 8 * hi) * 2), acc);
                        }
                        const int i = 32 * ai + l31; const float gi = sm_gcum[i];
#pragma unroll
                        for (int g4 = 0; g4 < 4; ++g4) { const int j0 = 32 * aj + 8 * g4 + 4 * hi; float v[4];
#pragma unroll
                            for (int e = 0; e < 4; ++e) { const int j = j0 + e; v[e] = (i >= j) ? acc[4 * g4 + e] * __expf(gi - sm_gcum[j]) : 0.f; }
                            *(LAS u32x2*)(lds + OFF_QK + i * SK + j0 * 2) = (u32x2){cvtpk2(v[0], v[1]), cvtpk2(v[2], v[3])}; }
                    }
                    f32x16 a1;
#pragma unroll
                    for (int r = 0; r < 16; ++r) a1[r] = 0.f;
                    if (wave >= 2) {
#pragma unroll
                        for (int kk = 0; kk < 8; ++kk) a1 = mfma(ldf(lds + OFF_Q + (32 * ti + l31) * SQ + (16 * kk + 8 * hi) * 2), ldf(lds + OFF_ST + (32 * tc + l31) * SQ + (16 * kk + 8 * hi) * 2), a1);
                    }
                    if (wave < 2) {
                        const int c = l31, bb = 32 * wave;
                        const float cf = (float)c;
                        const LAS float* Ab = (const LAS float*)(lds + OFF_A + wave * 4608); asm volatile("" : "+v"(Ab));
                        f32x2_t xp[16];
#pragma unroll
                        for (int p = 0; p < 16; ++p) xp[p] = (f32x2_t){0.f, 0.f};
                        f32x4 rbA[8], rbB[8];
#define GDN_ROWLOAD(dst, row) do { _Pragma("unroll") for (int q_ = 0; q_ < ((row) + 3) / 4; ++q_) dst[q_] = *(const LAS f32x4*)(Ab + (row) * 36 + 4 * q_); } while (0)
#define GDN_ROWSOLVE(src, row) do { f32x2_t sA = (f32x2_t){fmaxf(0.f, 1.f - fabsf(cf - (float)(row))), 0.f}, sB = (f32x2_t){0.f, 0.f}; \
        _Pragma("unroll") for (int j4 = 0; j4 < (row); j4 += 4) { const f32x4 a = src[j4 >> 2]; sA -= (f32x2_t){a[0], a[1]} * xp[j4 >> 1]; sB -= (f32x2_t){a[2], a[3]} * xp[(j4 >> 1) + 1]; } \
        const float xr_ = (sA[0] + sA[1]) + (sB[0] + sB[1]); xp[(row) >> 1][(row) & 1] = xr_; } while (0)
#pragma unroll
                        for (int ii = 0; ii < 32; ii += 2) {
                            GDN_ROWLOAD(rbB, ii + 1);
                            GDN_ROWSOLVE(rbA, ii);
                            if (ii + 2 < 32) GDN_ROWLOAD(rbA, ii + 2);
                            GDN_ROWSOLVE(rbB, ii + 1);
                        }
#undef GDN_ROWLOAD
#undef GDN_ROWSOLVE
                        float x[32];
#pragma unroll
                        for (int p = 0; p < 16; ++p) { x[2 * p] = xp[p][0]; x[2 * p + 1] = xp[p][1]; }
                        const float bc = sm_beta[bb + c], bce = bc * sm_eg[bb + c];
                        if (hi == 0) {
#pragma unroll
                            for (int i = 0; i < 32; ++i) {
                                *(LAS unsigned short*)(lds + OFF_T1 + (bb + i) * SK + (bb + c) * 2) = bf1(x[i] * bc);
                                *(LAS unsigned short*)(lds + OFF_T2 + (bb + i) * SK + (bb + c) * 2) = bf1(x[i] * bce);
                            }
                            if (wave == 0) {
#pragma unroll
                                for (int i = 0; i < 32; ++i) { *(LAS unsigned short*)(lds + OFF_T1 + i * SK + (32 + c) * 2) = 0; *(LAS unsigned short*)(lds + OFF_T2 + i * SK + (32 + c) * 2) = 0; }
#pragma unroll
                                for (int q = 0; q < 4; ++q) *(LAS u32x4*)(lds + LDS_S2 + 2048 + c * 64 + q * 16) = (u32x4){cvtpk2(x[8 * q], x[8 * q + 1]), cvtpk2(x[8 * q + 2], x[8 * q + 3]), cvtpk2(x[8 * q + 4], x[8 * q + 5]), cvtpk2(x[8 * q + 6], x[8 * q + 7])};
                            } else {
#pragma unroll
                                for (int i = 0; i < 32; ++i) *(LAS unsigned short*)(lds + LDS_S2 + 4096 + i * 64 + c * 2) = bf1(x[i]);
                            }
                        }
                    }
                    __syncthreads();
                    if (wave < 2) {
#pragma unroll
                        for (int kk = 0; kk < 8; ++kk) a1 = mfma(ldf(lds + OFF_Q + (32 * ti + l31) * SQ + (16 * kk + 8 * hi) * 2), ldf(lds + OFF_ST + (32 * tc + l31) * SQ + (16 * kk + 8 * hi) * 2), a1);
                    }
                    if (wave >= 4) {
                        f32x16 y;
#pragma unroll
                        for (int r = 0; r < 16; ++r) y[r] = 0.f;
#pragma unroll
                        for (int kk = 0; kk < 2; ++kk) y = mfma(ldf(lds + LDS_S2 + l31 * 64 + (16 * kk + 8 * hi) * 2), ldf(lds + LDS_S2 + 2048 + l31 * 64 + (16 * kk + 8 * hi) * 2), y);
                        bf16x8 pa0, pa1;
#define GDN_PK4(P, BASE, OUT) do { const unsigned a0_ = cvtpk2(P[BASE + 0], P[BASE + 1]), a1_ = cvtpk2(P[BASE + 2], P[BASE + 3]), b0_ = cvtpk2(P[BASE + 4], P[BASE + 5]), b1_ = cvtpk2(P[BASE + 6], P[BASE + 7]); \
        auto r0_ = __builtin_amdgcn_permlane32_swap(a0_, b0_, false, false); auto r1_ = __builtin_amdgcn_permlane32_swap(a1_, b1_, false, false); \
        u32x4 w_ = {r0_[0], r1_[0], r0_[1], r1_[1]}; OUT = __builtin_bit_cast(bf16x8, w_); } while (0)
                        GDN_PK4(y, 0, pa0); GDN_PK4(y, 8, pa1);
#undef GDN_PK4
                        f32x16 zt;
#pragma unroll
                        for (int r = 0; r < 16; ++r) zt[r] = 0.f;
                        zt = mfma(pa0, ldf(lds + LDS_S2 + 4096 + l31 * 64 + (8 * hi) * 2), zt);
                        zt = mfma(pa1, ldf(lds + LDS_S2 + 4096 + l31 * 64 + (16 + 8 * hi) * 2), zt);
#pragma unroll
                        for (int g4 = 0; g4 < 4; ++g4) { const int c0 = 8 * g4 + 4 * hi;
                            const f32x4 b4 = *(const LAS f32x4*)(sm_beta + c0), e4 = *(const LAS f32x4*)(sm_eg + c0);
                            float t1[4], t2[4];
#pragma unroll
                            for (int e = 0; e < 4; ++e) { t1[e] = -zt[4 * g4 + e] * b4[e]; t2[e] = t1[e] * e4[e]; }
                            *(LAS u32x2*)(lds + OFF_T1 + (32 + l31) * SK + c0 * 2) = (u32x2){cvtpk2(t1[0], t1[1]), cvtpk2(t1[2], t1[3])};
                            *(LAS u32x2*)(lds + OFF_T2 + (32 + l31) * SK + c0 * 2) = (u32x2){cvtpk2(t2[0], t2[1]), cvtpk2(t2[2], t2[3])}; }
                    }
                    f32x16 au;
#pragma unroll
                    for (int r = 0; r < 16; ++r) au[r] = 0.f;
#pragma unroll
                    for (int kk = 0; kk < 4; ++kk) au = mfma(ldf(lds + OFF_T1 + (32 * ti + l31) * SK + (16 * kk + 8 * hi) * 2), ldf(lds + OFF_VT + (32 * tc + l31) * SK + (16 * kk + 8 * hi) * 2), au);
                    {
                        f32x16 aw;
#pragma unroll
                        for (int r = 0; r < 16; ++r) aw[r] = 0.f;
#pragma unroll
                        for (int kk = 0; kk < 4; ++kk) aw = mfma(ldf(lds + OFF_KT + (32 * td + l31) * SK + (16 * kk + 8 * hi) * 2), ldf(lds + OFF_T2 + (32 * ti + l31) * SK + (16 * kk + 8 * hi) * 2), aw);
                        const int i = 32 * ti + l31;
#pragma unroll
                        for (int g4 = 0; g4 < 4; ++g4) { const int d0 = 32 * td + 8 * g4 + 4 * hi;
                            *(LAS u32x2*)(lds + OFF_A + i * SQ + d0 * 2) = (u32x2){cvtpk2(-aw[4 * g4], -aw[4 * g4 + 1]), cvtpk2(-aw[4 * g4 + 2], -aw[4 * g4 + 3])}; }
                    }
                    __syncthreads();
#pragma unroll
                    for (int kk = 0; kk < 8; ++kk) au = mfma(ldf(lds + OFF_A + (32 * ti + l31) * SQ + (16 * kk + 8 * hi) * 2), ldf(lds + OFF_ST + (32 * tc + l31) * SQ + (16 * kk + 8 * hi) * 2), au);
                    {
                        const int c = 32 * tc + l31;
#pragma unroll
                        for (int g4 = 0; g4 < 4; ++g4) { const int i0 = 32 * ti + 8 * g4 + 4 * hi;
                            const f32x4 e2 = *(const LAS f32x4*)(sm_e2 + i0);
                            *(LAS u32x2*)(lds + OFF_VT + c * SK + i0 * 2) = (u32x2){cvtpk2(au[4 * g4], au[4 * g4 + 1]), cvtpk2(au[4 * g4 + 2], au[4 * g4 + 3])};
                            *(LAS u32x2*)(lds + OFF_K + c * SK + i0 * 2) = (u32x2){cvtpk2(au[4 * g4] * e2[0], au[4 * g4 + 1] * e2[1]), cvtpk2(au[4 * g4 + 2] * e2[2], au[4 * g4 + 3] * e2[3])}; }
                    }
                    __syncthreads();
                    f32x16 a2;
#pragma unroll
                    for (int r = 0; r < 16; ++r) a2[r] = 0.f;
#pragma unroll
                    for (int kk = 0; kk < 4; ++kk) a2 = mfma(ldf(lds + OFF_QK + (32 * ti + l31) * SK + (16 * kk + 8 * hi) * 2), ldf(lds + OFF_VT + (32 * tc + l31) * SK + (16 * kk + 8 * hi) * 2), a2);
#pragma unroll
                    for (int g4 = 0; g4 < 4; ++g4) { const f32x4 eg = *(const LAS f32x4*)(sm_eg + 32 * ti + 8 * g4 + 4 * hi);
#pragma unroll
                        for (int e = 0; e < 4; ++e) a2[4 * g4 + e] += a1[4 * g4 + e] * eg[e]; }
                    {
                        const float egl = sm_egl[0];
#pragma unroll
                        for (int r = 0; r < 16; ++r) { S0[r] *= egl; S1[r] *= egl; }
#pragma unroll
                        for (int kk = 0; kk < 4; ++kk) { const bf16x8 a = ldf(lds + OFF_KT + (32 * td + l31) * SK + (16 * kk + 8 * hi) * 2);
                            S0 = mfma(a, ldf(lds + OFF_K + (32 * (2 * ti) + l31) * SK + (16 * kk + 8 * hi) * 2), S0);
                            S1 = mfma(a, ldf(lds + OFF_K + (32 * (2 * ti + 1) + l31) * SK + (16 * kk + 8 * hi) * 2), S1); }
                    }
                    if (dir == 0) __syncthreads();
#pragma unroll
                    for (int g4 = 0; g4 < 4; ++g4) { const int d0 = 32 * td + 8 * g4 + 4 * hi;
                        *(LAS u32x2*)(lds + OFF_ST + (32 * (2 * ti) + l31) * SQ + d0 * 2) = (u32x2){cvtpk2(S0[4 * g4], S0[4 * g4 + 1]), cvtpk2(S0[4 * g4 + 2], S0[4 * g4 + 3])};
                        *(LAS u32x2*)(lds + OFF_ST + (32 * (2 * ti + 1) + l31) * SQ + d0 * 2) = (u32x2){cvtpk2(S1[4 * g4], S1[4 * g4 + 1]), cvtpk2(S1[4 * g4 + 2], S1[4 * g4 + 3])}; }
                    if (dir == 0) {
                        bf16_t* go = O + (size_t)(rowbase + c0 + 32 * ti) * 4096 + h * 128 + 32 * tc + l31;
#pragma unroll
                        for (int r = 0; r < 16; ++r) go[(size_t)crow(r, hi) * 4096] = bf1(a2[r]);
                    } else {
#pragma unroll
                        for (int r = 0; r < 16; ++r) *(LAS unsigned short*)(lds + OFF_A + (32 * ti + crow(r, hi)) * SQ + (32 * tc + l31) * 2) = bf1(a2[r]);
                        __syncthreads();
                    }
                    if (dir) {
                        const int i = tid >> 3, cs = (tid & 7) * 16;
                        const int t = dir ? c0 + 63 - i : c0 + i;
                        bf16_t* gp = O + (size_t)(rowbase + t) * 4096 + h * 128 + cs;
                        const u32x4 s0 = *(const LAS u32x4*)(lds + OFF_A + i * SQ + cs * 2), s1 = *(const LAS u32x4*)(lds + OFF_A + i * SQ + cs * 2 + 16);
                        if (dir == 0) { *(u32x4*)gp = s0; *(u32x4*)(gp + 8) = s1; }
                        else {
                            const u32x4 p0 = *(const u32x4*)gp, p1 = *(const u32x4*)(gp + 8);
                            float v[16];
                            v[0] = bflo(s0.x) + bflo(p0.x); v[1] = bfhi(s0.x) + bfhi(p0.x); v[2] = bflo(s0.y) + bflo(p0.y); v[3] = bfhi(s0.y) + bfhi(p0.y);
                            v[4] = bflo(s0.z) + bflo(p0.z); v[5] = bfhi(s0.z) + bfhi(p0.z); v[6] = bflo(s0.w) + bflo(p0.w); v[7] = bfhi(s0.w) + bfhi(p0.w);
                            v[8] = bflo(s1.x) + bflo(p1.x); v[9] = bfhi(s1.x) + bfhi(p1.x); v[10] = bflo(s1.y) + bflo(p1.y); v[11] = bfhi(s1.y) + bfhi(p1.y);
                            v[12] = bflo(s1.z) + bflo(p1.z); v[13] = bfhi(s1.z) + bfhi(p1.z); v[14] = bflo(s1.w) + bflo(p1.w); v[15] = bfhi(s1.w) + bfhi(p1.w);
                            float ss = 0.f;
#pragma unroll
                            for (int e = 0; e < 16; ++e) ss += v[e] * v[e];
                            ss += swzx<1>(ss); ss += swzx<2>(ss); ss += swzx<4>(ss);
                            const float rstd = rsqrtf(ss * (1.f / 128.f) + EPS);
#pragma unroll
                            for (int e = 0; e < 16; ++e) v[e] *= rstd * norm_g[cs + e];
                            *(u32x4*)gp = (u32x4){cvtpk2(v[0], v[1]), cvtpk2(v[2], v[3]), cvtpk2(v[4], v[5]), cvtpk2(v[6], v[7])};
                            *(u32x4*)(gp + 8) = (u32x4){cvtpk2(v[8], v[9]), cvtpk2(v[10], v[11]), cvtpk2(v[12], v[13]), cvtpk2(v[14], v[15])};
                        }
                    }
                }
            }
        }
        __syncthreads();
    }
}
}
#define XB_TMO      128
#define XB_XCNT(j)  (256  + 64 * (j))
#define XB_XSUB(j)  (1280 + 64 * (j))
#define XB_XGEN(j)  (2304 + 64 * (j))
#define XB_TOP      3328
#define XB_TOPGEN   3392
#define XCD_BAR_WORDS 3456
#define XB_SPIN_CAP (1u << 18)

__device__ __forceinline__ unsigned xb_ld(unsigned* p)              { return __hip_atomic_load(p, __ATOMIC_RELAXED, __HIP_MEMORY_SCOPE_AGENT); }
__device__ __forceinline__ unsigned xb_add(unsigned* p, unsigned v) { return __hip_atomic_fetch_add(p, v, __ATOMIC_RELAXED, __HIP_MEMORY_SCOPE_AGENT); }
__device__ __forceinline__ unsigned xb_xcc_id() { return (unsigned)__builtin_amdgcn_s_getreg((3 << 11) | 20) & 0xFu; }
#define XB_SPIN(cond, bar) do { unsigned _sp = 0; while (cond) { __builtin_amdgcn_s_sleep(1); \
    if ((++_sp & 255u) == 0u) { if (xb_ld(&(bar)[XB_TMO])) break; if (_sp > XB_SPIN_CAP) { atomicAdd(&(bar)[XB_TMO], 1u); break; } } } } while (0)

struct XcdBarrier {
    unsigned* bar; unsigned x;
    volatile LAS unsigned* st;
};

__device__ __forceinline__ XcdBarrier xcd_barrier_post(unsigned* bar, volatile LAS unsigned* st) {
    XcdBarrier b; b.bar = bar; b.x = xb_xcc_id(); b.st = st;
    if (threadIdx.x == 0) (void)xb_add(&bar[XB_XCNT(b.x)], 1u);
    return b;
}
__device__ __forceinline__ void xcd_barrier_complete(unsigned* bar, unsigned x, unsigned& nloc, unsigned& nx) {
    const unsigned G = gridDim.x * gridDim.y * gridDim.z;
    unsigned sum, cnt, mine, sp = 0u;
    for (;;) {
        sum = 0u; cnt = 0u; mine = 0u;
#pragma unroll
        for (unsigned j = 0; j < 16; ++j) { const unsigned c = xb_ld(&bar[XB_XCNT(j)]); sum += c; cnt += (c > 0u) ? 1u : 0u; mine = (j == x) ? c : mine; }
        if (sum == G) break;
        __builtin_amdgcn_s_sleep(1);
        if ((++sp & 255u) == 0u) { if (xb_ld(&bar[XB_TMO])) break; if (sp > XB_SPIN_CAP) { atomicAdd(&bar[XB_TMO], 1u); break; } }
    }
    nloc = mine > 0u ? mine : 1u; nx = cnt > 0u ? cnt : 1u;
}

__device__ __forceinline__ void xcd_barrier(const XcdBarrier& b) {
    asm volatile("s_waitcnt vmcnt(0)" ::: "memory");
    __syncthreads();
    if (threadIdx.x == 0) {
        unsigned* bar = b.bar;
        __builtin_amdgcn_s_waitcnt(0);
        unsigned nloc = b.st[0], nx = b.st[1];
        if (nloc == 0u) { xcd_barrier_complete(bar, b.x, nloc, nx); b.st[0] = nloc; b.st[1] = nx; }
        const unsigned old = xb_add(&bar[XB_XSUB(b.x)], 1u);
        const unsigned gen = old / nloc;
        if (old + 1u == (gen + 1u) * nloc) {
            __builtin_amdgcn_fence(__ATOMIC_RELEASE, "agent");
            asm volatile("s_waitcnt vmcnt(0)" ::: "memory");
            const unsigned og = xb_add(&bar[XB_TOP], 1u);
            const unsigned tg = og / nx;
            if (og + 1u == (tg + 1u) * nx) xb_add(&bar[XB_TOPGEN], 1u);
            else XB_SPIN(xb_ld(&bar[XB_TOPGEN]) == tg, bar);
            __builtin_amdgcn_fence(__ATOMIC_ACQUIRE, "agent");
            xb_add(&bar[XB_XGEN(b.x)], 1u);
            asm volatile("s_waitcnt vmcnt(0)" ::: "memory");
        } else {
            XB_SPIN(xb_ld(&bar[XB_XGEN(b.x)]) == gen, bar);
            __builtin_amdgcn_fence(__ATOMIC_ACQUIRE, "agent");
            asm volatile("s_waitcnt vmcnt(0)" ::: "memory");
        }
    }
    __syncthreads();
}

#ifndef EN_MOD
#define EN_MOD 1
#endif
#ifndef EN_GEMM
#define EN_GEMM 1
#endif
#ifndef EN_GDN
#define EN_GDN 1
#endif
#ifndef EN_ATT
#define EN_ATT 1
#endif
#ifndef EN_G1
#define EN_G1 1
#endif
#ifndef EN_G2
#define EN_G2 1
#endif
#ifndef EN_G3
#define EN_G3 1
#endif
#ifndef EN_G4
#define EN_G4 1
#endif
#ifndef EN_G5
#define EN_G5 1
#endif
#ifndef EN_G6
#define EN_G6 1
#endif
#define GSYNC() xcd_barrier(xbar)
#define GSYNC_CG() do { asm volatile("s_waitcnt vmcnt(0) lgkmcnt(0)" ::: "memory"); grid.sync(); __builtin_amdgcn_fence(__ATOMIC_ACQUIRE, "agent"); asm volatile("s_waitcnt vmcnt(0)" ::: "memory"); __syncthreads(); } while (0)
#ifndef DBG_MEMSET
#define DBG_MEMSET 0
#endif
#ifndef GDN_REPS
#define GDN_REPS 1
#endif
#ifndef SYNC_REPS
#define SYNC_REPS 1
#endif
#ifndef FFN1_REPS
#define FFN1_REPS 1
#endif
#ifndef ATT_REPS
#define ATT_REPS 1
#endif
#ifndef PR_REPS
#define PR_REPS 1
#endif
#ifndef PROBE_PREP
#define PROBE_PREP 0
#endif
#ifndef G1_REPS
#define G1_REPS 1
#endif
#ifndef PROBE_FFN2
#define PROBE_FFN2 0
#endif
#ifndef GEMM_ALIGN
#define GEMM_ALIGN true
#endif
#ifndef GEMM_SP2
#define GEMM_SP2 true
#endif
struct Args { const float* in[20]; float* out; unsigned char* ws; };

__global__ void __launch_bounds__(NTHR, 2) fwd_megakernel(Args args) {
    extern __shared__ __attribute__((aligned(16))) unsigned char lds_raw[];
    cg::grid_group grid = cg::this_grid();
    LAS unsigned char* lds = (LAS unsigned char*)lds_raw;
    const int G = gridDim.x, bid = blockIdx.x;
    if (threadIdx.x < 2) ((volatile LAS unsigned*)(lds + LDS_XB))[threadIdx.x] = 0u;
    __syncthreads();
    XcdBarrier xbar = xcd_barrier_post((unsigned*)(WS() + WS_BAR), (volatile LAS unsigned*)(lds + LDS_XB));
#if EN_MOD
    phase_mod(IN(1), IN(3), IN(4), IN(5), P_MOD, lds, G, bid);
#endif
    __syncthreads();
    phase_convert(0, P_Wb, lds, G, bid, 31, 0);
    GSYNC_CG();

    for (int L = 0; L < 4; ++L) {
        const bool is_gdn = !(L & 1), last = (L == 3);
        const int j = L >> 1;
        const int Mrows = last ? NLAT : MROWS;
        if (L == 0) phase_prep(IN(0), IN(2), P_xlat, P_xctx, true, nullptr, nullptr, P_BIG2, MODL, MODL + DM, MROWS, G, bid);
        else {
            phase_prep(P_xlat, P_xctx, P_xlat, P_xctx, true, IN(6) + (size_t)((L - 1) * 2 + 1) * DM, IN(7) + (size_t)((L - 1) * 2 + 1) * DM, P_BIG2, MODL, MODL + DM, MROWS, G, bid);
            phase_convert(L, P_Wb, lds, G, bid, 16, 0);
        }
        GSYNC();
        const bf16_t* mixA; int mixK, mixLda;
        if (is_gdn) {
            {
                pg8::Gemm g{P_BIG2, P_Wb + W_A, MROWS, GIN1, 1024, 1024}; pg8::StaticOrder S; S.init(MROWS, GIN1, G, bid);
                EpiGdnIn E{P_BIG1, P_GB, IN(12) + j * 32, IN(13) + j * 32};
                for (int gr_ = 0; gr_ < G1_REPS; ++gr_) pg8::gemm_phase<EpiGdnIn, pg8::StaticOrder, GEMM_ALIGN, GEMM_SP2>(lds, g, S, E);
            }
            GSYNC();
            for (int cr_ = 0; cr_ < PR_REPS; ++cr_) gdn::conv_phase(P_BIG1, IN(11) + (size_t)j * 5 * 4096, P_BIG2, 0, G, bid);
            GSYNC();
            for (int cr_ = 0; cr_ < PR_REPS; ++cr_) gdn::conv_phase(P_BIG1, IN(11) + (size_t)j * 5 * 4096, P_BIG1, 1, G, bid);
            GSYNC();
            for (int rep_ = 0; rep_ < GDN_REPS; ++rep_) gdn::core(P_BIG2, P_BIG1, P_GB, IN(14) + j * 128, P_BIG1 + 2048, lds, G, bid);
            GSYNC();
            for (int cr_ = 0; cr_ < PR_REPS; ++cr_) phase_prep(P_xlat, P_xctx, P_xlat, P_xctx, false, nullptr, nullptr, P_BIG2, MODL, MODL + DM, MROWS, G, bid);
            GSYNC();
            {
                pg8::Gemm g{P_BIG2, P_Wb + W_Z, MROWS, 2048, 1024, 1024}; pg8::StaticOrder S; S.init(MROWS, 2048, G, bid);
                EpiGateZ E{P_BIG1 + 2048};
                if (EN_GEMM && EN_G2) pg8::gemm_phase<EpiGateZ, pg8::StaticOrder, GEMM_ALIGN, GEMM_SP2>(lds, g, S, E);
            }
            GSYNC();
            mixA = P_BIG1 + 2048; mixK = 2048; mixLda = 4096;
        } else {
            {
                pg8::Gemm g{P_BIG2, P_Wb + W_A, MROWS, 1536, 1024, 1024}; pg8::StaticOrder S; S.init(MROWS, 1536, G, bid);
                EpiPlainBf16 E{P_QKV, 1536};
                if (EN_GEMM && EN_G3) pg8::gemm_phase<EpiPlainBf16, pg8::StaticOrder, GEMM_ALIGN, GEMM_SP2>(lds, g, S, E);
            }
            GSYNC();
            phase_qkvpost(P_QKV, P_KB, P_VB, IN(17) + j * 128, IN(18) + j * 128, G, bid);
            GSYNC();
            {
                const int total = 1024 + (last ? 0 : 128);
                for (int arep_ = 0; arep_ < ATT_REPS; ++arep_)
                for (int it = bid; it < total; it += G) {
                    const att::bf16 *Qp, *Kp, *Vp; unsigned short* Op; int seq;
                    if (it < 1024) {
                        const int rnd = it >> 8, b256 = it & 255, grp = rnd * 8 + (b256 & 7), within = b256 >> 3;
                        const int b = grp >> 1, kvh = grp & 1, gq = within >> 3, qb = within & 7, h = kvh * 4 + gq;
                        Qp = (const att::bf16*)(P_QKV + (size_t)(b * SEQ + qb * 256) * 1536 + h * 128);
                        Kp = (const att::bf16*)(P_KB + (size_t)(b * 2 + kvh) * KVLEN * 128); Vp = (const att::bf16*)(P_VB + (size_t)(b * 2 + kvh) * KVLEN * 128);
                        Op = P_AO + (size_t)(b * SEQ + qb * 256) * 1024 + h * 128; seq = KVLEN;
                    } else {
                        const int q = it - 1024, b = q >> 3, h = q & 7, kvh = h >> 2;
                        Qp = (const att::bf16*)(P_QKV + (size_t)(NLAT + b * CTXL) * 1536 + h * 128);
                        Kp = (const att::bf16*)(P_KB + (size_t)(b * 2 + kvh) * KVLEN * 128); Vp = (const att::bf16*)(P_VB + (size_t)(b * 2 + kvh) * KVLEN * 128);
                        Op = P_AO + (size_t)(NLAT + b * CTXL) * 1024 + h * 128; seq = CTXL;
                    }
                    if (EN_ATT) att::attn_dense_body<att::bf16, 1536, 128, 1024>(Qp, Kp, Vp, Op, seq, (char*)lds_raw);
                    __syncthreads();
                }
            }
            GSYNC();
            mixA = P_AO; mixK = 1024; mixLda = 1024;
        }
        {
            pg8::Gemm g{mixA, P_Wb + W_O, Mrows, 1024, mixK, mixLda}; pg8::StaticOrder S; S.init(Mrows, 1024, G, bid);
            EpiResid E{P_xlat, P_xctx, MODL + 2 * DM, ALPHA, 1.f};
            if (EN_GEMM && EN_G4) pg8::gemm_phase<EpiResid, pg8::StaticOrder, GEMM_ALIGN, GEMM_SP2>(lds, g, S, E);
        }
        GSYNC();
#if PROBE_PREP
        phase_prep(P_xlat, P_xctx, P_xlat, P_xctx, false, IN(6) + (size_t)(L * 2) * DM, IN(7) + (size_t)(L * 2) * DM, P_BIG1, MODL + 3 * DM, MODL + 4 * DM, Mrows, G, bid);
#endif
        phase_prep(P_xlat, P_xctx, P_xlat, P_xctx, true, IN(6) + (size_t)(L * 2) * DM, IN(7) + (size_t)(L * 2) * DM, P_BIG2, MODL + 3 * DM, MODL + 4 * DM, Mrows, G, bid);
        GSYNC();
        {
            pg8::Gemm g{P_BIG2, P_Wb + W_F1, Mrows, 5632, 1024, 1024}; pg8::StaticOrder S; S.init(Mrows, 5632, G, bid);
            EpiSwiglu E{P_BIG1};
            for (int rp_ = 0; rp_ < FFN1_REPS; ++rp_) pg8::gemm_phase<EpiSwiglu, pg8::StaticOrder, GEMM_ALIGN, GEMM_SP2>(lds, g, S, E);
        }
        GSYNC();
        {
            pg8::Gemm g{P_BIG1, P_Wb + W_F2, Mrows, 1024, DFF, DFF}; pg8::StaticOrder S; S.init(Mrows, 1024, G, bid);
#if PROBE_FFN2
            { EpiResid E0{P_xlat, P_xctx, MODL + 5 * DM, 1.f, 0.f}; pg8::gemm_phase<EpiResid, pg8::StaticOrder, GEMM_ALIGN, GEMM_SP2>(lds, g, S, E0); }
#endif
            EpiResid E{P_xlat, P_xctx, MODL + 5 * DM, ALPHA, 1.f};
            if (EN_GEMM && EN_G6) pg8::gemm_phase<EpiResid, pg8::StaticOrder, GEMM_ALIGN, GEMM_SP2>(lds, g, S, E);
            if (L < 3) { __syncthreads(); phase_convert(L + 1, P_Wb, lds, G, bid, 15, (G == 256 && Mrows == MROWS) ? 64 : 0); }
        }
        GSYNC();
    }
    phase_prep(P_xlat, P_xctx, P_xlat, P_xctx, true, IN(6) + (size_t)7 * DM, IN(7) + (size_t)7 * DM, nullptr, nullptr, nullptr, NLAT, G, bid);
}

extern "C" void kernel_launch(void* const* d_in, const int* in_sizes, int n_in, void* d_out, int out_size, void* d_ws, size_t ws_size, hipStream_t stream) {
    static int grid = 0;
    if (grid == 0) {
        if (n_in != 20 || out_size != NLAT * DM || ws_size < WS_END) { fprintf(stderr, "kernel_launch: unexpected shapes: n_in %d out %d ws %zu (need %zu)\n", n_in, out_size, ws_size, (size_t)WS_END); grid = -1; return; }
        int dev = 0, cus = 0, per_cu = 0;
        hipGetDevice(&dev); hipDeviceGetAttribute(&cus, hipDeviceAttributeMultiprocessorCount, dev);
        if (hipFuncSetAttribute((const void*)fwd_megakernel, hipFuncAttributeMaxDynamicSharedMemorySize, LDS_BYTES) != hipSuccess) { fprintf(stderr, "kernel_launch: hipFuncSetAttribute failed\n"); grid = -1; return; }
        if (hipOccupancyMaxActiveBlocksPerMultiprocessor(&per_cu, (const void*)fwd_megakernel, NTHR, LDS_BYTES) != hipSuccess || per_cu < 1) { fprintf(stderr, "kernel_launch: occupancy query says %d\n", per_cu); per_cu = 1; }
        (void)hipGetLastError();
        grid = cus;
    }
    if (grid < 0) return;
    Args a{};
    for (int i = 0; i < 20; ++i) a.in[i] = (const float*)d_in[i];
    a.out = (float*)d_out; a.ws = (unsigned char*)d_ws;
#if DBG_MEMSET
    (void)hipMemsetAsync(d_ws, 0, WS_END, stream); (void)hipMemsetAsync(d_out, 0, (size_t)out_size * 4, stream);
#endif
    (void)hipMemsetAsync((char*)d_ws + WS_BAR, 0, WS_BAR_BYTES, stream);
    void* kargs[] = {&a};
    hipError_t e = hipLaunchCooperativeKernel((const void*)fwd_megakernel, dim3(grid), dim3(NTHR), kargs, LDS_BYTES, stream);
    if (e != hipSuccess) fprintf(stderr, "kernel_launch: cooperative launch failed: %s (grid %d)\n", hipGetErrorString(e), grid);
}
```
